# Optimizing an MI355X kernel written in HIP

```python
import math
import jax, jax.numpy as jnp
from jax import lax
import numpy as np

D_MODEL = 2048
BATCH = 8
SEQ = 2048
DEPTH = 2

MIX_WIDTH = D_MODEL
RET_WIDTH = MIX_WIDTH // 2
SSM_WIDTH = MIX_WIDTH - RET_WIDTH
RET_HEAD_DIM = 256
RET_HEADS = RET_WIDTH // RET_HEAD_DIM
RET_CHUNK = 128
ROPE_BASE = 10000.0
SSM_GROUP = 16
SSM_GROUPS = SSM_WIDTH // SSM_GROUP
SSM_STATE = 64
DT_MIN = 1e-3
DT_MAX = 1e-1
IN_PROJ_WIDTH = 4 * RET_WIDTH + SSM_WIDTH
N_EXPERTS = 32
N_EXPERT_GROUPS = 4
EXPERTS_PER_GROUP = N_EXPERTS // N_EXPERT_GROUPS
TOP_K = 2
D_EXPERT = D_MODEL // 2
EXPERT_BLOCK = 128
LN_EPS = 1e-5
DEEPNORM_ALPHA = (2.0 * DEPTH) ** 0.25
DEEPNORM_BETA = (8.0 * DEPTH) ** -0.25

kernel_name = "hybrid_retention_s5_grouped_moe_deepnorm"

F32 = jnp.float32


def _layer_norm(x, g, b):
    xf = x.astype(F32)
    mu = jnp.mean(xf, -1, keepdims=True)
    var = jnp.mean(jnp.square(xf - mu), -1, keepdims=True)
    return ((xf - mu) * lax.rsqrt(var + LN_EPS) * g.astype(F32) + b.astype(F32)).astype(x.dtype)


def _head_norm(o):
    mu = jnp.mean(o, -1, keepdims=True)
    var = jnp.mean(jnp.square(o - mu), -1, keepdims=True)
    return (o - mu) * lax.rsqrt(var + LN_EPS)


def _rotary(t):
    L = t.shape[1]
    inv = 1.0 / (ROPE_BASE ** (jnp.arange(0, RET_HEAD_DIM, 2, dtype=F32) / RET_HEAD_DIM))
    ang = jnp.arange(L, dtype=F32)[:, None] * inv[None, :]
    cos = jnp.cos(ang)[None, :, None, :]
    sin = jnp.sin(ang)[None, :, None, :]
    tf = t.astype(F32)
    t1, t2 = tf[..., 0::2], tf[..., 1::2]
    return jnp.stack([t1 * cos - t2 * sin, t1 * sin + t2 * cos], -1).reshape(tf.shape)


def _retention(q, k, v):
    Bn, L, H, Dh = q.shape
    C = RET_CHUNK
    N = L // C
    log_gamma = jnp.log(1.0 - 2.0 ** (-5.0 - jnp.arange(H, dtype=F32)))
    q = _rotary(q).reshape(Bn, N, C, H, Dh)
    k = (_rotary(k) * (Dh ** -0.5)).reshape(Bn, N, C, H, Dh)
    v = v.astype(F32).reshape(Bn, N, C, H, Dh)
    idx = jnp.arange(C, dtype=F32)
    diff = idx[:, None] - idx[None, :]
    mask = jnp.where(diff >= 0, jnp.exp(log_gamma[:, None, None] * jnp.maximum(diff, 0.0)), 0.0)
    scores = jnp.einsum('bnihd,bnjhd->bnhij', q, k) * mask
    inner = jnp.einsum('bnhij,bnjhd->bnihd', scores, v)
    k_decay = jnp.exp(log_gamma[None, :] * (C - 1.0 - idx)[:, None])
    kv = jnp.einsum('bnjhd,jh,bnjhe->nbhde', k, k_decay, v)
    chunk_decay = jnp.exp(log_gamma * C)[None, :, None, None]

    def step(R, kv_n):
        return chunk_decay * R + kv_n, R

    _, R_prev = lax.scan(step, jnp.zeros((Bn, H, Dh, Dh), F32), kv)
    q_decay = jnp.exp(log_gamma[None, :] * (idx + 1.0)[:, None])
    cross = jnp.einsum('bnihd,ih,nbhde->bnihe', q, q_decay, R_prev)
    return (inner + cross).reshape(Bn, L, H, Dh)


def _s5(u, lam_re, lam_im, b_re, b_im, c_re, c_im, d, log_dt, w_glu):
    Bn, L, _ = u.shape
    uf = u.astype(F32).reshape(Bn, L, SSM_GROUPS, SSM_GROUP)
    lam = lax.complex(lam_re.astype(F32), lam_im.astype(F32))
    dt = jnp.exp(log_dt.astype(F32))[:, None]
    lam_bar = jnp.exp(lam * dt)
    bmat = lax.complex(b_re.astype(F32), b_im.astype(F32))
    b_bar = ((lam_bar - 1.0) / lam)[..., None] * bmat
    bu = jnp.einsum('blgh,gph->blgp', uf.astype(jnp.complex64), b_bar)
    a_seq = jnp.broadcast_to(lam_bar, (L,) + lam_bar.shape)

    def binop(e1, e2):
        a1, b1 = e1
        a2, b2 = e2
        return a1 * a2, a2 * b1 + b2

    def scan_seq(bu_seq):
        return lax.associative_scan(binop, (a_seq, bu_seq))[1]

    h = jax.vmap(scan_seq)(bu)
    cmat = lax.complex(c_re.astype(F32), c_im.astype(F32))
    y = jnp.real(jnp.einsum('blgp,ghp->blgh', h, cmat)) + d.astype(F32) * uf
    y = jax.nn.gelu(y.reshape(Bn, L, SSM_WIDTH))
    return y * jax.nn.sigmoid(y @ w_glu.astype(F32))


def _mixer(x, w_in, w_out, lam_re, lam_im, b_re, b_im, c_re, c_im, d, log_dt, w_glu):
    Bn, L, _ = x.shape
    proj = x @ w_in
    q, k, v, g, u = jnp.split(proj, [RET_WIDTH, 2 * RET_WIDTH, 3 * RET_WIDTH, 4 * RET_WIDTH], axis=-1)
    heads = lambda t: t.reshape(Bn, L, RET_HEADS, RET_HEAD_DIM)
    o = _head_norm(_retention(heads(q), heads(k), heads(v))).reshape(Bn, L, RET_WIDTH)
    ret_out = jax.nn.silu(g.astype(F32)) * o
    ssm_out = _s5(u, lam_re, lam_im, b_re, b_im, c_re, c_im, d, log_dt, w_glu)
    mixed = jnp.concatenate([ret_out, ssm_out], -1).astype(x.dtype)
    return mixed @ w_out


def _moe(x, router_w, router_b, w_gate, w_up, w_down):
    Bn, L, D = x.shape
    T = Bn * L
    xt = x.reshape(T, D)
    logits = (xt @ router_w).astype(F32) + router_b.astype(F32)
    probs = jax.nn.softmax(logits, -1).reshape(T, N_EXPERT_GROUPS, EXPERTS_PER_GROUP)
    top_in_group, _ = lax.top_k(probs, TOP_K)
    group = jnp.argmax(jnp.sum(top_in_group, -1), -1)
    group_probs = jnp.take_along_axis(probs, group[:, None, None], 1)[:, 0]
    vals, local = lax.top_k(group_probs, TOP_K)
    expert = group[:, None] * EXPERTS_PER_GROUP + local
    weight = vals / jnp.sum(vals, -1, keepdims=True)
    A = T * TOP_K
    e_flat = expert.reshape(A)
    tok_flat = jnp.repeat(jnp.arange(T, dtype=jnp.int32), TOP_K)
    w_flat = weight.reshape(A)
    order = jnp.argsort(e_flat, stable=True)
    e_sorted = e_flat[order]
    counts = jnp.bincount(e_flat, length=N_EXPERTS)
    starts = jnp.cumsum(counts) - counts
    padded = (counts + EXPERT_BLOCK - 1) // EXPERT_BLOCK * EXPERT_BLOCK
    padded_end = jnp.cumsum(padded)
    padded_start = padded_end - padded
    dest = padded_start[e_sorted] + (jnp.arange(A) - starts[e_sorted])
    P = (A + EXPERT_BLOCK - 1) // EXPERT_BLOCK * EXPERT_BLOCK + N_EXPERTS * EXPERT_BLOCK
    n_blocks = P // EXPERT_BLOCK
    row_tok = jnp.full((P,), T, jnp.int32).at[dest].set(tok_flat[order])
    row_w = jnp.zeros((P,), F32).at[dest].set(w_flat[order])
    block_start = jnp.arange(n_blocks) * EXPERT_BLOCK
    block_expert = jnp.minimum(jnp.sum(block_start[:, None] >= padded_end[None, :], -1), N_EXPERTS - 1)
    x_pad = jnp.concatenate([xt, jnp.zeros((1, D), xt.dtype)], 0)
    xb = x_pad[row_tok].reshape(n_blocks, EXPERT_BLOCK, D)

    def expert_block(args):
        xblk, e = args
        hblk = jax.nn.silu(xblk @ w_gate[e]) * (xblk @ w_up[e])
        return hblk @ w_down[e]

    yb = lax.map(expert_block, (xb, block_expert)).reshape(P, D)
    out = jnp.zeros((T + 1, D), F32).at[row_tok].add(yb.astype(F32) * row_w[:, None])
    return out[:T].astype(x.dtype).reshape(Bn, L, D)


def setup_inputs(seed: int = 0) -> dict:
    key = jax.random.key(seed)
    ks = jax.random.split(key, 24)
    nrm = lambda k, shape, s: jax.random.normal(k, shape, F32) * s
    x = nrm(ks[0], (BATCH, SEQ, D_MODEL), 1.0)
    w_in = nrm(ks[1], (DEPTH, D_MODEL, IN_PROJ_WIDTH), D_MODEL ** -0.5)
    w_out = nrm(ks[2], (DEPTH, MIX_WIDTH, D_MODEL), MIX_WIDTH ** -0.5 * DEEPNORM_BETA)
    n = jnp.arange(SSM_STATE, dtype=F32)
    ssm_lambda_re = -0.5 + nrm(ks[3], (DEPTH, SSM_GROUPS, SSM_STATE), 0.01)
    ssm_lambda_im = math.pi * n[None, None, :] + nrm(ks[4], (DEPTH, SSM_GROUPS, SSM_STATE), 0.01)
    bs = (2.0 * SSM_GROUP) ** -0.5
    ssm_b_re = nrm(ks[5], (DEPTH, SSM_GROUPS, SSM_STATE, SSM_GROUP), bs)
    ssm_b_im = nrm(ks[6], (DEPTH, SSM_GROUPS, SSM_STATE, SSM_GROUP), bs)
    cs = (2.0 * SSM_STATE) ** -0.5
    ssm_c_re = nrm(ks[7], (DEPTH, SSM_GROUPS, SSM_GROUP, SSM_STATE), cs)
    ssm_c_im = nrm(ks[8], (DEPTH, SSM_GROUPS, SSM_GROUP, SSM_STATE), cs)
    ssm_d = nrm(ks[9], (DEPTH, SSM_GROUPS, SSM_GROUP), 1.0)
    ssm_log_dt = jax.random.uniform(ks[10], (DEPTH, SSM_GROUPS), F32, math.log(DT_MIN), math.log(DT_MAX))
    w_glu = nrm(ks[11], (DEPTH, SSM_WIDTH, SSM_WIDTH), SSM_WIDTH ** -0.5)
    ln1_g = 1.0 + nrm(ks[12], (DEPTH, D_MODEL), 0.02)
    ln1_b = nrm(ks[13], (DEPTH, D_MODEL), 0.02)
    ln2_g = 1.0 + nrm(ks[14], (DEPTH, D_MODEL), 0.02)
    ln2_b = nrm(ks[15], (DEPTH, D_MODEL), 0.02)
    router_w = nrm(ks[16], (D_MODEL, N_EXPERTS), D_MODEL ** -0.5)
    router_b = nrm(ks[17], (N_EXPERTS,), 0.01)
    w_gate = nrm(ks[18], (DEPTH, N_EXPERTS, D_MODEL, D_EXPERT), D_MODEL ** -0.5)
    w_up = nrm(ks[19], (DEPTH, N_EXPERTS, D_MODEL, D_EXPERT), D_MODEL ** -0.5)
    w_down = nrm(ks[20], (DEPTH, N_EXPERTS, D_EXPERT, D_MODEL), D_EXPERT ** -0.5 * DEEPNORM_BETA)
    return {"x": x, "w_in": w_in, "w_out": w_out,
            "ssm_lambda_re": ssm_lambda_re, "ssm_lambda_im": ssm_lambda_im,
            "ssm_b_re": ssm_b_re, "ssm_b_im": ssm_b_im,
            "ssm_c_re": ssm_c_re, "ssm_c_im": ssm_c_im,
            "ssm_d": ssm_d, "ssm_log_dt": ssm_log_dt, "w_glu": w_glu,
            "ln1_g": ln1_g, "ln1_b": ln1_b, "ln2_g": ln2_g, "ln2_b": ln2_b,
            "router_w": router_w, "router_b": router_b,
            "w_gate": w_gate, "w_up": w_up, "w_down": w_down}


def reference(x, w_in, w_out, ssm_lambda_re, ssm_lambda_im, ssm_b_re, ssm_b_im,
              ssm_c_re, ssm_c_im, ssm_d, ssm_log_dt, w_glu,
              ln1_g, ln1_b, ln2_g, ln2_b, router_w, router_b,
              w_gate, w_up, w_down):
    for l in range(DEPTH):
        h = _mixer(x, w_in[l], w_out[l], ssm_lambda_re[l], ssm_lambda_im[l],
                   ssm_b_re[l], ssm_b_im[l], ssm_c_re[l], ssm_c_im[l],
                   ssm_d[l], ssm_log_dt[l], w_glu[l])
        x = _layer_norm(DEEPNORM_ALPHA * x + h, ln1_g[l], ln1_b[l])
        h = _moe(x, router_w, router_b, w_gate[l], w_up[l], w_down[l])
        x = _layer_norm(DEEPNORM_ALPHA * x + h, ln2_g[l], ln2_b[l])
    return x
```

```cpp
#include <hip/hip_runtime.h>
#include <cstdio>
#include <cstdint>

#ifndef PG8_ALIGN_EPI
#define PG8_ALIGN_EPI 1
#endif
#ifndef PROBE_EPI
#define PROBE_EPI 0
#endif
#ifndef MK_N_LAUNCHES
#define MK_N_LAUNCHES 1
#endif

#define LAS __attribute__((address_space(3)))
#define GAS __attribute__((address_space(1)))
typedef unsigned short bf16;
typedef short bf16x8 __attribute__((ext_vector_type(8)));
typedef float f32x4 __attribute__((ext_vector_type(4)));
typedef float f32x2 __attribute__((ext_vector_type(2)));
typedef unsigned u32x4 __attribute__((ext_vector_type(4)));
typedef unsigned u32x2 __attribute__((ext_vector_type(2)));
typedef int i32x4 __attribute__((ext_vector_type(4)));
typedef int i32x8 __attribute__((ext_vector_type(8)));

constexpr int BATCH = 8, SEQ = 2048, DM = 2048, T = BATCH * SEQ;
constexpr int RW = 1024, HD = 256, NPROJ = 5120;
constexpr int NE = 32, DE = 1024;
constexpr int SGRP = 64, SCH = 16, SST = 64, CS = 16, NCHUNK = SEQ / CS;
constexpr int KS5 = 384;
constexpr float LN_EPS = 1e-5f;
constexpr float ALPHA = 1.41421356237309515f;
constexpr int NPH = 19;

constexpr size_t MiB = 1u << 20;
constexpr size_t WS_CTL = 0, CTL_ZERO_BYTES = 128 * 1024;
constexpr size_t WS_WIN = 1 * MiB;
constexpr size_t WS_WOUT = WS_WIN + 40 * MiB;
constexpr size_t WS_WGLU = WS_WOUT + 16 * MiB;
constexpr size_t WS_WGU = WS_WGLU + 4 * MiB;
constexpr size_t WS_WDN = WS_WGU + 512 * MiB;
constexpr size_t WS_S5OUT = WS_WDN + 256 * MiB;
constexpr size_t WS_S5IN = WS_S5OUT + 24 * MiB;
constexpr size_t WS_S5A = WS_S5IN + 8 * MiB;
constexpr size_t WS_COS = WS_S5A + 1 * MiB;
constexpr size_t WS_SIN = WS_COS + 1 * MiB;
constexpr size_t WS_RWT = WS_SIN + 1 * MiB;
constexpr size_t WS_XB = WS_RWT + 1 * MiB;
constexpr size_t WS_XF = WS_XB + 64 * MiB;
constexpr size_t WS_Y8 = WS_XF + 32 * MiB;
constexpr size_t WS_MIX8 = WS_XF + 64 * MiB;
constexpr size_t WS_XB8 = WS_XF + 96 * MiB;
constexpr size_t WS_Q = WS_XF + 128 * MiB;
constexpr size_t WS_K = WS_Q + 32 * MiB;
constexpr size_t WS_G = WS_K + 32 * MiB;
constexpr size_t WS_VT = WS_G + 32 * MiB;
constexpr size_t WS_U2 = WS_VT + 32 * MiB;
constexpr size_t WS_Y = WS_U2 + 48 * MiB;
constexpr size_t WS_MIX = WS_Y + 32 * MiB;
constexpr size_t WS_Z = WS_MIX + 64 * MiB;
constexpr size_t WS_X1B = WS_Z + 128 * MiB;
constexpr size_t WS_LIST = WS_X1B + 64 * MiB;
constexpr size_t WS_TOK = WS_LIST + 2 * MiB;
constexpr size_t WS_H = WS_TOK + 1 * MiB;
constexpr size_t WS_YB = WS_H + 80 * MiB;
constexpr size_t WS_END = WS_YB + 160 * MiB;
constexpr int CW_BAR = 4096;
constexpr int CW_CNT = 16384;

constexpr int RING_BYTES = 131072;
constexpr int TAB_OFF = 150528;
constexpr int TST_OFF = TAB_OFF + 8192;
constexpr int MISC_OFF = TST_OFF + 1024;
constexpr int LDS_BYTES = 160768;
static_assert(MISC_OFF + 64 <= LDS_BYTES && LDS_BYTES <= 163840, "LDS map");
constexpr int NWAVES = 8;

__device__ __forceinline__ unsigned cvt_pk_bf16(float lo, float hi) { unsigned r; asm volatile("v_cvt_pk_bf16_f32 %0, %1, %2" : "=v"(r) : "v"(lo), "v"(hi)); return r; }
__device__ __forceinline__ float bflo(unsigned w) { return __uint_as_float(w << 16); }
__device__ __forceinline__ float bfhi(unsigned w) { return __uint_as_float(w & 0xffff0000u); }
__device__ __forceinline__ float sigmoid_f(float x) { return __builtin_amdgcn_rcpf(1.0f + __builtin_amdgcn_exp2f(-1.44269504089f * x)); }
__device__ __forceinline__ float silu_f(float x) { return x * sigmoid_f(x); }
__device__ __forceinline__ float gelu_tanh_f(float x) { return x * sigmoid_f(1.59576912161f * (x + 0.044715f * x * x * x)); }
__device__ __forceinline__ unsigned cvt4_fp8(float a, float b, float c, float d) { int w = __builtin_amdgcn_cvt_pk_fp8_f32(a, b, 0, false); w = __builtin_amdgcn_cvt_pk_fp8_f32(c, d, w, true); return (unsigned)w; }
constexpr float W8_SCALE = 64.0f, W8_INV = 1.0f / 64.0f;
__device__ __forceinline__ float wave_sum(float v) {
#pragma unroll
    for (int o = 1; o < 64; o <<= 1) v += __shfl_xor(v, o);
    return v;
}
#define VM_WAIT() asm volatile("s_waitcnt vmcnt(0)" ::: "memory")
#define LDS_WAIT() asm volatile("s_waitcnt lgkmcnt(0)" ::: "memory")

namespace pg8 {
constexpr int BM = 256, BK = 64, HALF = 128, HTB = HALF * BK * 2, STAGE_BYTES = 8 * HTB, NXCD = 8, WGM = 8;
__host__ __device__ __forceinline__ int lds_byte(int r, int c) { const int st = (r >> 4) * 2 + (c >> 5), rr = r & 15, cc = c & 31, ob = rr * 64 + cc * 2; return st * 1024 + (ob ^ (((ob >> 9) & 1) << 5)); }
__host__ __device__ __forceinline__ void stage_rc(int b, int& R, int& C) { const int st = b / 1024, sb = b % 1024, swz = sb ^ (((sb >> 9) & 1) << 5); R = (st >> 1) * 16 + swz / 64; C = (st & 1) * 32 + (swz % 64) / 2; }
__host__ __device__ __forceinline__ int perm32(int rho) { const int n = rho >> 4, i = rho & 15; return 8 * (i >> 2) + 4 * n + (i & 3); }

struct Unit { int pm, pn, e, li; };
__device__ __forceinline__ void glds16s(const char* sbase, unsigned voff, unsigned lds_dst) { unsigned keep;
    asm volatile("s_mov_b32 %0, m0\n\ts_mov_b32 m0, %3\n\ts_nop 2\n\tglobal_load_lds_dwordx4 %1, %2\n\ts_mov_b32 m0, %0" : "=&s"(keep) : "v"(voff), "s"(sbase), "s"(lds_dst) : "memory"); }

struct NoHook { static constexpr bool ON = false; __device__ __forceinline__ void operator()(int) const {} };
template <bool FP8, class Epi, class Sched, class Hook = NoHook>
__device__ __forceinline__ void gemm_phase(LAS unsigned char* lds, const int tid, const char* Abase, const int Kc, const Sched& S, const Epi& E, const Hook& H = Hook()) {
    int K = Kc; asm volatile("" : "+s"(K));
    const int wid = __builtin_amdgcn_readfirstlane(tid >> 6), lane = tid & 63, wr = wid >> 2, wc = wid & 3, fr = lane & 15, fq = lane >> 4;
    const int nt = FP8 ? K / 128 : K / BK;
    int R0, C0; stage_rc(tid * 16, R0, C0);
    const int Rb0 = Epi::PERM ? ((R0 & ~31) + perm32(R0 & 31)) : R0;
    const unsigned Cb0 = (unsigned)C0 * 2u;
    const unsigned voffB0 = FP8 ? (unsigned)(Rb0 * K) + Cb0 : (unsigned)(Rb0 * K) * 2u + Cb0;
    const size_t bstep64 = (size_t)64 * K * (FP8 ? 1 : 2);
    const size_t hstepB = 2 * bstep64;
    const unsigned ldsw = (unsigned)wid * 1024u; const unsigned ldsb = (unsigned)(size_t)lds + ldsw;
    const int aoff = lds_byte(wr * 64 + fr, fq * 8), boff = lds_byte(wc * 32 + fr, fq * 8);
    struct AOff { unsigned o0, o1, o2, o3; };
    const unsigned rb64 = Sched::GATHER ? 0u : S.rowstep() * 64u;
#define PG8_LOAD_AO(AO, U, rr) do { if constexpr (Sched::GATHER) { AO.o0 = S.rowoff(U, (rr)) + Cb0; AO.o1 = S.rowoff(U, (rr) + 64) + Cb0; AO.o2 = S.rowoff(U, (rr) + 128) + Cb0; AO.o3 = S.rowoff(U, (rr) + 192) + Cb0; } \
        else { AO.o0 = S.rowoff(U, (rr)) + Cb0; AO.o1 = 0u; AO.o2 = 0u; AO.o3 = 0u; } } while (0)
#define PG8_SA(b, h) (((b) * 2 + (h)) * HTB)
#define PG8_SB(b, h) ((4 + (b) * 2 + (h)) * HTB)
#define PG8_STAGE_B(bufoff, gbase) do { const char* gb_ = (const char*)(gbase); \
        glds16s(gb_, voffB0, ldsb + (unsigned)(bufoff)); glds16s(gb_ + bstep64, voffB0, ldsb + (unsigned)(bufoff) + 8192u); } while (0)
#define PG8_STAGE_A(bufoff, AO, h, kb) do { \
        if constexpr (Sched::GATHER) { const char* ab_ = Abase + (size_t)(kb); \
            glds16s(ab_, (h) ? AO.o2 : AO.o0, ldsb + (unsigned)(bufoff)); glds16s(ab_, (h) ? AO.o3 : AO.o1, ldsb + (unsigned)(bufoff) + 8192u); \
        } else { const char* ab_ = Abase + (size_t)(kb) + (size_t)((h) * 2) * rb64; \
            glds16s(ab_, AO.o0, ldsb + (unsigned)(bufoff)); glds16s(ab_ + rb64, AO.o0, ldsb + (unsigned)(bufoff) + 8192u); } } while (0)
#define PG8_LDA(dst, b, h) do { _Pragma("unroll") for (int m = 0; m < 4; ++m) _Pragma("unroll") for (int k = 0; k < 2; ++k) dst[m][k] = *(const LAS bf16x8*)(lds + PG8_SA(b, h) + aoff + m * 2048 + k * 1024); } while (0)
#define PG8_LDB(dst, b, h) do { _Pragma("unroll") for (int n = 0; n < 2; ++n) _Pragma("unroll") for (int k = 0; k < 2; ++k) dst[n][k] = *(const LAS bf16x8*)(lds + PG8_SB(b, h) + boff + n * 2048 + k * 1024); } while (0)
#define PG8_MMA(ai, bj, At, Bt) do { __builtin_amdgcn_s_setprio(1); _Pragma("unroll") for (int m = 0; m < 4; ++m) _Pragma("unroll") for (int n = 0; n < 2; ++n) { \
        if constexpr (FP8) { \
            const i32x8 bq_ = __builtin_shufflevector(__builtin_bit_cast(i32x4, Bt[n][0]), __builtin_bit_cast(i32x4, Bt[n][1]), 0, 1, 2, 3, 4, 5, 6, 7); \
            const i32x8 aq_ = __builtin_shufflevector(__builtin_bit_cast(i32x4, At[m][0]), __builtin_bit_cast(i32x4, At[m][1]), 0, 1, 2, 3, 4, 5, 6, 7); \
            asm volatile("s_nop 1\n\tv_mfma_f32_16x16x128_f8f6f4 %0, %1, %2, %0" : "+v"(acc[ai][bj][m][n]) : "v"(bq_), "v"(aq_));   \
        } else { _Pragma("unroll") for (int k = 0; k < 2; ++k) \
            acc[ai][bj][m][n] = __builtin_amdgcn_mfma_f32_16x16x32_bf16(Bt[n][k], At[m][k], acc[ai][bj][m][n], 0, 0, 0); } } \
        __builtin_amdgcn_s_setprio(0); } while (0)
#define PG8_WAIT_V(n) asm volatile("s_waitcnt vmcnt(" #n ")" ::: "memory")
#define PG8_WAIT_VN(n) asm volatile("s_waitcnt vmcnt(%0)" :: "n"(n) : "memory")
#define PG8_WAIT_V8F() do { if (fa) PG8_WAIT_VN(8 + Epi::NST); else PG8_WAIT_V(8); } while (0)
#define PG8_WAIT_V6F() do { if (fa) PG8_WAIT_VN(6 + Epi::NST); else PG8_WAIT_V(6); } while (0)
#define PG8_WAIT_L(n) asm volatile("s_waitcnt lgkmcnt(" #n ")" ::: "memory")
#define PG8_BAR __builtin_amdgcn_s_barrier()
#define PG8_SCHED __builtin_amdgcn_sched_barrier(0)
    Unit cur, nxt; int ui = 0;
    if (!S.next(0, cur)) return;
    f32x4 acc[2][2][4][2];
#pragma unroll
    for (int a = 0; a < 2; ++a)
#pragma unroll
        for (int b = 0; b < 2; ++b)
#pragma unroll
            for (int m = 0; m < 4; ++m)
#pragma unroll
                for (int n = 0; n < 2; ++n) acc[a][b][m][n] = (f32x4){0.f, 0.f, 0.f, 0.f};
    bf16x8 At[4][2], B0[2][2], B1[2][2];
    AOff oc; PG8_LOAD_AO(oc, cur, R0);
    const char* cB = S.bbase(cur);
    PG8_STAGE_B(PG8_SB(0, 0), cB); PG8_STAGE_B(PG8_SB(0, 1), cB + hstepB); PG8_STAGE_A(PG8_SA(0, 0), oc, 0, 0u); PG8_STAGE_A(PG8_SA(0, 1), oc, 1, 0u);
    if (wr == 1) PG8_BAR;
    PG8_WAIT_V(2); PG8_BAR;
    PG8_STAGE_B(PG8_SB(1, 0), cB + 128); PG8_STAGE_A(PG8_SA(1, 0), oc, 0, 128u); PG8_STAGE_B(PG8_SB(1, 1), cB + hstepB + 128);
    PG8_WAIT_V(6); PG8_BAR;
    for (;;) {
        const bool has_next = S.next(ui + 1, nxt);
        const char* nB = has_next ? S.bbase(nxt) : cB;
        const bool hcur = Sched::HALFABLE ? S.half(cur) : false;
        for (int t = 0; t < nt; t += 2) {
            const bool last = (t == nt - 2);
            const unsigned kb1 = (unsigned)(t + 1) * 128u, kb2 = last ? 0u : (unsigned)(t + 2) * 128u, kb3 = kb2 + 128u;
            AOff pn = oc;
            if (last && has_next) { int t_ = (int)__builtin_amdgcn_mbcnt_hi(~0u, __builtin_amdgcn_mbcnt_lo(~0u, 0u)); asm volatile("" : "+v"(t_));
                int r0_, c0_; stage_rc((wid * 64 + t_) * 16, r0_, c0_); const unsigned Cb0 = (unsigned)c0_ * 2u; PG8_LOAD_AO(pn, nxt, r0_); }
            const char* b2 = last ? nB : cB + (size_t)(t + 2) * 128; const char* b3 = b2 + 128;
            const bool fa = FP8 && (t == 0) && (ui > 0);
            PG8_LDB(B0, 0, 0); PG8_LDB(B1, 0, 1); PG8_SCHED; PG8_LDA(At, 0, 0); if (!fa) PG8_STAGE_A(PG8_SA(1, 1), oc, 1, kb1);
            PG8_WAIT_V8F(); PG8_WAIT_L(0); PG8_BAR; PG8_MMA(0, 0, At, B0); PG8_MMA(0, 1, At, B1); PG8_BAR; PG8_SCHED;
            if (!hcur) PG8_LDA(At, 0, 1); PG8_STAGE_B(PG8_SB(0, 0), b2); PG8_STAGE_B(PG8_SB(0, 1), b2 + hstepB);
            PG8_WAIT_V6F(); PG8_WAIT_L(0); PG8_BAR; if (!hcur) PG8_MMA(1, 0, At, B0); PG8_STAGE_A(PG8_SA(0, 0), pn, 0, kb2); if (!hcur) PG8_MMA(1, 1, At, B1); PG8_BAR; PG8_SCHED;
            PG8_LDB(B0, 1, 0); PG8_LDB(B1, 1, 1); PG8_SCHED; PG8_LDA(At, 1, 0); PG8_STAGE_A(PG8_SA(0, 1), pn, 1, kb2);
            PG8_WAIT_V8F(); PG8_WAIT_L(0); PG8_BAR; PG8_MMA(0, 0, At, B0); PG8_MMA(0, 1, At, B1); PG8_BAR; PG8_SCHED;
            if (!hcur) PG8_LDA(At, 1, 1); PG8_STAGE_B(PG8_SB(1, 0), b3); PG8_STAGE_B(PG8_SB(1, 1), b3 + hstepB);
            PG8_WAIT_V(6); PG8_WAIT_L(0); PG8_BAR; if (!hcur) PG8_MMA(1, 0, At, B0); PG8_STAGE_A(PG8_SA(1, 0), pn, 0, kb3); if (!hcur) PG8_MMA(1, 1, At, B1); PG8_BAR; PG8_SCHED;
            if (FP8 && last && has_next) PG8_STAGE_A(PG8_SA(1, 1), pn, 1, 128u);
        }
        if constexpr (FP8) { asm volatile("s_nop 15\n\ts_nop 15" ::: "memory"); }
        if (PG8_ALIGN_EPI) { if (wr == 0) PG8_BAR; }
        { int l_ = (int)__builtin_amdgcn_mbcnt_hi(~0u, __builtin_amdgcn_mbcnt_lo(~0u, 0u)); asm volatile("" : "+v"(l_));
          E(acc, cur, wr, wc, l_ & 15, l_ >> 4);
          if (PROBE_EPI) { asm volatile("" ::: "memory"); E(acc, cur, wr, wc, l_ & 15, l_ >> 4); } }
        if (!has_next) break;
        if constexpr (Hook::ON) { if (H.wants(ui)) { H(ui); asm volatile("s_waitcnt vmcnt(0)" ::: "memory"); } }
#pragma unroll
        for (int a = 0; a < 2; ++a)
#pragma unroll
            for (int b = 0; b < 2; ++b)
#pragma unroll
                for (int m = 0; m < 4; ++m)
#pragma unroll
                    for (int n = 0; n < 2; ++n) acc[a][b][m][n] = (f32x4){0.f, 0.f, 0.f, 0.f};
        cur = nxt; cB = nB; ++ui;
        { int t_ = (int)__builtin_amdgcn_mbcnt_hi(~0u, __builtin_amdgcn_mbcnt_lo(~0u, 0u)); asm volatile("" : "+v"(t_));
          int r0_, c0_; stage_rc((wid * 64 + t_) * 16, r0_, c0_); const unsigned Cb0 = (unsigned)c0_ * 2u; PG8_LOAD_AO(oc, cur, r0_); }
        if (PG8_ALIGN_EPI) { if (wr == 1) PG8_BAR; }
    }
    PG8_WAIT_V(0);
    if (!PG8_ALIGN_EPI) { if (wr == 0) PG8_BAR; }
    PG8_BAR;
#undef PG8_SA
#undef PG8_SB
#undef PG8_STAGE_A
#undef PG8_LOAD_AO
#undef PG8_STAGE_B
#undef PG8_LDA
#undef PG8_LDB
#undef PG8_MMA
#undef PG8_WAIT_V
#undef PG8_WAIT_VN
#undef PG8_WAIT_V8F
#undef PG8_WAIT_V6F
#undef PG8_WAIT_V6F
#undef PG8_WAIT_L
#undef PG8_BAR
#undef PG8_SCHED
}

struct DenseOrder {
    static constexpr bool GATHER = false, HALFABLE = false;
    __device__ __forceinline__ bool half(const Unit&) const { return false; }
    int nM, nN, nwg, G, c; unsigned rowbytes; const char* Bt; size_t tstepB;
    __device__ __forceinline__ unsigned rowstep() const { return rowbytes; }
    __device__ __forceinline__ void init(int M, int N, int K, int G_, int c_, const void* Bt_, int eb = 2) { nM = M / BM; nN = N / BM; nwg = nM * nN; G = G_; c = c_; rowbytes = (unsigned)(K * eb); Bt = (const char*)Bt_; tstepB = (size_t)BM * K * eb; }
    const LAS int* ulist;
    __device__ __forceinline__ bool next(int i, Unit& u) const { if (i >= 8) return false; const i32x4 v = *(const LAS i32x4*)(ulist + 4 * i); u.pm = v[0]; u.pn = v[1]; u.e = v[2]; u.li = i; return v[3] != 0; }
    __device__ __forceinline__ bool find(int i, Unit& u) const {
        const long L = (long)i * G + c; if (L >= nwg) return false;
        int wgid = (int)L; { const int q = nwg / NXCD, r = nwg % NXCD, xcd = wgid % NXCD, off = wgid / NXCD; wgid = (xcd < r ? xcd * (q + 1) : r * (q + 1) + (xcd - r) * q) + off; }
        const int nig = WGM * nN, gid = wgid / nig, fm = gid * WGM, gsz = (nM - fm) < WGM ? (nM - fm) : WGM;
        u.pm = fm + ((wgid % nig) % gsz); u.pn = (wgid % nig) / gsz; u.e = 0; u.li = i; return true;
    }
    __device__ __forceinline__ unsigned rowoff(const Unit& u, int r) const { return (unsigned)(u.pm * BM + r) * rowbytes; }
    __device__ __forceinline__ const char* bbase(const Unit& u) const { return Bt + (size_t)u.pn * tstepB; }
};
struct S5Order {
    static constexpr bool GATHER = false, HALFABLE = false;
    __device__ __forceinline__ bool half(const Unit&) const { return false; }
    int G, c; const char* Bt;
    __device__ __forceinline__ unsigned rowstep() const { return (unsigned)(KS5 * 2); }
    const LAS int* ulist;
    __device__ __forceinline__ bool next(int i, Unit& u) const { if (i >= 8) return false; const i32x4 v = *(const LAS i32x4*)(ulist + 4 * i); u.pm = v[0]; u.pn = v[1]; u.e = v[2]; u.li = i; return v[3] != 0; }
    __device__ __forceinline__ bool find(int i, Unit& u) const { const int L = i * G + c; if (L >= 256) return false; u.pm = L; u.pn = L >> 2; u.e = 0; u.li = i; return true; }
    __device__ __forceinline__ unsigned rowoff(const Unit& u, int r) const { return (unsigned)(u.pm * BM + r) * (unsigned)(KS5 * 2); }
    __device__ __forceinline__ const char* bbase(const Unit& u) const { return Bt + (size_t)u.pn * (size_t)(BM * KS5 * 2); }
};
template <bool GATHER_> struct MoeOrder {
    static constexpr bool GATHER = GATHER_, HALFABLE = true;
    int NF, NU, G, c; const LAS int* pst; const LAS int* fst; const LAS int* hst; const LAS unsigned* table; const char* Bt; size_t estepB, tstepB; unsigned rowbytes;
    __device__ __forceinline__ unsigned rowstep() const { return rowbytes; }
    const LAS int* ulist;
    __device__ __forceinline__ bool find(int i, Unit& u) const {
        const int L = i * G + c; if (L >= NU) return false;
        int e = 0;
        if (L < NF) { const int rt = L >> 3; while (e < NE - 1 && fst[e + 1] <= rt) ++e; u.pm = (pst[e] + 2 * (rt - fst[e])) * 128; u.e = e; }
        else { const int hh = (L - NF) >> 3; while (e < NE - 1 && hst[e + 1] <= hh) ++e; u.pm = (pst[e + 1] - 1) * 128; u.e = e | 256; }
        u.pn = L & 7; u.li = i; return true;
    }
    int ibeg = 0, iend = 8;
    __device__ __forceinline__ bool next(int i, Unit& u) const {
        const int j = ibeg + i; if (j >= iend) return false;
        const i32x4 v = *(const LAS i32x4*)(ulist + 4 * j);
        u.pm = v[0]; u.pn = v[1]; u.e = v[2]; u.li = j; return v[3] != 0;
    }
    __device__ __forceinline__ bool half(const Unit& u) const { return (u.e & 256) != 0; }
    __device__ __forceinline__ unsigned rowoff(const Unit& u, int r) const { if constexpr (GATHER_) return table[u.li * 256 + r]; else return (unsigned)(u.pm + r) * rowbytes; }
    __device__ __forceinline__ const char* bbase(const Unit& u) const { return Bt + (size_t)(u.e & 255) * estepB + (size_t)u.pn * tstepB; }
};

template <class MO> __device__ __forceinline__ void moe_units(const MO& S, LAS int* ulist, int tid) {
    if (tid < 8) { Unit u; u.pm = 0; u.pn = 0; u.e = 0; u.li = tid; const bool ok = S.find(tid, u); *(LAS i32x4*)(ulist + 4 * tid) = (i32x4){u.pm, u.pn, u.e, ok ? 1 : 0}; }
}

struct EpiInProj {
    static constexpr int NST = 16;
    static constexpr bool PERM = true;
    bf16 *Q, *Kk, *Gs, *U2; const float *cosT, *sinT;
    __device__ __forceinline__ void operator()(const f32x4 (&acc)[2][2][4][2], const Unit& u, int wr, int wc, int fr, int fq) const {
        const int seg = u.pn >> 2;
        const int colseg = (u.pn & 3) * 256 + wc * 32 + 8 * fq;
        const int hd_ = u.pn & 3;
        const float lgam = hd_ == 0 ? -0.045803689613f : hd_ == 1 ? -0.022720076500f : hd_ == 2 ? -0.011315313227f : -0.005646563141f;
        if (seg <= 1) {
            bf16* const O = (seg == 0) ? Q : Kk;
            float frq[2][4];
#pragma unroll
            for (int bj = 0; bj < 2; ++bj) { const int i0 = ((colseg + bj * HALF) & (HD - 1)) >> 1;
#pragma unroll
                for (int j = 0; j < 4; ++j) frq[bj][j] = __builtin_amdgcn_exp2f(-0.10381025296523f * (float)(i0 + j)) * 0.15915494309189535f; }
#pragma unroll
            for (int ai = 0; ai < 2; ++ai) {
#pragma unroll
                for (int m = 0; m < 4; ++m) { const int row = u.pm * BM + ai * HALF + wr * 64 + m * 16 + fr; const int tpos = row & (SEQ - 1); const float tf = (float)tpos;
                    const float fdec = (seg == 0) ? W8_INV * __builtin_amdgcn_exp2f(lgam * tf) : (W8_INV * 0.0625f) * __builtin_amdgcn_exp2f(-lgam * tf);
#pragma unroll
                    for (int bj = 0; bj < 2; ++bj) { const int col = colseg + bj * HALF; const f32x4 v0 = acc[ai][bj][m][0] * fdec, v1 = acc[ai][bj][m][1] * fdec; f32x4 c, sn;
#pragma unroll
                        for (int j = 0; j < 4; ++j) { const float x = __builtin_amdgcn_fractf(tf * frq[bj][j]); c[j] = __builtin_amdgcn_cosf(x); sn[j] = __builtin_amdgcn_sinf(x); }
                        u32x4 w; w.x = cvt_pk_bf16(v0[0] * c[0] - v0[1] * sn[0], v0[0] * sn[0] + v0[1] * c[0]); w.y = cvt_pk_bf16(v0[2] * c[1] - v0[3] * sn[1], v0[2] * sn[1] + v0[3] * c[1]);
                        w.z = cvt_pk_bf16(v1[0] * c[2] - v1[1] * sn[2], v1[0] * sn[2] + v1[1] * c[2]); w.w = cvt_pk_bf16(v1[2] * c[3] - v1[3] * sn[3], v1[2] * sn[3] + v1[3] * c[3]);
                        *(u32x4*)(O + (size_t)row * RW + col) = w; } }
            }
        } else {
#pragma unroll
            for (int ai = 0; ai < 2; ++ai)
#pragma unroll
                for (int m = 0; m < 4; ++m) {
                    const int row = u.pm * BM + ai * HALF + wr * 64 + m * 16 + fr; const int tpos = row & (SEQ - 1);
#pragma unroll
                    for (int bj = 0; bj < 2; ++bj) {
                        const int col = colseg + bj * HALF; const f32x4 v0 = acc[ai][bj][m][0] * W8_INV, v1 = acc[ai][bj][m][1] * W8_INV;
                        if (seg == 2) {
                            u32x4 w; w.x = cvt_pk_bf16(silu_f(v0[0]), silu_f(v0[1])); w.y = cvt_pk_bf16(silu_f(v0[2]), silu_f(v0[3])); w.z = cvt_pk_bf16(silu_f(v1[0]), silu_f(v1[1])); w.w = cvt_pk_bf16(silu_f(v1[2]), silu_f(v1[3]));
                            *(u32x4*)(Gs + (size_t)row * RW + col) = w;
                        } else {
                            const int gidx = col >> 4, ch0 = col & 15, b = row >> 11, c = tpos >> 4, tt = tpos & 15;
                            u32x4 w; w.x = cvt_pk_bf16(v0[0], v0[1]); w.y = cvt_pk_bf16(v0[2], v0[3]); w.z = cvt_pk_bf16(v1[0], v1[1]); w.w = cvt_pk_bf16(v1[2], v1[3]);
                            *(u32x4*)(U2 + (size_t)(gidx * 1024 + b * 128 + c) * KS5 + tt * 16 + ch0) = w;
                        }
                    }
                }
        }
    }
};
struct EpiBf16 {
    static constexpr int NST = 16;
    static constexpr bool PERM = true;
    bf16* O; int ldc; float sc;
    __device__ __forceinline__ void operator()(const f32x4 (&acc)[2][2][4][2], const Unit& u, int wr, int wc, int fr, int fq) const {
        const int row0 = u.pm * BM + wr * 64 + fr, col0 = u.pn * BM + wc * 32 + 8 * fq;
#pragma unroll
        for (int ai = 0; ai < 2; ++ai)
#pragma unroll
            for (int m = 0; m < 4; ++m) { bf16* rowp = O + (size_t)(row0 + ai * HALF + m * 16) * ldc + col0;
#pragma unroll
                for (int bj = 0; bj < 2; ++bj) { const f32x4 v0 = acc[ai][bj][m][0] * sc, v1 = acc[ai][bj][m][1] * sc;
                    u32x4 w; w.x = cvt_pk_bf16(v0[0], v0[1]); w.y = cvt_pk_bf16(v0[2], v0[3]); w.z = cvt_pk_bf16(v1[0], v1[1]); w.w = cvt_pk_bf16(v1[2], v1[3]);
                    *(u32x4*)(rowp + bj * HALF) = w; } }
    }
};
struct EpiF8 {
    static constexpr int NST = 8;
    static constexpr bool PERM = true;
    unsigned char* O; int ldc; float sc;
    __device__ __forceinline__ void operator()(const f32x4 (&acc)[2][2][4][2], const Unit& u, int wr, int wc, int fr, int fq) const {
        const int row0 = u.pm + wr * 64 + fr, col0 = u.pn * BM + wc * 32 + 8 * fq; const int nai = (u.e & 256) ? 1 : 2;
#pragma unroll
        for (int ai = 0; ai < 2; ++ai) if (ai < nai)
#pragma unroll
            for (int m = 0; m < 4; ++m) { unsigned char* rowp = O + (size_t)(row0 + ai * HALF + m * 16) * ldc + col0;
#pragma unroll
                for (int bj = 0; bj < 2; ++bj) { const f32x4 v0 = acc[ai][bj][m][0] * sc, v1 = acc[ai][bj][m][1] * sc;
                    u32x2 w; w.x = cvt4_fp8(v0[0], v0[1], v0[2], v0[3]); w.y = cvt4_fp8(v1[0], v1[1], v1[2], v1[3]);
                    *(u32x2*)(rowp + bj * HALF) = w; } }
    }
};
struct EpiS5Out {
    static constexpr int NST = 32;
    static constexpr bool PERM = true;
    bf16* Y; unsigned char* Y8;
    __device__ __forceinline__ void operator()(const f32x4 (&acc)[2][2][4][2], const Unit& u, int wr, int wc, int fr, int fq) const {
#pragma unroll
        for (int ai = 0; ai < 2; ++ai)
#pragma unroll
            for (int m = 0; m < 4; ++m) {
                const int R = u.pm * BM + ai * HALF + wr * 64 + m * 16 + fr; const int gidx = R >> 10, b = (R >> 7) & 7, c = R & 127;
#pragma unroll
                for (int bj = 0; bj < 2; ++bj) {
                    const int n = bj * HALF + wc * 32 + 8 * fq, tt = n >> 4, ch0 = n & 15;
                    const f32x4 v0 = acc[ai][bj][m][0], v1 = acc[ai][bj][m][1];
                    u32x4 w; w.x = cvt_pk_bf16(gelu_tanh_f(v0[0]), gelu_tanh_f(v0[1])); w.y = cvt_pk_bf16(gelu_tanh_f(v0[2]), gelu_tanh_f(v0[3]));
                    w.z = cvt_pk_bf16(gelu_tanh_f(v1[0]), gelu_tanh_f(v1[1])); w.w = cvt_pk_bf16(gelu_tanh_f(v1[2]), gelu_tanh_f(v1[3]));
                    const size_t yo = (size_t)(b * SEQ + c * CS + tt) * 1024 + gidx * 16 + ch0;
                    *(u32x4*)(Y + yo) = w;
                    u32x2 w8; w8.x = cvt4_fp8(bflo(w.x), bfhi(w.x), bflo(w.y), bfhi(w.y)); w8.y = cvt4_fp8(bflo(w.z), bfhi(w.z), bflo(w.w), bfhi(w.w));
                    *(u32x2*)(Y8 + yo) = w8;
                }
            }
    }
};
struct EpiGlu {
    static constexpr int NST = 16;
    static constexpr bool PERM = true;
    const bf16* Y; unsigned char* MIX8;
    __device__ __forceinline__ void operator()(const f32x4 (&acc)[2][2][4][2], const Unit& u, int wr, int wc, int fr, int fq) const {
        const int row0 = u.pm * BM + wr * 64 + fr, col0 = u.pn * BM + wc * 32 + 8 * fq;
        u32x4 yv[2][4][2];
#pragma unroll
        for (int ai = 0; ai < 2; ++ai)
#pragma unroll
            for (int m = 0; m < 4; ++m)
#pragma unroll
                for (int bj = 0; bj < 2; ++bj) yv[ai][m][bj] = *(const u32x4*)(Y + (size_t)(row0 + ai * HALF + m * 16) * 1024 + col0 + bj * HALF);
#pragma unroll
        for (int ai = 0; ai < 2; ++ai)
#pragma unroll
            for (int m = 0; m < 4; ++m) { const int row = row0 + ai * HALF + m * 16;
#pragma unroll
                for (int bj = 0; bj < 2; ++bj) { const int col = col0 + bj * HALF; const f32x4 v0 = acc[ai][bj][m][0] * W8_INV, v1 = acc[ai][bj][m][1] * W8_INV;
                    const u32x4 y = yv[ai][m][bj];
                    u32x2 w; w.x = cvt4_fp8(bflo(y.x) * sigmoid_f(v0[0]), bfhi(y.x) * sigmoid_f(v0[1]), bflo(y.y) * sigmoid_f(v0[2]), bfhi(y.y) * sigmoid_f(v0[3]));
                    w.y = cvt4_fp8(bflo(y.z) * sigmoid_f(v1[0]), bfhi(y.z) * sigmoid_f(v1[1]), bflo(y.w) * sigmoid_f(v1[2]), bfhi(y.w) * sigmoid_f(v1[3]));
                    *(u32x2*)(MIX8 + (size_t)row * DM + 1024 + col) = w; } }
    }
};
template <bool XF32> struct EpiResid {
    static constexpr int NST = 16;
    static constexpr bool PERM = true;
    const void* xin_; bf16* Z;
    __device__ __forceinline__ void operator()(const f32x4 (&acc)[2][2][4][2], const Unit& u, int wr, int wc, int fr, int fq) const {
        const int row0 = u.pm * BM + wr * 64 + fr, col0 = u.pn * BM + wc * 32 + 8 * fq;
#pragma unroll
        for (int ai = 0; ai < 2; ++ai) {
            f32x4 xf0[XF32 ? 4 : 1][2], xf1[XF32 ? 4 : 1][2]; u32x4 xb[XF32 ? 1 : 4][2];
#pragma unroll
            for (int m = 0; m < 4; ++m)
#pragma unroll
                for (int bj = 0; bj < 2; ++bj) { const size_t off = (size_t)(row0 + ai * HALF + m * 16) * DM + col0 + bj * HALF;
                    if constexpr (XF32) { const float* xf = (const float*)xin_ + off; xf0[m][bj] = __builtin_nontemporal_load((const f32x4*)xf); xf1[m][bj] = __builtin_nontemporal_load((const f32x4*)(xf + 4)); }
                    else xb[m][bj] = __builtin_nontemporal_load((const u32x4*)((const bf16*)xin_ + off)); }
#pragma unroll
            for (int m = 0; m < 4; ++m) { const size_t off = (size_t)(row0 + ai * HALF + m * 16) * DM + col0;
#pragma unroll
                for (int bj = 0; bj < 2; ++bj) { const f32x4 v0 = acc[ai][bj][m][0] * W8_INV, v1 = acc[ai][bj][m][1] * W8_INV;
                    u32x4 w;
                    if constexpr (XF32) { const f32x4 x0 = xf0[m][bj], x1 = xf1[m][bj];
                        w.x = cvt_pk_bf16(ALPHA * x0[0] + v0[0], ALPHA * x0[1] + v0[1]); w.y = cvt_pk_bf16(ALPHA * x0[2] + v0[2], ALPHA * x0[3] + v0[3]);
                        w.z = cvt_pk_bf16(ALPHA * x1[0] + v1[0], ALPHA * x1[1] + v1[1]); w.w = cvt_pk_bf16(ALPHA * x1[2] + v1[2], ALPHA * x1[3] + v1[3]);
                    } else { const u32x4 x = xb[m][bj];
                        w.x = cvt_pk_bf16(ALPHA * bflo(x.x) + v0[0], ALPHA * bfhi(x.x) + v0[1]); w.y = cvt_pk_bf16(ALPHA * bflo(x.y) + v0[2], ALPHA * bfhi(x.y) + v0[3]);
                        w.z = cvt_pk_bf16(ALPHA * bflo(x.z) + v1[0], ALPHA * bfhi(x.z) + v1[1]); w.w = cvt_pk_bf16(ALPHA * bflo(x.w) + v1[2], ALPHA * bfhi(x.w) + v1[3]); }
                    *(u32x4*)(Z + off + bj * HALF) = w; } }
        }
    }
};
struct EpiGateUp {
    static constexpr int NST = 4;
    static constexpr bool PERM = true;
    unsigned char* H;
    __device__ __forceinline__ void operator()(const f32x4 (&acc)[2][2][4][2], const Unit& u, int wr, int wc, int fr, int fq) const {
        const int row0 = u.pm + wr * 64 + fr, col0 = u.pn * HALF + wc * 32 + 8 * fq; const int nai = (u.e & 256) ? 1 : 2;
#pragma unroll
        for (int ai = 0; ai < 2; ++ai) if (ai < nai)
#pragma unroll
            for (int m = 0; m < 4; ++m) { const f32x4 g0 = acc[ai][0][m][0] * W8_INV, g1 = acc[ai][0][m][1] * W8_INV, u0 = acc[ai][1][m][0] * W8_INV, u1 = acc[ai][1][m][1] * W8_INV;
                u32x2 w; w.x = cvt4_fp8(silu_f(g0[0]) * u0[0], silu_f(g0[1]) * u0[1], silu_f(g0[2]) * u0[2], silu_f(g0[3]) * u0[3]);
                w.y = cvt4_fp8(silu_f(g1[0]) * u1[0], silu_f(g1[1]) * u1[1], silu_f(g1[2]) * u1[2], silu_f(g1[3]) * u1[3]);
                *(u32x2*)(H + (size_t)(row0 + ai * HALF + m * 16) * DE + col0) = w; }
    }
};
}

#define XB_TMO      128
#define XB_XCNT(j)  (256  + 64 * (j))
#define XB_XSUB(j)  (1280 + 64 * (j))
#define XB_XGEN(j)  (2304 + 64 * (j))
#define XB_TOP      3328
#define XB_TOPGEN   3392
#define XCD_BAR_WORDS 3456
#define XB_SPIN_CAP (1u << 18)

__device__ __forceinline__ unsigned xb_ld(unsigned* p)              { return __hip_atomic_load(p, __ATOMIC_RELAXED, __HIP_MEMORY_SCOPE_AGENT); }
__device__ __forceinline__ unsigned xb_add(unsigned* p, unsigned v) { return __hip_atomic_fetch_add(p, v, __ATOMIC_RELAXED, __HIP_MEMORY_SCOPE_AGENT); }
__device__ __forceinline__ unsigned xb_xcc_id() { return (unsigned)__builtin_amdgcn_s_getreg((3 << 11) | 20) & 0xFu; }
#define XB_SPIN(cond, bar) do { unsigned _sp = 0; while (cond) { __builtin_amdgcn_s_sleep(1); \
    if ((++_sp & 255u) == 0u) { if (xb_ld(&(bar)[XB_TMO])) break; if (_sp > XB_SPIN_CAP) { atomicAdd(&(bar)[XB_TMO], 1u); break; } } } } while (0)

struct XcdBarrier { unsigned* bar; unsigned x; volatile LAS unsigned* st; };

__device__ __forceinline__ XcdBarrier xcd_barrier_post(unsigned* bar, volatile LAS unsigned* st) {
    XcdBarrier b; b.bar = bar; b.x = xb_xcc_id(); b.st = st;
    if (threadIdx.x == 0) (void)xb_add(&bar[XB_XCNT(b.x)], 1u);
    return b;
}
__device__ __forceinline__ void xcd_barrier_complete(unsigned* bar, unsigned x, unsigned& nloc, unsigned& nx) {
    const unsigned G = gridDim.x * gridDim.y * gridDim.z;
    unsigned sum, cnt, mine, sp = 0u;
    for (;;) {
        sum = 0u; cnt = 0u; mine = 0u;
#pragma unroll
        for (unsigned j = 0; j < 16; ++j) { const unsigned c = xb_ld(&bar[XB_XCNT(j)]); sum += c; cnt += (c > 0u) ? 1u : 0u; mine = (j == x) ? c : mine; }
        if (sum == G) break;
        __builtin_amdgcn_s_sleep(1);
        if ((++sp & 255u) == 0u) { if (xb_ld(&bar[XB_TMO])) break; if (sp > XB_SPIN_CAP) { atomicAdd(&bar[XB_TMO], 1u); break; } }
    }
    nloc = mine > 0u ? mine : 1u; nx = cnt > 0u ? cnt : 1u;
}
__device__ __forceinline__ void xcd_barrier(const XcdBarrier& b) {
    asm volatile("s_waitcnt vmcnt(0)" ::: "memory");
    __syncthreads();
    if (threadIdx.x == 0) {
        unsigned* bar = b.bar;
        __builtin_amdgcn_s_waitcnt(0);
        unsigned nloc = b.st[0], nx = b.st[1];
        if (nloc == 0u) { xcd_barrier_complete(bar, b.x, nloc, nx); b.st[0] = nloc; b.st[1] = nx; }
        const unsigned old = xb_add(&bar[XB_XSUB(b.x)], 1u);
        const unsigned gen = old / nloc;
        if (old + 1u == (gen + 1u) * nloc) {
            __builtin_amdgcn_fence(__ATOMIC_RELEASE, "agent");
            asm volatile("s_waitcnt vmcnt(0)" ::: "memory");
            const unsigned og = xb_add(&bar[XB_TOP], 1u);
            const unsigned tg = og / nx;
            if (og + 1u == (tg + 1u) * nx) xb_add(&bar[XB_TOPGEN], 1u);
            else XB_SPIN(xb_ld(&bar[XB_TOPGEN]) == tg, bar);
            __builtin_amdgcn_fence(__ATOMIC_ACQUIRE, "agent");
            xb_add(&bar[XB_XGEN(b.x)], 1u);
            asm volatile("s_waitcnt vmcnt(0)" ::: "memory");
        } else {
            XB_SPIN(xb_ld(&bar[XB_XGEN(b.x)]) == gen, bar);
            __builtin_amdgcn_fence(__ATOMIC_ACQUIRE, "agent");
            asm volatile("s_waitcnt vmcnt(0)" ::: "memory");
        }
    }
    __syncthreads();
}

struct Args { const float* in[21]; float* out; unsigned char* ws; int ph_lo, ph_hi; };

struct Frame {
    LAS unsigned char* lds;
    int tid, lane, wave, vcu, G;
    unsigned char* ws; unsigned* ctl;
};

struct TItem { const float* src; unsigned char* dst; int srcN, dld, f8; };
__device__ __forceinline__ void titem_load(const TItem& t, f32x4 (&v)[16], int lane) {
    const float* p = t.src + (size_t)(16 * (lane >> 4)) * t.srcN + 4 * (lane & 15);
#pragma unroll
    for (int i = 0; i < 16; ++i) v[i] = __builtin_nontemporal_load((const f32x4*)(p + (size_t)i * t.srcN));
}
__device__ __forceinline__ void titem_convert_write(const TItem& t, const f32x4 (&v)[16], int lane) {
    unsigned char* d = t.dst + (size_t)(4 * (lane & 15)) * t.dld + 16 * (lane >> 4);
#pragma unroll
    for (int c = 0; c < 4; ++c) { u32x4 w;
        w.x = cvt4_fp8(v[0][c] * W8_SCALE, v[1][c] * W8_SCALE, v[2][c] * W8_SCALE, v[3][c] * W8_SCALE); w.y = cvt4_fp8(v[4][c] * W8_SCALE, v[5][c] * W8_SCALE, v[6][c] * W8_SCALE, v[7][c] * W8_SCALE);
        w.z = cvt4_fp8(v[8][c] * W8_SCALE, v[9][c] * W8_SCALE, v[10][c] * W8_SCALE, v[11][c] * W8_SCALE); w.w = cvt4_fp8(v[12][c] * W8_SCALE, v[13][c] * W8_SCALE, v[14][c] * W8_SCALE, v[15][c] * W8_SCALE);
        *(u32x4*)(d + (size_t)c * t.dld) = w; }
}
constexpr int TI_IN = 2 * 32 * 80, TI_OUT = 2 * 32 * 32, TI_GLU = 2 * 16 * 16, TI_G = 64 * 32 * 16, TI_U = TI_G, TI_D = 64 * 16 * 32;
constexpr int TI_N = TI_IN + TI_OUT + TI_GLU + TI_G + TI_U + TI_D;
__device__ __forceinline__ TItem titem_decode(const Args& a, unsigned char* ws, int it) {
    TItem t; int r = it;
    if (r < TI_IN) { const int l = r / (32 * 80), q = r % (32 * 80), kb = q / 80, nb = q % 80, n0 = nb * 64, seg = n0 >> 10;
        const int drow = (seg == 0 ? 0 : seg == 1 ? 1024 : seg == 2 ? 4096 : seg == 3 ? 2048 : 3072) + (n0 & 1023);
        t.src = a.in[1] + (size_t)l * DM * NPROJ + (size_t)kb * 64 * NPROJ + n0; t.srcN = NPROJ; t.dst = ws + WS_WIN + (((size_t)l * NPROJ + drow) * DM + kb * 64); t.dld = DM; t.f8 = 1; return t; }
    r -= TI_IN;
    if (r < TI_OUT) { const int l = r / 1024, q = r % 1024, kb = q / 32, nb = q % 32;
        t.src = a.in[2] + (size_t)l * DM * DM + (size_t)kb * 64 * DM + nb * 64; t.srcN = DM; t.dst = ws + WS_WOUT + (((size_t)l * DM + nb * 64) * DM + kb * 64); t.dld = DM; t.f8 = 1; return t; }
    r -= TI_OUT;
    if (r < TI_GLU) { const int l = r / 256, q = r % 256, kb = q / 16, nb = q % 16;
        t.src = a.in[11] + (size_t)l * 1024 * 1024 + (size_t)kb * 64 * 1024 + nb * 64; t.srcN = 1024; t.dst = ws + WS_WGLU + (((size_t)l * 1024 + nb * 64) * 1024 + kb * 64); t.dld = 1024; t.f8 = 1; return t; }
    r -= TI_GLU;
    if (r < TI_G + TI_U) { const int up = r >= TI_G ? 1 : 0; if (up) r -= TI_G; const int le = r / 512, q = r % 512, kb = ((q >> 1) / 16) * 2 + (q & 1), nb = (q >> 1) % 16, n0 = nb * 64;
        const int drow = (n0 >> 7) * 256 + up * 128 + (n0 & 127);
        t.src = (up ? a.in[19] : a.in[18]) + (size_t)le * DM * DE + (size_t)kb * 64 * DE + n0; t.srcN = DE; t.dst = ws + WS_WGU + ((size_t)le * 2048 + drow) * DM + kb * 64; t.dld = DM; t.f8 = 1; return t; }
    r -= TI_G + TI_U;
    { const int le = r / 512, q = r % 512, kb = ((q >> 1) / 32) * 2 + (q & 1), nb = (q >> 1) % 32;
        t.src = a.in[20] + (size_t)le * DE * DM + (size_t)kb * 64 * DM + nb * 64; t.srcN = DM; t.dst = ws + WS_WDN + ((size_t)le * DM + nb * 64) * DE + kb * 64; t.dld = DE; t.f8 = 1; return t; }
}

__device__ __forceinline__ void convert_items(Frame& F, const Args& a, int first, int count, int gw = -1, int NGW = 0) {
    int lane_ = F.lane; asm volatile("" : "+v"(lane_));
    if (gw < 0) { gw = F.vcu * NWAVES + F.wave; NGW = F.G * NWAVES; }
    f32x4 va[16], vb[16];
    for (int q = gw; q < count / 2; q += NGW) {
        const TItem ta = titem_decode(a, F.ws, first + 2 * q), tb = titem_decode(a, F.ws, first + 2 * q + 1);
        titem_load(ta, va, lane_); titem_load(tb, vb, lane_);
        titem_convert_write(ta, va, lane_); titem_convert_write(tb, vb, lane_);
    }
}
struct ConvHook { static constexpr bool ON = true; Frame* F; const Args* a; int first, count, gw, ngw, at;
    __device__ __forceinline__ bool wants(int ui) const { return ui == at; }
    __device__ __forceinline__ void operator()(int) const { convert_items(*F, *a, first, count, gw, ngw); } };
constexpr int TI_MOE0 = TI_IN + TI_OUT + TI_GLU;

__device__ __forceinline__ void p0_prologue(Frame& F, const Args& a) {
    LAS float* scr = (LAS float*)(F.lds + F.wave * 16640);
    const int gw = F.vcu * NWAVES + F.wave, NGW = F.G * NWAVES;
    {
        LAS float* APr = (LAS float*)(F.lds);
        LAS float* APi = APr + 17 * 64;
        LAS float* BBr = APi + 17 * 64;
        LAS float* BBi = BBr + 1024;
        LAS float* CCr = BBi + 1024;
        LAS float* CCi = CCr + 1024;
        LAS float* DD = CCi + 1024;
        LAS float* KM = DD + 16;
        for (int it = F.vcu; it < 2 * SGRP; it += F.G) {
            const int l = it / SGRP, g = it % SGRP; const size_t lg = (size_t)l * SGRP + g;
            const float dt = expf(a.in[10][lg]);
            for (int idx = F.tid; idx < 17 * 64; idx += 512) { const int tau = idx >> 6, p = idx & 63;
                const float zr = a.in[3][lg * SST + p] * dt, zi = a.in[4][lg * SST + p] * dt; const float mg = expf(zr * (float)tau); float sn, cs; sincosf(zi * (float)tau, &sn, &cs);
                APr[idx] = mg * cs; APi[idx] = mg * sn;
                if (tau == 16) { float* A16 = (float*)(F.ws + WS_S5A) + (lg * SST + p) * 2; A16[0] = mg * cs; A16[1] = mg * sn; } }
            for (int idx = F.tid; idx < 1024; idx += 512) { const int p = idx >> 4;
                const float lre = a.in[3][lg * SST + p], lim = a.in[4][lg * SST + p], zr = lre * dt, zi = lim * dt;
                float sn, cs, sh, ch_; sincosf(zi, &sn, &cs); sincosf(0.5f * zi, &sh, &ch_); (void)ch_;
                const float em = expm1f(zr), ez = em + 1.0f; const float nr = em * cs - 2.0f * sh * sh, ni = ez * sn, den = lre * lre + lim * lim;
                const float sr = (nr * lre + ni * lim) / den, si = (ni * lre - nr * lim) / den;
                const float br = a.in[5][lg * 1024 + idx], bi = a.in[6][lg * 1024 + idx];
                BBr[idx] = sr * br - si * bi; BBi[idx] = sr * bi + si * br;
                CCr[idx] = a.in[7][lg * 1024 + idx]; CCi[idx] = a.in[8][lg * 1024 + idx]; }
            if (F.tid < 16) DD[F.tid] = a.in[9][lg * SCH + F.tid];
            __syncthreads();
            { const int tau = F.tid >> 5, ch0 = ((F.tid >> 2) & 7) * 2, cp0 = (F.tid & 3) * 4; float acc[2][4];
#pragma unroll
              for (int i = 0; i < 2; ++i)
#pragma unroll
                  for (int j = 0; j < 4; ++j) acc[i][j] = 0.f;
              for (int p = 0; p < 64; ++p) { const float ar = APr[tau * 64 + p], ai = APi[tau * 64 + p];
                  const f32x4 br = *(const LAS f32x4*)(BBr + p * 16 + cp0), bi = *(const LAS f32x4*)(BBi + p * 16 + cp0);
#pragma unroll
                  for (int i = 0; i < 2; ++i) { const float cr = CCr[(ch0 + i) * 64 + p], ci = CCi[(ch0 + i) * 64 + p]; const float car = cr * ar - ci * ai, cai = cr * ai + ci * ar;
#pragma unroll
                      for (int j = 0; j < 4; ++j) acc[i][j] += car * br[j] - cai * bi[j]; } }
#pragma unroll
              for (int i = 0; i < 2; ++i)
#pragma unroll
                  for (int j = 0; j < 4; ++j) KM[(tau << 8) + ((ch0 + i) << 4) + cp0 + j] = acc[i][j]; }
            __syncthreads();
            bf16* Bout = (bf16*)(F.ws + WS_S5OUT) + lg * (size_t)(256 * KS5);
            for (int v = F.tid; v < 256 * 48; v += 512) { const int n = v / 48, k8 = (v % 48) * 8, tt = n >> 4, ch = n & 15; float o[8];
                if (k8 < 256) { const int s5 = k8 >> 4, cpb = k8 & 15;
#pragma unroll
                    for (int j = 0; j < 8; ++j) { float x = (s5 <= tt) ? KM[((tt - s5) << 8) + (ch << 4) + cpb + j] : 0.f; if (s5 == tt && cpb + j == ch) x += DD[ch]; o[j] = x; } }
                else { const int p0 = (k8 - 256) & 63; const bool im = k8 >= 320;
#pragma unroll
                    for (int j = 0; j < 8; ++j) { const int p = p0 + j; const float cr = CCr[ch * 64 + p], ci = CCi[ch * 64 + p], ar = APr[(tt + 1) * 64 + p], ai = APi[(tt + 1) * 64 + p];
                        o[j] = im ? -(cr * ai + ci * ar) : (cr * ar - ci * ai); } }
                u32x4 w; w.x = cvt_pk_bf16(o[0], o[1]); w.y = cvt_pk_bf16(o[2], o[3]); w.z = cvt_pk_bf16(o[4], o[5]); w.w = cvt_pk_bf16(o[6], o[7]);
                *(u32x4*)(Bout + (size_t)n * KS5 + k8) = w; }
            bf16* Min = (bf16*)(F.ws + WS_S5IN) + lg * (size_t)(128 * 256);
            for (int v = F.tid; v < 128 * 32; v += 512) { const int n = v >> 5, k8 = (v & 31) * 8, p = n & 63, s5 = k8 >> 4, cpb = k8 & 15; float o[8];
                const float ar = APr[(15 - s5) * 64 + p], ai = APi[(15 - s5) * 64 + p];
#pragma unroll
                for (int j = 0; j < 8; ++j) { const float br = BBr[p * 16 + cpb + j], bi = BBi[p * 16 + cpb + j]; o[j] = (n < 64) ? (ar * br - ai * bi) : (ar * bi + ai * br); }
                u32x4 w; w.x = cvt_pk_bf16(o[0], o[1]); w.y = cvt_pk_bf16(o[2], o[3]); w.z = cvt_pk_bf16(o[4], o[5]); w.w = cvt_pk_bf16(o[6], o[7]);
                *(u32x4*)(Min + (size_t)n * 256 + k8) = w; }
            __syncthreads();
        }
    }
    __syncthreads();
    convert_items(F, a, 0, TI_IN / 2);
    for (int part = 0; part < 2; ++part) { const float* x = a.in[0];
      const bool split = (F.G == 256); const size_t half = (size_t)T * DM / 16;
      if (split && part == 0 && F.vcu < 128) continue;
      const size_t i0 = split ? (size_t)part * half : 0, i1 = split ? i0 + half : (part == 0 ? 2 * half : 0);
      const size_t gwx = (split && part == 0) ? (size_t)(gw - 128 * NWAVES) : (size_t)gw, ngwx = (split && part == 0) ? (size_t)(128 * NWAVES) : (size_t)NGW;
      for (size_t i = i0 + gwx * 64 + F.lane; i < i1; i += 4 * ngwx * 64) {
          f32x4 p[4], q[4];
#pragma unroll
          for (int k = 0; k < 4; ++k) { const size_t ik = i + (size_t)k * ngwx * 64; if (ik < i1) { p[k] = __builtin_nontemporal_load((const f32x4*)(x + ik * 8)); q[k] = __builtin_nontemporal_load((const f32x4*)(x + ik * 8 + 4)); } }
#pragma unroll
          for (int k = 0; k < 4; ++k) { const size_t ik = i + (size_t)k * ngwx * 64; if (ik < i1) {
              u32x2 w8; w8.x = cvt4_fp8(p[k][0], p[k][1], p[k][2], p[k][3]); w8.y = cvt4_fp8(q[k][0], q[k][1], q[k][2], q[k][3]); *(u32x2*)(F.ws + WS_XB8 + ik * 8) = w8; } } } }
    { const float* rw = a.in[16]; bf16* hi = (bf16*)(F.ws + WS_RWT); bf16* lo = hi + NE * DM;
      for (int i = gw * 64 + F.lane; i < NE * DM; i += NGW * 64) { const int e = i >> 11, k = i & 2047; const float v = rw[k * NE + e];
          const unsigned h = cvt_pk_bf16(v, 0.f) & 0xffffu; const float r = v - __uint_as_float(h << 16);
          hi[i] = (bf16)h; lo[i] = (bf16)(cvt_pk_bf16(r, 0.f) & 0xffffu); } }
}

typedef float f32x16 __attribute__((ext_vector_type(16)));
constexpr int RK_OFF = 0, RV_OFF = 65536, RP_OFF = 131072, RX_OFF = 147456;
#define RET_BAR() do { asm volatile("s_waitcnt vmcnt(0) lgkmcnt(0)" ::: "memory"); __builtin_amdgcn_s_barrier(); asm volatile("" ::: "memory"); } while (0)
#define RET_BAR_L() do { asm volatile("s_waitcnt lgkmcnt(0)" ::: "memory"); __builtin_amdgcn_s_barrier(); asm volatile("" ::: "memory"); } while (0)
__device__ __forceinline__ void retention_qtile(Frame& F, const bf16* Q, const bf16* Kk, const bf16* VT, const bf16* Gs, unsigned char* MIX8, int b, int h, int I) {
    int lane_ = F.lane; asm volatile("" : "+v"(lane_));
    const int w = F.wave, rg = w & 3, hf = w >> 2, l31 = lane_ & 31, hh = lane_ >> 5;
    LAS unsigned char* Ks = F.lds + RK_OFF; LAS unsigned char* Vs = F.lds + RV_OFF; LAS unsigned char* Ps = F.lds + RP_OFF; LAS float* Xs = (LAS float*)(F.lds + RX_OFF);
    const int ipos = I * 128 + rg * 32 + l31; const size_t tok = (size_t)b * SEQ + ipos;
    bf16x8 qf[16];
#pragma unroll
    for (int ks = 0; ks < 16; ++ks) qf[ks] = *(const bf16x8*)(Q + tok * RW + h * HD + ks * 16 + hh * 8);
    f32x16 oacc[4];
#pragma unroll
    for (int e = 0; e < 4; ++e)
#pragma unroll
        for (int r = 0; r < 16; ++r) oacc[e][r] = 0.f;
    const int nJ = 2 * I + 2;
    const char* kbase = (const char*)(Kk + ((size_t)b * SEQ) * RW + h * HD); const char* vbase = (const char*)(VT + ((size_t)h * HD) * T + (size_t)b * SEQ);
    const int krow = w * 2 + (lane_ >> 5), vrow = w * 8 + (lane_ >> 3);
    const unsigned ko0 = (unsigned)(krow * RW * 2 + ((l31 ^ (krow & 15)) * 16)), vo0 = (unsigned)(vrow * T * 2 + (((lane_ & 7) ^ ((vrow >> 1) & 7)) * 16));
#define RET_DMA_KV(J) do { const char* kb_ = kbase + (size_t)(J) * (64 * RW * 2); const char* vb_ = vbase + (size_t)(J) * 128; const int bo_ = ((J) & 1) * 32768; \
        unsigned ko_ = ko0, vo_ = vo0; asm volatile("" : "+v"(ko_), "+v"(vo_)); \
        _Pragma("unroll") for (int k = 0; k < 4; ++k) __builtin_amdgcn_global_load_lds((const unsigned*)(kb_ + (ko_ + (unsigned)k * (unsigned)(16 * RW * 2))), (LAS unsigned*)(Ks + bo_ + (k * 512 + w * 64) * 16), 16, 0, 0); \
        _Pragma("unroll") for (int k = 0; k < 4; ++k) __builtin_amdgcn_global_load_lds((const unsigned*)(vb_ + (vo_ + (unsigned)k * (unsigned)(64 * T * 2))), (LAS unsigned*)(Vs + bo_ + (k * 512 + w * 64) * 16), 16, 0, 0); } while (0)
    const int kr = 32 * hf + l31, kx = kr & 15; const int pr = 32 * rg + l31, px = (pr >> 1) & 7; const int vx = (l31 >> 1) & 7;
    LAS unsigned char* pp = Ps + pr * 128;
    unsigned ka[8], pa[4], va[4];
#pragma unroll
    for (int m = 0; m < 8; ++m) ka[m] = (unsigned)(size_t)(Ks + kr * 512 + (((2 * m + hh) ^ kx) * 16));
#pragma unroll
    for (int m = 0; m < 4; ++m) { pa[m] = (unsigned)(size_t)(Ps + pr * 128 + (((2 * m + hh) ^ px) * 16)); va[m] = (unsigned)(size_t)(Vs + (128 * hf + l31) * 128 + (((2 * m + hh) ^ vx) * 16)); }
#define DSR128(dst, addr, off) asm volatile("ds_read_b128 %0, %1 offset:" #off : "=v"(dst) : "v"(addr) : "memory")
#define WAITL(n) do { asm volatile("s_waitcnt lgkmcnt(" #n ")" ::: "memory"); __builtin_amdgcn_sched_barrier(0); } while (0)
#define SBAR() __builtin_amdgcn_sched_barrier(0)
#define RET_DMA_K(J_) do { const char* kb_ = kbase + (size_t)(J_) * (64 * RW * 2); const int bo_ = ((J_) & 1) * 32768; unsigned ko_ = ko0; asm volatile("" : "+v"(ko_)); \
        _Pragma("unroll") for (int k = 0; k < 4; ++k) __builtin_amdgcn_global_load_lds((const unsigned*)(kb_ + (ko_ + (unsigned)k * (unsigned)(16 * RW * 2))), (LAS unsigned*)(Ks + bo_ + (k * 512 + w * 64) * 16), 16, 0, 0); } while (0)
#define RET_DMA_V(J_) do { const char* vb_ = vbase + (size_t)(J_) * 128; const int bo_ = ((J_) & 1) * 32768; unsigned vo_ = vo0; asm volatile("" : "+v"(vo_)); \
        _Pragma("unroll") for (int k = 0; k < 4; ++k) __builtin_amdgcn_global_load_lds((const unsigned*)(vb_ + (vo_ + (unsigned)k * (unsigned)(64 * T * 2))), (LAS unsigned*)(Vs + bo_ + (k * 512 + w * 64) * 16), 16, 0, 0); } while (0)
#define RET_BARV(n) do { asm volatile("s_waitcnt vmcnt(" #n ")" ::: "memory"); __builtin_amdgcn_s_barrier(); asm volatile("" ::: "memory"); } while (0)
    bf16x8 f0, f1, f2, f3;
    RET_DMA_K(0); RET_DMA_V(0); RET_DMA_K(1);
    RET_BARV(8);
    SBAR(); DSR128(f0, ka[0], 0); DSR128(f1, ka[1], 0); DSR128(f2, ka[2], 0); DSR128(f3, ka[3], 0); SBAR();
    for (int J = 0; J < nJ; ++J) {
        const bool hasn = (J + 1 < nJ);
        if (hasn) RET_BARV(4); else RET_BARV(0);
        if (hasn) RET_DMA_V(J + 1);
        const unsigned bofs = (unsigned)((J & 1) * 32768);
        unsigned kaj[8], vaj[4];
#pragma unroll
        for (int m = 0; m < 8; ++m) kaj[m] = ka[m] + bofs;
#pragma unroll
        for (int m = 0; m < 4; ++m) vaj[m] = va[m] + bofs;
        f32x16 sacc;
#pragma unroll
        for (int r = 0; r < 16; ++r) sacc[r] = 0.f;
        {
#define RET_S1(fr, ks, cnt, nxt) WAITL(cnt); sacc = __builtin_amdgcn_mfma_f32_32x32x16_bf16(fr, qf[ks], sacc, 0, 0, 0); SBAR(); nxt; SBAR();
            RET_S1(f0, 0, 3, DSR128(f0, kaj[4], 0)) RET_S1(f1, 1, 3, DSR128(f1, kaj[5], 0)) RET_S1(f2, 2, 3, DSR128(f2, kaj[6], 0)) RET_S1(f3, 3, 3, DSR128(f3, kaj[7], 0))
            RET_S1(f0, 4, 3, DSR128(f0, kaj[0], 256)) RET_S1(f1, 5, 3, DSR128(f1, kaj[1], 256)) RET_S1(f2, 6, 3, DSR128(f2, kaj[2], 256)) RET_S1(f3, 7, 3, DSR128(f3, kaj[3], 256))
            RET_S1(f0, 8, 3, DSR128(f0, kaj[4], 256)) RET_S1(f1, 9, 3, DSR128(f1, kaj[5], 256)) RET_S1(f2, 10, 3, DSR128(f2, kaj[6], 256)) RET_S1(f3, 11, 3, DSR128(f3, kaj[7], 256))
            RET_S1(f0, 12, 3, (void)0) RET_S1(f1, 13, 2, (void)0) RET_S1(f2, 14, 1, (void)0) RET_S1(f3, 15, 0, (void)0)
#undef RET_S1
        }
        if (J * 64 + 63 > I * 128 + rg * 32) { const int d0 = ipos - J * 64 - 32 * hf - 4 * hh;
#pragma unroll
            for (int r = 0; r < 16; ++r) sacc[r] = (d0 >= (r & 3) + 8 * (r >> 2)) ? sacc[r] : 0.f; }
#pragma unroll
        for (int q = 0; q < 4; ++q) { u32x2 pw; pw.x = cvt_pk_bf16(sacc[4 * q], sacc[4 * q + 1]); pw.y = cvt_pk_bf16(sacc[4 * q + 2], sacc[4 * q + 3]);
            *(LAS u32x2*)(pp + (((4 * hf + q) ^ px) * 16) + 8 * hh) = pw; }
        bf16x8 pA, pB, v0, v1, v2, v3;
        SBAR(); DSR128(v0, vaj[0], 0); DSR128(v1, vaj[0], 4096); DSR128(v2, vaj[0], 8192); DSR128(v3, vaj[0], 12288); SBAR();
        asm volatile("s_waitcnt lgkmcnt(4)" ::: "memory");
        RET_BARV(4);
        if (J + 2 < nJ) RET_DMA_K(J + 2);
        {
            SBAR(); DSR128(pA, pa[0], 0); DSR128(pB, pa[1], 0);
#define RET_S2(vr, pr_, et, cnt, nxt) WAITL(cnt); oacc[et] = __builtin_amdgcn_mfma_f32_32x32x16_bf16(vr, pr_, oacc[et], 0, 0, 0); SBAR(); nxt; SBAR();
            RET_S2(v0, pA, 0, 1, DSR128(v0, vaj[1], 0)) RET_S2(v1, pA, 1, 2, DSR128(v1, vaj[1], 4096)) RET_S2(v2, pA, 2, 3, DSR128(v2, vaj[1], 8192)) RET_S2(v3, pA, 3, 4, DSR128(v3, vaj[1], 12288))
            SBAR(); DSR128(pA, pa[2], 0);
            RET_S2(v0, pB, 0, 4, DSR128(v0, vaj[2], 0)) RET_S2(v1, pB, 1, 4, DSR128(v1, vaj[2], 4096)) RET_S2(v2, pB, 2, 4, DSR128(v2, vaj[2], 8192)) RET_S2(v3, pB, 3, 4, DSR128(v3, vaj[2], 12288))
            SBAR(); DSR128(pB, pa[3], 0);
            RET_S2(v0, pA, 0, 4, DSR128(v0, vaj[3], 0)) RET_S2(v1, pA, 1, 4, DSR128(v1, vaj[3], 4096)) RET_S2(v2, pA, 2, 4, DSR128(v2, vaj[3], 8192)) RET_S2(v3, pA, 3, 4, DSR128(v3, vaj[3], 12288))
            RET_S2(v0, pB, 0, 3, (void)0) RET_S2(v1, pB, 1, 2, (void)0) RET_S2(v2, pB, 2, 1, (void)0) RET_S2(v3, pB, 3, 0, (void)0)
#undef RET_S2
        }
        if (hasn) { const unsigned bn = (unsigned)(((J + 1) & 1) * 32768);
            SBAR(); DSR128(f0, ka[0] + bn, 0); DSR128(f1, ka[1] + bn, 0); DSR128(f2, ka[2] + bn, 0); DSR128(f3, ka[3] + bn, 0); SBAR(); }
    }
#undef RET_DMA_K
#undef RET_DMA_V
#undef RET_BARV
#undef RET_DMA_KV
#undef DSR128
#undef WAITL
#undef SBAR
    float s1 = 0.f, s2 = 0.f;
#pragma unroll
    for (int et = 0; et < 4; ++et)
#pragma unroll
        for (int r = 0; r < 16; ++r) { s1 += oacc[et][r]; s2 += oacc[et][r] * oacc[et][r]; }
    s1 += __shfl_xor(s1, 32); s2 += __shfl_xor(s2, 32);
    if (hh == 0) { Xs[(hf * 128 + pr) * 2] = s1; Xs[(hf * 128 + pr) * 2 + 1] = s2; }
    RET_BAR();
    s1 += Xs[((hf ^ 1) * 128 + pr) * 2]; s2 += Xs[((hf ^ 1) * 128 + pr) * 2 + 1];
    const float mean = s1 * (1.0f / 256.0f); const float var = fmaxf(s2 * (1.0f / 256.0f) - mean * mean, 0.f);
    const float rstd = 1.0f / sqrtf(var + LN_EPS);
    u32x2 gvv[4][4];
#pragma unroll
    for (int et = 0; et < 4; ++et)
#pragma unroll
        for (int q = 0; q < 4; ++q) gvv[et][q] = *(const u32x2*)(Gs + tok * RW + h * HD + 128 * hf + 32 * et + 8 * q + 4 * hh);
#pragma unroll
    for (int et = 0; et < 4; ++et)
#pragma unroll
        for (int q = 0; q < 4; ++q) { const int e = h * HD + 128 * hf + 32 * et + 8 * q + 4 * hh;
            const u32x2 gv = gvv[et][q];
            *(unsigned*)(MIX8 + tok * DM + e) = cvt4_fp8((oacc[et][4 * q] - mean) * rstd * bflo(gv.x), (oacc[et][4 * q + 1] - mean) * rstd * bfhi(gv.x),
                                                         (oacc[et][4 * q + 2] - mean) * rstd * bflo(gv.y), (oacc[et][4 * q + 3] - mean) * rstd * bfhi(gv.y)); }
    RET_BAR();
}

constexpr int S5A_OFF = 0, S5I_OFF = 65536, S5E_OFF = S5I_OFF + 128 * 129 * 4;
__device__ __forceinline__ void s5in_pair(Frame& F, bf16* U2, const bf16* Min, const float* A16, int g, int b0) {
    const int l15 = F.lane & 15, g4 = F.lane >> 4, w = F.wave;
    LAS unsigned char* As = F.lds + S5A_OFF; LAS float* inc = (LAS float*)(F.lds + S5I_OFF); LAS float* Es = (LAS float*)(F.lds + S5E_OFF);
#define S5_STAGE(bb) do { const char* ub = (const char*)(U2 + (size_t)(g * 1024 + (bb) * 128) * KS5); const int row0 = w * 2 + (F.lane >> 5); \
      const unsigned so = (unsigned)(row0 * KS5 * 2 + (((F.lane & 31) ^ (row0 & 15)) * 16)); \
      _Pragma("unroll") for (int k = 0; k < 8; ++k) pg8::glds16s(ub + (size_t)k * (16 * KS5 * 2), so, (unsigned)(size_t)As + (unsigned)((k * 512 + w * 64) * 16)); } while (0)
    S5_STAGE(b0);
    bf16x8 bfr[8];
#pragma unroll
    for (int ks = 0; ks < 8; ++ks) bfr[ks] = *(const bf16x8*)(Min + (size_t)(w * 16 + l15) * 256 + ks * 32 + g4 * 8);
    const float a16r = A16[F.lane * 2], a16i = A16[F.lane * 2 + 1];
#pragma nounroll
    for (int ub_ = 0; ub_ < 2; ++ub_) { const int b = b0 + ub_;
    asm volatile("s_waitcnt vmcnt(0)" ::: "memory"); __syncthreads();
#pragma unroll 2
    for (int ct = 0; ct < 8; ++ct) { f32x4 acc = (f32x4){0.f, 0.f, 0.f, 0.f}; const int row = ct * 16 + l15;
#pragma unroll
        for (int ks = 0; ks < 8; ++ks) { const bf16x8 af = *(const LAS bf16x8*)(As + row * 512 + (((4 * ks + g4) ^ (row & 15)) * 16));
            acc = __builtin_amdgcn_mfma_f32_16x16x32_bf16(af, bfr[ks], acc, 0, 0, 0); }
#pragma unroll
        for (int r = 0; r < 4; ++r) inc[(ct * 16 + 4 * g4 + r) * 129 + w * 16 + l15] = acc[r]; }
    __syncthreads();
    if (ub_ == 0) S5_STAGE(b0 + 1);
    { const int p = F.lane, seg = w; const float ar = a16r, ai = a16i;
      float hr = 0.f, hi = 0.f;
#pragma unroll 4
      for (int j = 0; j < 16; ++j) { const int c = seg * 16 + j; const float ir = inc[c * 129 + p], ii = inc[c * 129 + 64 + p];
          const float nr = ar * hr - ai * hi + ir, ni = ar * hi + ai * hr + ii; hr = nr; hi = ni; }
      Es[(seg * 64 + p) * 2] = hr; Es[(seg * 64 + p) * 2 + 1] = hi;
      float pr = ar, pi = ai;
#pragma unroll
      for (int q = 0; q < 4; ++q) { const float t = pr * pr - pi * pi; pi = 2.f * pr * pi; pr = t; }
      LDS_WAIT(); __builtin_amdgcn_s_barrier(); asm volatile("" ::: "memory");
      float sr = 0.f, si = 0.f;
      for (int j = 0; j < seg; ++j) { const float er = Es[(j * 64 + p) * 2], ei = Es[(j * 64 + p) * 2 + 1]; const float nr = pr * sr - pi * si + er, ni = pr * si + pi * sr + ei; sr = nr; si = ni; }
      hr = sr; hi = si;
      bf16* row = U2 + (size_t)(g * 1024 + b * 128 + seg * 16) * KS5 + 256 + p;
#pragma unroll 4
      for (int j = 0; j < 16; ++j) { const int c = seg * 16 + j;
          row[(size_t)j * KS5] = (bf16)(cvt_pk_bf16(hr, 0.f) & 0xffffu); row[(size_t)j * KS5 + 64] = (bf16)(cvt_pk_bf16(hi, 0.f) & 0xffffu);
          const float ir = inc[c * 129 + p], ii = inc[c * 129 + 64 + p];
          const float nr = ar * hr - ai * hi + ir, ni = ar * hi + ai * hr + ii; hr = nr; hi = ni; }
    }
    LDS_WAIT(); __builtin_amdgcn_s_barrier(); asm volatile("" ::: "memory");
    }
    asm volatile("s_waitcnt vmcnt(0)" ::: "memory"); __syncthreads();
#undef S5_STAGE
}

__device__ __forceinline__ void ln1_router_unit(Frame& F, const Args& a, int layer, int unit) {
    const int l15 = F.lane & 15, g4 = F.lane >> 4, w = F.wave;
    const bf16* Zb = (const bf16*)(F.ws + WS_Z); unsigned char* X1F8 = F.ws + WS_XF; float* stats = (float*)(F.ws + WS_Z + 64 * MiB);
    const float* gam = a.in[12] + layer * DM; const float* bet = a.in[13] + layer * DM;
    LAS int* lcnt = (LAS int*)(F.lds + TST_OFF + 640); LAS int* lbase = lcnt + 32;
    if (F.tid < 32) lcnt[F.tid] = 0;
    const int r0 = unit * 64;
    LAS unsigned char* x1s = F.lds;
    LAS float* gl = (LAS float*)(F.lds + 131584);
    const f32x4 gst = *(const f32x4*)(gam + 4 * F.tid), bst = *(const f32x4*)(bet + 4 * F.tid);
    LAS float* sts = (LAS float*)(F.lds + 147968);
    f32x4 acc[4][2];
#pragma unroll
    for (int rt = 0; rt < 4; ++rt) { acc[rt][0] = (f32x4){0.f, 0.f, 0.f, 0.f}; acc[rt][1] = (f32x4){0.f, 0.f, 0.f, 0.f}; }
    {
        u32x4 xin[8][4];
#pragma unroll
        for (int rr = 0; rr < 8; ++rr)
#pragma unroll
            for (int j = 0; j < 4; ++j) xin[rr][j] = __builtin_nontemporal_load((const u32x4*)(Zb + (size_t)(r0 + 32 * (rr >> 2) + 4 * w + (rr & 3)) * DM + 8 * F.lane + 512 * j));
        *(LAS f32x4*)(gl + 4 * F.tid) = gst; *(LAS f32x4*)(gl + DM + 4 * F.tid) = bst;
        LDS_WAIT(); __builtin_amdgcn_s_barrier(); asm volatile("" ::: "memory");
        size_t zo_ = 0; asm volatile("" : "+s"(zo_));
        const bf16* rwh = (const bf16*)(F.ws + WS_RWT) + zo_ + (size_t)l15 * DM + w * 256 + g4 * 8; const bf16* rwl = rwh + NE * DM;
#pragma unroll
        for (int p = 0; p < 2; ++p) {
#pragma unroll
            for (int q4 = 0; q4 < 4; ++q4) { const int rr = 4 * p + q4; const int lr = 4 * w + q4; float v[4][8]; float s = 0.f;
                unsigned go_ = (unsigned)(8 * F.lane); asm volatile("" : "+v"(go_));
#pragma unroll
                for (int j = 0; j < 4; ++j) { const u32x4 x = xin[rr][j];
                    v[j][0] = bflo(x.x); v[j][1] = bfhi(x.x); v[j][2] = bflo(x.y); v[j][3] = bfhi(x.y); v[j][4] = bflo(x.z); v[j][5] = bfhi(x.z); v[j][6] = bflo(x.w); v[j][7] = bfhi(x.w);
#pragma unroll
                    for (int q = 0; q < 8; ++q) s += v[j][q]; }
                const float mean = wave_sum(s) * (1.0f / DM); float s2 = 0.f;
#pragma unroll
                for (int j = 0; j < 4; ++j)
#pragma unroll
                    for (int q = 0; q < 8; ++q) { v[j][q] -= mean; s2 += v[j][q] * v[j][q]; }
                const float rstd = 1.0f / sqrtf(wave_sum(s2) * (1.0f / DM) + LN_EPS);
                if (F.lane == 0) { sts[(32 * p + lr) * 2] = mean; sts[(32 * p + lr) * 2 + 1] = rstd; }
#pragma unroll
                for (int j = 0; j < 4; ++j) { const f32x4 g0 = *(const LAS f32x4*)(gl + go_ + 512 * j), g1 = *(const LAS f32x4*)(gl + go_ + 512 * j + 4), b0 = *(const LAS f32x4*)(gl + DM + go_ + 512 * j), b1 = *(const LAS f32x4*)(gl + DM + go_ + 512 * j + 4);
                    u32x4 pk; pk.x = cvt_pk_bf16(v[j][0] * rstd * g0[0] + b0[0], v[j][1] * rstd * g0[1] + b0[1]); pk.y = cvt_pk_bf16(v[j][2] * rstd * g0[2] + b0[2], v[j][3] * rstd * g0[3] + b0[3]);
                    pk.z = cvt_pk_bf16(v[j][4] * rstd * g1[0] + b1[0], v[j][5] * rstd * g1[1] + b1[1]); pk.w = cvt_pk_bf16(v[j][6] * rstd * g1[2] + b1[2], v[j][7] * rstd * g1[3] + b1[3]);
                    *(LAS u32x4*)(x1s + lr * 4112 + (8 * F.lane + 512 * j) * 2) = pk;
                    u32x2 p8; p8.x = cvt4_fp8(bflo(pk.x), bfhi(pk.x), bflo(pk.y), bfhi(pk.y)); p8.y = cvt4_fp8(bflo(pk.z), bfhi(pk.z), bflo(pk.w), bfhi(pk.w));
                    *(u32x2*)(X1F8 + (size_t)(r0 + 32 * p + lr) * DM + 8 * F.lane + 512 * j) = p8; }
            }
            LDS_WAIT(); __builtin_amdgcn_s_barrier(); asm volatile("" ::: "memory");
#pragma nounroll
            for (int s0 = 0; s0 < 8; s0 += 4) {
                bf16x8 ah[4][2], bh[4][2], bl[4][2];
#pragma unroll
                for (int i = 0; i < 4; ++i) {
#pragma unroll
                    for (int t = 0; t < 2; ++t) ah[i][t] = *(const LAS bf16x8*)(x1s + (t * 16 + l15) * 4112 + (w * 256 + (s0 + i) * 32 + g4 * 8) * 2);
#pragma unroll
                    for (int n = 0; n < 2; ++n) { bh[i][n] = *(const bf16x8*)(rwh + (size_t)n * 16 * DM + (s0 + i) * 32); bl[i][n] = *(const bf16x8*)(rwl + (size_t)n * 16 * DM + (s0 + i) * 32); } }
#pragma unroll
                for (int i = 0; i < 4; ++i)
#pragma unroll
                    for (int t = 0; t < 2; ++t)
#pragma unroll
                        for (int n = 0; n < 2; ++n) { acc[2 * p + t][n] = __builtin_amdgcn_mfma_f32_16x16x32_bf16(ah[i][t], bh[i][n], acc[2 * p + t][n], 0, 0, 0);
                            acc[2 * p + t][n] = __builtin_amdgcn_mfma_f32_16x16x32_bf16(ah[i][t], bl[i][n], acc[2 * p + t][n], 0, 0, 0); } }
            LDS_WAIT(); __builtin_amdgcn_s_barrier(); asm volatile("" ::: "memory");
        }
    }
    {
      LAS float* part = (LAS float*)F.lds;
#pragma unroll
      for (int rt = 0; rt < 4; ++rt)
#pragma unroll
          for (int n = 0; n < 2; ++n)
#pragma unroll
              for (int r = 0; r < 4; ++r) part[(w * 64 + rt * 16 + 4 * g4 + r) * 33 + n * 16 + l15] = acc[rt][n][r];
    }
    __syncthreads();
    { LAS float* part = (LAS float*)F.lds; LAS float* lsum = part + 8 * 64 * 33;
      const int row = F.tid >> 3, eb = (F.tid & 7) * 4;
#pragma unroll
      for (int j = 0; j < 4; ++j) { float sacc_ = 0.f;
#pragma unroll
          for (int k = 0; k < 8; ++k) sacc_ += part[(k * 64 + row) * 33 + eb + j];
          lsum[row * 33 + eb + j] = sacc_; } }
    __syncthreads();
    int e0 = 0, e1 = 0, rk0 = 0, rk1 = 0; float w0 = 0.f, w1 = 0.f;
    if (F.tid < 64) { const LAS float* part = (const LAS float*)F.lds; const float* rb = a.in[17];
        float lgt[32]; float mx = -3.0e38f;
#pragma unroll
        for (int e = 0; e < 32; ++e) { lgt[e] = part[(8 * 64 + F.tid) * 33 + e] + rb[e]; mx = fmaxf(mx, lgt[e]); }
        float bs = -1.f; float ba1 = 0.f, ba2 = 0.f; int bi1 = 0, bi2 = 0;
#pragma unroll
        for (int gi = 0; gi < 4; ++gi) { float a1 = -3.0e38f, a2 = -3.0e38f; int i1 = 0, i2 = 0;
#pragma unroll
            for (int j = 0; j < 8; ++j) { const float v = lgt[gi * 8 + j]; if (v > a1) { a2 = a1; i2 = i1; a1 = v; i1 = gi * 8 + j; } else if (v > a2) { a2 = v; i2 = gi * 8 + j; } }
            const float p1 = __expf(a1 - mx), p2 = __expf(a2 - mx), sc = p1 + p2;
            if (sc > bs) { bs = sc; ba1 = p1; ba2 = p2; bi1 = i1; bi2 = i2; } }
        e0 = bi1; e1 = bi2; w0 = ba1 / (ba1 + ba2); w1 = ba2 / (ba1 + ba2);
        rk0 = __hip_atomic_fetch_add(lcnt + e0, 1, __ATOMIC_RELAXED, __HIP_MEMORY_SCOPE_WORKGROUP);
        rk1 = __hip_atomic_fetch_add(lcnt + e1, 1, __ATOMIC_RELAXED, __HIP_MEMORY_SCOPE_WORKGROUP);
    }
    __syncthreads();
    if (F.tid < 32) lbase[F.tid] = (int)__hip_atomic_fetch_add(F.ctl + CW_CNT + (layer * NE + F.tid) * 64, (unsigned)lcnt[F.tid], __ATOMIC_RELAXED, __HIP_MEMORY_SCOPE_AGENT);
    __syncthreads();
    if (F.tid < 64) { const int tok = r0 + F.tid; const int s0 = lbase[e0] + rk0, s1 = lbase[e1] + rk1;
        int* list = (int*)(F.ws + WS_LIST); list[e0 * T + s0] = tok; list[e1 * T + s1] = tok;
        i32x4* ti = (i32x4*)(F.ws + WS_TOK) + (size_t)tok * 2;
        ti[0] = (i32x4){e0, s0, e1, s1}; ti[1] = (i32x4){(int)__float_as_uint(w0), (int)__float_as_uint(w1), 0, 0}; }
    if (F.tid < 64) { f32x2 st; st[0] = sts[F.tid * 2]; st[1] = sts[F.tid * 2 + 1]; *(f32x2*)(stats + (size_t)(r0 + F.tid) * 2) = st; }
    __syncthreads();
}

__device__ __forceinline__ void moe_setup(Frame& F, int layer) {
    LAS int* cnt = (LAS int*)(F.lds + TST_OFF); LAS int* pst = cnt + 32; LAS int* fst = pst + 33; LAS int* hst = fst + 33;
    __syncthreads();
    if (F.tid < 32) cnt[F.tid] = (int)__hip_atomic_load(F.ctl + CW_CNT + (layer * NE + F.tid) * 64, __ATOMIC_RELAXED, __HIP_MEMORY_SCOPE_AGENT);
    __syncthreads();
    if (F.tid < 64) {
        const int e = F.tid; int c = e < NE ? cnt[e & 31] : 0; c = c < 0 ? 0 : (c > T ? T : c); const int t = (c + 127) >> 7, f = t >> 1, hb = t & 1;
        int st = t, sf = f, sh = hb;
#pragma unroll
        for (int o = 1; o < 32; o <<= 1) { const int a = __shfl_up(st, o), b = __shfl_up(sf, o), d = __shfl_up(sh, o); if (e >= o) { st += a; sf += b; sh += d; } }
        if (e < NE) { pst[e] = st - t; fst[e] = sf - f; hst[e] = sh - hb; }
        if (e == NE - 1) { pst[NE] = st; fst[NE] = sf; hst[NE] = sh; } }
    __syncthreads();
}

constexpr int LN2R = 2;
__device__ __forceinline__ void ln2_rows(Frame& F, const LAS float* gl, const int (&toks)[LN2R], float* outf, bf16* outb) {
    const LAS int* pst = (const LAS int*)(F.lds + TST_OFF) + 32;
    i32x4 inf[LN2R][2];
#pragma unroll
    for (int r = 0; r < LN2R; ++r) { const i32x4* ti = (const i32x4*)(F.ws + WS_TOK) + (size_t)toks[r] * 2; inf[r][0] = ti[0]; inf[r][1] = ti[1]; }
    u32x4 xx[LN2R][4]; u32x2 pa[LN2R][4], pb[LN2R][4]; f32x2 stv[LN2R];
#pragma unroll
    for (int r = 0; r < LN2R; ++r) { const int tok = toks[r]; const int e0 = inf[r][0][0] & 31, e1 = inf[r][0][2] & 31;
        const size_t ra = (size_t)pst[e0] * 128 + inf[r][0][1], rb = (size_t)pst[e1] * 128 + inf[r][0][3];
        const bf16* x1 = (const bf16*)(F.ws + WS_Z) + (size_t)tok * DM + 8 * F.lane;
        stv[r] = *(const f32x2*)((const float*)(F.ws + WS_Z + 64 * MiB) + (size_t)tok * 2);
        const unsigned char* ya = F.ws + WS_YB + ra * DM + 8 * F.lane; const unsigned char* yb = F.ws + WS_YB + rb * DM + 8 * F.lane;
#pragma unroll
        for (int j = 0; j < 4; ++j) { xx[r][j] = __builtin_nontemporal_load((const u32x4*)(x1 + 512 * j)); pa[r][j] = __builtin_nontemporal_load((const u32x2*)(ya + 512 * j)); pb[r][j] = __builtin_nontemporal_load((const u32x2*)(yb + 512 * j)); } }
    float wts[LN2R][2];
#pragma unroll
    for (int r = 0; r < LN2R; ++r) { wts[r][0] = __uint_as_float((unsigned)inf[r][1][0]) * 0.0625f; wts[r][1] = __uint_as_float((unsigned)inf[r][1][1]) * 0.0625f; }
#pragma unroll
    for (int r = 0; r < LN2R; ++r) { const int tok = toks[r];
        const float w0 = wts[r][0], w1 = wts[r][1];
        float v[4][8]; float s = 0.f;
        const float m1 = stv[r][0], r1 = stv[r][1];
        unsigned g1o_ = (unsigned)(8 * F.lane); asm volatile("" : "+v"(g1o_));
#pragma unroll
        for (int j = 0; j < 4; ++j) { const u32x4 x = xx[r][j]; const u32x2 p = pa[r][j], q = pb[r][j];
            const f32x4 ga = *(const LAS f32x4*)(gl + 2 * DM + g1o_ + 512 * j), gb = *(const LAS f32x4*)(gl + 2 * DM + g1o_ + 512 * j + 4), ba = *(const LAS f32x4*)(gl + 3 * DM + g1o_ + 512 * j), bb = *(const LAS f32x4*)(gl + 3 * DM + g1o_ + 512 * j + 4);
            float x1v[8];
            x1v[0] = (bflo(x.x) - m1) * r1 * ga[0] + ba[0]; x1v[1] = (bfhi(x.x) - m1) * r1 * ga[1] + ba[1]; x1v[2] = (bflo(x.y) - m1) * r1 * ga[2] + ba[2]; x1v[3] = (bfhi(x.y) - m1) * r1 * ga[3] + ba[3];
            x1v[4] = (bflo(x.z) - m1) * r1 * gb[0] + bb[0]; x1v[5] = (bfhi(x.z) - m1) * r1 * gb[1] + bb[1]; x1v[6] = (bflo(x.w) - m1) * r1 * gb[2] + bb[2]; x1v[7] = (bfhi(x.w) - m1) * r1 * gb[3] + bb[3];
            const f32x2 p0 = __builtin_amdgcn_cvt_pk_f32_fp8((int)p.x, false), p1 = __builtin_amdgcn_cvt_pk_f32_fp8((int)p.x, true), p2 = __builtin_amdgcn_cvt_pk_f32_fp8((int)p.y, false), p3 = __builtin_amdgcn_cvt_pk_f32_fp8((int)p.y, true);
            const f32x2 q0 = __builtin_amdgcn_cvt_pk_f32_fp8((int)q.x, false), q1 = __builtin_amdgcn_cvt_pk_f32_fp8((int)q.x, true), q2 = __builtin_amdgcn_cvt_pk_f32_fp8((int)q.y, false), q3 = __builtin_amdgcn_cvt_pk_f32_fp8((int)q.y, true);
            v[j][0] = ALPHA * x1v[0] + w0 * p0[0] + w1 * q0[0]; v[j][1] = ALPHA * x1v[1] + w0 * p0[1] + w1 * q0[1];
            v[j][2] = ALPHA * x1v[2] + w0 * p1[0] + w1 * q1[0]; v[j][3] = ALPHA * x1v[3] + w0 * p1[1] + w1 * q1[1];
            v[j][4] = ALPHA * x1v[4] + w0 * p2[0] + w1 * q2[0]; v[j][5] = ALPHA * x1v[5] + w0 * p2[1] + w1 * q2[1];
            v[j][6] = ALPHA * x1v[6] + w0 * p3[0] + w1 * q3[0]; v[j][7] = ALPHA * x1v[7] + w0 * p3[1] + w1 * q3[1];
#pragma unroll
            for (int t = 0; t < 8; ++t) s += v[j][t]; }
        const float mean = wave_sum(s) * (1.0f / DM); float s2 = 0.f;
#pragma unroll
        for (int j = 0; j < 4; ++j)
#pragma unroll
            for (int t = 0; t < 8; ++t) { v[j][t] -= mean; s2 += v[j][t] * v[j][t]; }
        const float rstd = 1.0f / sqrtf(wave_sum(s2) * (1.0f / DM) + LN_EPS);
        unsigned go_ = (unsigned)(8 * F.lane); asm volatile("" : "+v"(go_));
#pragma unroll
        for (int j = 0; j < 4; ++j) { const f32x4 g0 = *(const LAS f32x4*)(gl + go_ + 512 * j), g1 = *(const LAS f32x4*)(gl + go_ + 512 * j + 4), b0 = *(const LAS f32x4*)(gl + DM + go_ + 512 * j), b1 = *(const LAS f32x4*)(gl + DM + go_ + 512 * j + 4);
            f32x4 o0, o1;
#pragma unroll
            for (int t = 0; t < 4; ++t) { o0[t] = v[j][t] * rstd * g0[t] + b0[t]; o1[t] = v[j][4 + t] * rstd * g1[t] + b1[t]; }
            if (outf) { float* op = outf + (size_t)tok * DM + 8 * F.lane + 512 * j; __builtin_nontemporal_store(o0, (f32x4*)op); __builtin_nontemporal_store(o1, (f32x4*)(op + 4)); }
            if (outb) { u32x4 pk; pk.x = cvt_pk_bf16(o0[0], o0[1]); pk.y = cvt_pk_bf16(o0[2], o0[3]); pk.z = cvt_pk_bf16(o1[0], o1[1]); pk.w = cvt_pk_bf16(o1[2], o1[3]);
                __builtin_nontemporal_store(pk, (u32x4*)(outb + (size_t)tok * DM + 8 * F.lane + 512 * j));
                u32x2 p8; p8.x = cvt4_fp8(o0[0], o0[1], o0[2], o0[3]); p8.y = cvt4_fp8(o1[0], o1[1], o1[2], o1[3]); *(u32x2*)(F.ws + WS_XB8 + (size_t)tok * DM + 8 * F.lane + 512 * j) = p8; } }
    }
}

__global__ void __launch_bounds__(NWAVES * 64, 2) mk_fwd(Args args) {
    extern __shared__ __attribute__((aligned(16))) unsigned char lds_raw[];
    Frame F;
    F.lds = (LAS unsigned char*)lds_raw;
    F.tid = threadIdx.x; F.lane = F.tid & 63; F.wave = __builtin_amdgcn_readfirstlane(F.tid >> 6);
    F.G = gridDim.x; { const int bx = blockIdx.x; F.vcu = (F.G % 8 == 0) ? (bx % 8) * (F.G / 8) + bx / 8 : bx; }
    F.ws = args.ws; F.ctl = (unsigned*)(args.ws + WS_CTL);
    volatile LAS unsigned* MISC = (volatile LAS unsigned*)(F.lds + MISC_OFF);
    if (F.tid < 4) MISC[F.tid] = 0u;
    __syncthreads();
    XcdBarrier bar; bar.bar = F.ctl + CW_BAR; bar.x = 0; bar.st = MISC;
    if (MK_N_LAUNCHES == 1) bar = xcd_barrier_post(F.ctl + CW_BAR, MISC);
    const int lo = args.ph_lo, hi = args.ph_hi;
#ifndef ONLY_PHASE
#define ONLY_PHASE -1
#endif
#define PON(k) (ONLY_PHASE < 0 || ONLY_PHASE == (k))
#ifndef PROBE_PHASE
#define PROBE_PHASE -1
#endif
#define RPT(k) ((PROBE_PHASE == (k)) ? 2 : 1)
#define IN(k) (lo <= (k) && (k) < hi)
#define PHASE_FRAME Frame P = F; { size_t z_ = 0; asm volatile("" : "+s"(z_)); P.ws = F.ws + z_; P.wave = F.wave + (int)z_; } P.lane = (int)__builtin_amdgcn_mbcnt_hi(~0u, __builtin_amdgcn_mbcnt_lo(~0u, 0u)); asm volatile("" : "+v"(P.lane)); P.tid = P.wave * 64 + P.lane; P.ctl = (unsigned*)(P.ws + WS_CTL)
#define SEAM(k) do { if (IN(k) && IN((k) + 1)) xcd_barrier(bar); } while (0)

    if (PON(0) && IN(0)) { PHASE_FRAME; p0_prologue(P, args); __syncthreads(); }
    if (PROBE_PHASE == 0 && PON(0) && IN(0)) { PHASE_FRAME; p0_prologue(P, args); __syncthreads(); }
    SEAM(0);

    for (int layer = 0; layer < 2; ++layer) {
        const int pb = 1 + 9 * layer;
#define MIXCONV() do { const int c_ = P.vcu & 1, ng_ = (P.G >> 1) * NWAVES, g0_ = (P.vcu >> 1) * NWAVES + P.wave; \
            convert_items(P, args, TI_IN / 2 + c_ * (TI_IN / 4), TI_IN / 4, g0_, ng_); \
            convert_items(P, args, TI_IN + c_ * (TI_OUT / 2), TI_OUT / 2, (g0_ + ng_ - (TI_IN / 8) % ng_) % ng_, ng_); \
            convert_items(P, args, TI_IN + TI_OUT + c_ * (TI_GLU / 2), TI_GLU / 2, (g0_ + 2 * ng_ - (TI_IN / 8 + TI_OUT / 4) % ng_) % ng_, ng_); } while (0)
        if (PON(1) && IN(pb + 0)) for (int rp_ = 0; rp_ < RPT(1); ++rp_) {
            PHASE_FRAME;
            bf16* XB = (bf16*)(P.ws + WS_XB); float* XF = (float*)(P.ws + WS_XF);
            bf16* Qb = (bf16*)(P.ws + WS_Q); bf16* Kb = (bf16*)(P.ws + WS_K); bf16* Gb = (bf16*)(P.ws + WS_G); bf16* VT = (bf16*)(P.ws + WS_VT);
            bf16* U2 = (bf16*)(P.ws + WS_U2); bf16* Yb = (bf16*)(P.ws + WS_Y); bf16* MIX = (bf16*)(P.ws + WS_MIX); float* Z = (float*)(P.ws + WS_Z);
            bf16* X1B = (bf16*)(P.ws + WS_X1B); bf16* Hb = (bf16*)(P.ws + WS_H); bf16* YB = (bf16*)(P.ws + WS_YB);
            const bf16* Win = (const bf16*)(P.ws + WS_WIN) + (size_t)layer * NPROJ * DM;
            (void)XB; (void)XF; (void)Qb; (void)Kb; (void)Gb; (void)VT; (void)U2; (void)Yb; (void)MIX; (void)Z; (void)X1B; (void)Hb; (void)YB; (void)Win;
            { pg8::DenseOrder S; S.init(T, 4096, DM, P.G, (int)blockIdx.x, P.ws + WS_WIN + (size_t)layer * NPROJ * DM, 1);
              pg8::EpiInProj E{Qb, Kb, Gb, U2, (const float*)(P.ws + WS_COS), (const float*)(P.ws + WS_SIN)};
              if (layer == 0 && (P.vcu & 1) != 0) { MIXCONV(); __syncthreads(); }
              S.ulist = (const LAS int*)(P.lds + TST_OFF + 896); __syncthreads(); pg8::moe_units(S, (LAS int*)(P.lds + TST_OFF + 896), P.tid); __syncthreads();
              pg8::gemm_phase<true>(P.lds, P.tid, (const char*)(P.ws + WS_XB8), DM, S, E); }
            { pg8::DenseOrder S; S.init(1024, T, DM, P.G, (int)blockIdx.x, P.ws + WS_XB8, 1);
              pg8::EpiBf16 E{VT, T, W8_INV};
              S.ulist = (const LAS int*)(P.lds + TST_OFF + 896); __syncthreads(); pg8::moe_units(S, (LAS int*)(P.lds + TST_OFF + 896), P.tid); __syncthreads();
              pg8::gemm_phase<true>(P.lds, P.tid, (const char*)(P.ws + WS_WIN + ((size_t)layer * NPROJ + 4096) * DM), DM, S, E); }
            if (layer == 0 && (P.vcu & 1) == 0) { __syncthreads(); MIXCONV(); }
        }
        SEAM(pb + 0);

        if (PON(2) && IN(pb + 1)) for (int rp_ = 0; rp_ < RPT(2); ++rp_) {
            PHASE_FRAME;
            bf16* XB = (bf16*)(P.ws + WS_XB); float* XF = (float*)(P.ws + WS_XF);
            bf16* Qb = (bf16*)(P.ws + WS_Q); bf16* Kb = (bf16*)(P.ws + WS_K); bf16* Gb = (bf16*)(P.ws + WS_G); bf16* VT = (bf16*)(P.ws + WS_VT);
            bf16* U2 = (bf16*)(P.ws + WS_U2); bf16* Yb = (bf16*)(P.ws + WS_Y); bf16* MIX = (bf16*)(P.ws + WS_MIX); float* Z = (float*)(P.ws + WS_Z);
            bf16* X1B = (bf16*)(P.ws + WS_X1B); bf16* Hb = (bf16*)(P.ws + WS_H); bf16* YB = (bf16*)(P.ws + WS_YB);
            const bf16* Win = (const bf16*)(P.ws + WS_WIN) + (size_t)layer * NPROJ * DM;
            (void)XB; (void)XF; (void)Qb; (void)Kb; (void)Gb; (void)VT; (void)U2; (void)Yb; (void)MIX; (void)Z; (void)X1B; (void)Hb; (void)YB; (void)Win;
            const int cpos = P.vcu & 3, ufirst4 = TI_MOE0 + TI_G + layer * (TI_U / 2) + cpos * (TI_U / 8), cgw4 = (P.vcu >> 2) * NWAVES + P.wave, cngw4 = (P.G >> 2) * NWAVES;
            for (int rq_ = 0; rq_ < (PROBE_PHASE == 21 ? 2 : 1); ++rq_)
            for (int u = P.vcu; u < 256; u += P.G) { const int bh = u >> 3, p = u & 7, b = bh >> 2, h = bh & 3;
                if (cpos == 0) { convert_items(P, args, ufirst4, TI_U / 8, cgw4, cngw4); __syncthreads(); }
                retention_qtile(P, Qb, Kb, VT, Gb, P.ws + WS_MIX8, b, h, 15 - p); __syncthreads();
                if (cpos == 1) { convert_items(P, args, ufirst4, TI_U / 8, cgw4, cngw4); __syncthreads(); }
                retention_qtile(P, Qb, Kb, VT, Gb, P.ws + WS_MIX8, b, h, p); __syncthreads();
                if (cpos == 2) { convert_items(P, args, ufirst4, TI_U / 8, cgw4, cngw4); __syncthreads(); } }
            for (int rq_ = 0; rq_ < (PROBE_PHASE == 22 ? 2 : 1); ++rq_)
            for (int u2 = P.vcu * 2; u2 < 512; u2 += 2 * P.G) { const int g = u2 >> 3, b0 = u2 & 7;
                s5in_pair(P, U2, (const bf16*)(P.ws + WS_S5IN) + ((size_t)layer * SGRP + g) * (128 * 256), (const float*)(P.ws + WS_S5A) + ((size_t)layer * SGRP + g) * SST * 2, g, b0); }
            if (cpos == 3) { __syncthreads(); convert_items(P, args, ufirst4, TI_U / 8, cgw4, cngw4); __syncthreads(); }
        }
        if (F.G == 256) { if (IN(pb + 1) && IN(pb + 2)) { VM_WAIT(); __syncthreads(); } } else SEAM(pb + 1);

        if (PON(3) && IN(pb + 2)) for (int rp_ = 0; rp_ < RPT(3); ++rp_) {
            PHASE_FRAME;
            bf16* XB = (bf16*)(P.ws + WS_XB); float* XF = (float*)(P.ws + WS_XF);
            bf16* Qb = (bf16*)(P.ws + WS_Q); bf16* Kb = (bf16*)(P.ws + WS_K); bf16* Gb = (bf16*)(P.ws + WS_G); bf16* VT = (bf16*)(P.ws + WS_VT);
            bf16* U2 = (bf16*)(P.ws + WS_U2); bf16* Yb = (bf16*)(P.ws + WS_Y); bf16* MIX = (bf16*)(P.ws + WS_MIX); float* Z = (float*)(P.ws + WS_Z);
            bf16* X1B = (bf16*)(P.ws + WS_X1B); bf16* Hb = (bf16*)(P.ws + WS_H); bf16* YB = (bf16*)(P.ws + WS_YB);
            const bf16* Win = (const bf16*)(P.ws + WS_WIN) + (size_t)layer * NPROJ * DM;
            (void)XB; (void)XF; (void)Qb; (void)Kb; (void)Gb; (void)VT; (void)U2; (void)Yb; (void)MIX; (void)Z; (void)X1B; (void)Hb; (void)YB; (void)Win;
            pg8::S5Order S; S.G = P.G; S.c = P.vcu; S.Bt = (const char*)((const bf16*)(P.ws + WS_S5OUT) + (size_t)layer * SGRP * 256 * KS5);
            pg8::EpiS5Out E{Yb, P.ws + WS_Y8};
            int k5 = KS5; asm volatile("" : "+s"(k5));
            S.ulist = (const LAS int*)(P.lds + TST_OFF + 896); __syncthreads(); pg8::moe_units(S, (LAS int*)(P.lds + TST_OFF + 896), P.tid); __syncthreads();
            pg8::gemm_phase<false>(P.lds, P.tid, (const char*)U2, k5, S, E);
        }
        SEAM(pb + 2);

        if (PON(4) && IN(pb + 3)) for (int rp_ = 0; rp_ < RPT(4); ++rp_) {
            PHASE_FRAME;
            bf16* XB = (bf16*)(P.ws + WS_XB); float* XF = (float*)(P.ws + WS_XF);
            bf16* Qb = (bf16*)(P.ws + WS_Q); bf16* Kb = (bf16*)(P.ws + WS_K); bf16* Gb = (bf16*)(P.ws + WS_G); bf16* VT = (bf16*)(P.ws + WS_VT);
            bf16* U2 = (bf16*)(P.ws + WS_U2); bf16* Yb = (bf16*)(P.ws + WS_Y); bf16* MIX = (bf16*)(P.ws + WS_MIX); float* Z = (float*)(P.ws + WS_Z);
            bf16* X1B = (bf16*)(P.ws + WS_X1B); bf16* Hb = (bf16*)(P.ws + WS_H); bf16* YB = (bf16*)(P.ws + WS_YB);
            const bf16* Win = (const bf16*)(P.ws + WS_WIN) + (size_t)layer * NPROJ * DM;
            (void)XB; (void)XF; (void)Qb; (void)Kb; (void)Gb; (void)VT; (void)U2; (void)Yb; (void)MIX; (void)Z; (void)X1B; (void)Hb; (void)YB; (void)Win;
            pg8::DenseOrder S; S.init(T, 1024, 1024, P.G, (int)blockIdx.x, P.ws + WS_WGLU + (size_t)layer * 1024 * 1024, 1);
            pg8::EpiGlu E{Yb, P.ws + WS_MIX8};
            S.ulist = (const LAS int*)(P.lds + TST_OFF + 896); __syncthreads(); pg8::moe_units(S, (LAS int*)(P.lds + TST_OFF + 896), P.tid); __syncthreads();
            pg8::gemm_phase<true>(P.lds, P.tid, (const char*)(P.ws + WS_Y8), 1024, S, E);
        }
        SEAM(pb + 3);

        if (PON(5) && IN(pb + 4)) for (int rp_ = 0; rp_ < RPT(5); ++rp_) {
            PHASE_FRAME;
            bf16* XB = (bf16*)(P.ws + WS_XB); float* XF = (float*)(P.ws + WS_XF);
            bf16* Qb = (bf16*)(P.ws + WS_Q); bf16* Kb = (bf16*)(P.ws + WS_K); bf16* Gb = (bf16*)(P.ws + WS_G); bf16* VT = (bf16*)(P.ws + WS_VT);
            bf16* U2 = (bf16*)(P.ws + WS_U2); bf16* Yb = (bf16*)(P.ws + WS_Y); bf16* MIX = (bf16*)(P.ws + WS_MIX); float* Z = (float*)(P.ws + WS_Z);
            bf16* X1B = (bf16*)(P.ws + WS_X1B); bf16* Hb = (bf16*)(P.ws + WS_H); bf16* YB = (bf16*)(P.ws + WS_YB);
            const bf16* Win = (const bf16*)(P.ws + WS_WIN) + (size_t)layer * NPROJ * DM;
            (void)XB; (void)XF; (void)Qb; (void)Kb; (void)Gb; (void)VT; (void)U2; (void)Yb; (void)MIX; (void)Z; (void)X1B; (void)Hb; (void)YB; (void)Win;
            pg8::DenseOrder S; S.init(T, DM, DM, P.G, (int)blockIdx.x, P.ws + WS_WOUT + (size_t)layer * DM * DM, 1);

            constexpr int GC0 = 5462, GC1 = 5462, GC2 = TI_G / 2 - GC0 - GC1;
            const int gcls = P.vcu % 3, gfirst = TI_MOE0 + layer * (TI_G / 2) + (gcls == 0 ? 0 : (gcls == 1 ? GC0 : GC0 + GC1)), gcount = gcls == 0 ? GC0 : (gcls == 1 ? GC1 : GC2);
            const int cgw = (P.vcu / 3) * NWAVES + P.wave, cngw = ((P.G - gcls + 2) / 3) * NWAVES;
            if (gcls == 0) convert_items(P, args, gfirst, gcount, cgw, cngw);
            S.ulist = (const LAS int*)(P.lds + TST_OFF + 896); __syncthreads(); pg8::moe_units(S, (LAS int*)(P.lds + TST_OFF + 896), P.tid); __syncthreads();
            const ConvHook H{&P, &args, gfirst, gcount, cgw, cngw, gcls == 1 ? 0 : -1};
            if (layer == 0) { pg8::EpiResid<true> E{(const void*)args.in[0], (bf16*)Z}; pg8::gemm_phase<true>(P.lds, P.tid, (const char*)(P.ws + WS_MIX8), DM, S, E, H); }
            else { pg8::EpiResid<false> E{(const void*)XB, (bf16*)Z}; pg8::gemm_phase<true>(P.lds, P.tid, (const char*)(P.ws + WS_MIX8), DM, S, E, H); }
            if (gcls == 2) convert_items(P, args, gfirst, gcount, cgw, cngw);
        }
        SEAM(pb + 4);

        if (PON(6) && IN(pb + 5)) for (int rp_ = 0; rp_ < RPT(6); ++rp_) {
            PHASE_FRAME;
            bf16* XB = (bf16*)(P.ws + WS_XB); float* XF = (float*)(P.ws + WS_XF);
            bf16* Qb = (bf16*)(P.ws + WS_Q); bf16* Kb = (bf16*)(P.ws + WS_K); bf16* Gb = (bf16*)(P.ws + WS_G); bf16* VT = (bf16*)(P.ws + WS_VT);
            bf16* U2 = (bf16*)(P.ws + WS_U2); bf16* Yb = (bf16*)(P.ws + WS_Y); bf16* MIX = (bf16*)(P.ws + WS_MIX); float* Z = (float*)(P.ws + WS_Z);
            bf16* X1B = (bf16*)(P.ws + WS_X1B); bf16* Hb = (bf16*)(P.ws + WS_H); bf16* YB = (bf16*)(P.ws + WS_YB);
            const bf16* Win = (const bf16*)(P.ws + WS_WIN) + (size_t)layer * NPROJ * DM;
            (void)XB; (void)XF; (void)Qb; (void)Kb; (void)Gb; (void)VT; (void)U2; (void)Yb; (void)MIX; (void)Z; (void)X1B; (void)Hb; (void)YB; (void)Win;
            for (int u = P.vcu; u < T / 64; u += P.G) ln1_router_unit(P, args, layer, u);

        }
        SEAM(pb + 5);

        if (PON(7) && IN(pb + 6)) for (int rp_ = 0; rp_ < RPT(7); ++rp_) {
            PHASE_FRAME;
            bf16* XB = (bf16*)(P.ws + WS_XB); float* XF = (float*)(P.ws + WS_XF);
            bf16* Qb = (bf16*)(P.ws + WS_Q); bf16* Kb = (bf16*)(P.ws + WS_K); bf16* Gb = (bf16*)(P.ws + WS_G); bf16* VT = (bf16*)(P.ws + WS_VT);
            bf16* U2 = (bf16*)(P.ws + WS_U2); bf16* Yb = (bf16*)(P.ws + WS_Y); bf16* MIX = (bf16*)(P.ws + WS_MIX); float* Z = (float*)(P.ws + WS_Z);
            bf16* X1B = (bf16*)(P.ws + WS_X1B); bf16* Hb = (bf16*)(P.ws + WS_H); bf16* YB = (bf16*)(P.ws + WS_YB);
            const bf16* Win = (const bf16*)(P.ws + WS_WIN) + (size_t)layer * NPROJ * DM;
            (void)XB; (void)XF; (void)Qb; (void)Kb; (void)Gb; (void)VT; (void)U2; (void)Yb; (void)MIX; (void)Z; (void)X1B; (void)Hb; (void)YB; (void)Win;
            moe_setup(P, layer);
            const LAS int* cnt = (const LAS int*)(P.lds + TST_OFF); const LAS int* pst = cnt + 32; const LAS int* fst = pst + 33; const LAS int* hst = fst + 33;
            LAS unsigned* table = (LAS unsigned*)(P.lds + TAB_OFF);
            pg8::MoeOrder<true> S; S.NF = fst[NE] * 8; S.NU = S.NF + hst[NE] * 8; S.G = P.G; S.c = P.vcu; S.pst = pst; S.fst = fst; S.hst = hst; S.table = table; S.rowbytes = 0;
            S.Bt = (const char*)(P.ws + WS_WGU) + (size_t)layer * NE * 2048 * DM; S.estepB = (size_t)2048 * DM; S.tstepB = (size_t)256 * DM;
            S.ulist = (const LAS int*)(P.lds + TST_OFF + 896); pg8::moe_units(S, (LAS int*)(P.lds + TST_OFF + 896), P.tid); __syncthreads();
            { const int* list = (const int*)(P.ws + WS_LIST); int tk[8]; bool okk[8];
#pragma unroll
              for (int i = 0; i < 8; ++i) { pg8::Unit u; okk[i] = S.next(i, u) && (P.tid < 256); int tok = 0;
                  if (okk[i]) { const int e = u.e & 255; const int slot = (u.pm - pst[e] * 128) + P.tid; if (slot < cnt[e]) tok = list[e * T + slot]; }
                  tk[i] = tok; }
#pragma unroll
              for (int i = 0; i < 8; ++i) if (okk[i]) { int tok = tk[i]; tok = tok < 0 ? 0 : (tok >= T ? T - 1 : tok); table[i * 256 + P.tid] = (unsigned)tok * (unsigned)DM; } }
            __syncthreads();
            const int dcls = P.vcu & 3, dk = P.vcu >> 2, nclass = P.G >> 2;
            int dfirst = TI_MOE0 + 2 * TI_G + layer * (TI_D / 2) + dcls * (TI_D / 8), dcount = TI_D / 8, dgw = dk * NWAVES + P.wave, dngw = nclass * NWAVES;
            { const int ntall = S.NU - 4 * P.G; int nt = ntall > dcls ? (ntall - dcls + 3) >> 2 : 0; nt = nt > nclass ? nclass : nt;
              const int wtot = 2 * nt + 6 * (nclass - nt), c0 = 2 * (dk < nt ? dk : nt) + 6 * (dk > nt ? dk - nt : 0), c1 = c0 + (dk < nt ? 2 : 6);
              const int npc = TI_D / 16;
              const int p0 = (int)(((long)npc * c0) / wtot), p1 = (int)(((long)npc * c1) / wtot);
              dfirst += 2 * p0; dcount = 2 * (p1 - p0); dgw = P.wave; dngw = NWAVES; }
            pg8::EpiGateUp E{(unsigned char*)Hb};
            if (dcls == 0) convert_items(P, args, dfirst, dcount, dgw, dngw);
            { const ConvHook H{&P, &args, dfirst, dcount, dgw, dngw, dcls == 1 ? 0 : (dcls == 2 ? 2 : -1)};
              pg8::gemm_phase<true>(P.lds, P.tid, (const char*)(P.ws + WS_XF), DM, S, E, H); }
            if (dcls == 3) convert_items(P, args, dfirst, dcount, dgw, dngw);
        }
        SEAM(pb + 6);

        if (PON(8) && IN(pb + 7)) for (int rp_ = 0; rp_ < RPT(8); ++rp_) {
            PHASE_FRAME;
            bf16* XB = (bf16*)(P.ws + WS_XB); float* XF = (float*)(P.ws + WS_XF);
            bf16* Qb = (bf16*)(P.ws + WS_Q); bf16* Kb = (bf16*)(P.ws + WS_K); bf16* Gb = (bf16*)(P.ws + WS_G); bf16* VT = (bf16*)(P.ws + WS_VT);
            bf16* U2 = (bf16*)(P.ws + WS_U2); bf16* Yb = (bf16*)(P.ws + WS_Y); bf16* MIX = (bf16*)(P.ws + WS_MIX); float* Z = (float*)(P.ws + WS_Z);
            bf16* X1B = (bf16*)(P.ws + WS_X1B); bf16* Hb = (bf16*)(P.ws + WS_H); bf16* YB = (bf16*)(P.ws + WS_YB);
            const bf16* Win = (const bf16*)(P.ws + WS_WIN) + (size_t)layer * NPROJ * DM;
            (void)XB; (void)XF; (void)Qb; (void)Kb; (void)Gb; (void)VT; (void)U2; (void)Yb; (void)MIX; (void)Z; (void)X1B; (void)Hb; (void)YB; (void)Win;
            moe_setup(P, layer);
            const LAS int* pst = (const LAS int*)(P.lds + TST_OFF) + 32; const LAS int* fst = pst + 33; const LAS int* hst = fst + 33;
            pg8::MoeOrder<false> S; S.NF = fst[NE] * 8; S.NU = S.NF + hst[NE] * 8; S.G = P.G; S.c = P.vcu; S.pst = pst; S.fst = fst; S.hst = hst; S.table = (const LAS unsigned*)(P.lds + TAB_OFF); S.rowbytes = DE;
            S.ulist = (const LAS int*)(P.lds + TST_OFF + 896);
            S.Bt = (const char*)(P.ws + WS_WDN) + (size_t)layer * NE * DM * DE; S.estepB = (size_t)DM * DE; S.tstepB = (size_t)256 * DE;
            pg8::moe_units(S, (LAS int*)(P.lds + TST_OFF + 896), P.tid); __syncthreads();
            pg8::EpiF8 E{(unsigned char*)YB, DM, W8_INV * 16.0f};
            pg8::gemm_phase<true>(P.lds, P.tid, (const char*)Hb, DE, S, E);
        }
        SEAM(pb + 7);

        if (PON(9) && IN(pb + 8)) for (int rp_ = 0; rp_ < RPT(9); ++rp_) {
            PHASE_FRAME;
            bf16* XB = (bf16*)(P.ws + WS_XB); float* XF = (float*)(P.ws + WS_XF);
            bf16* Qb = (bf16*)(P.ws + WS_Q); bf16* Kb = (bf16*)(P.ws + WS_K); bf16* Gb = (bf16*)(P.ws + WS_G); bf16* VT = (bf16*)(P.ws + WS_VT);
            bf16* U2 = (bf16*)(P.ws + WS_U2); bf16* Yb = (bf16*)(P.ws + WS_Y); bf16* MIX = (bf16*)(P.ws + WS_MIX); float* Z = (float*)(P.ws + WS_Z);
            bf16* X1B = (bf16*)(P.ws + WS_X1B); bf16* Hb = (bf16*)(P.ws + WS_H); bf16* YB = (bf16*)(P.ws + WS_YB);
            const bf16* Win = (const bf16*)(P.ws + WS_WIN) + (size_t)layer * NPROJ * DM;
            (void)XB; (void)XF; (void)Qb; (void)Kb; (void)Gb; (void)VT; (void)U2; (void)Yb; (void)MIX; (void)Z; (void)X1B; (void)Hb; (void)YB; (void)Win;
            moe_setup(P, layer);
            float* outf = layer == 1 ? args.out : (float*)nullptr; bf16* outb = layer == 1 ? (bf16*)nullptr : XB;
            { LAS float* gl = (LAS float*)P.lds;
              { const f32x4 g = *(const f32x4*)(args.in[14] + layer * DM + 4 * P.tid), b = *(const f32x4*)(args.in[15] + layer * DM + 4 * P.tid); *(LAS f32x4*)(gl + 4 * P.tid) = g; *(LAS f32x4*)(gl + DM + 4 * P.tid) = b;
                const f32x4 g1 = *(const f32x4*)(args.in[12] + layer * DM + 4 * P.tid), b1 = *(const f32x4*)(args.in[13] + layer * DM + 4 * P.tid); *(LAS f32x4*)(gl + 2 * DM + 4 * P.tid) = g1; *(LAS f32x4*)(gl + 3 * DM + 4 * P.tid) = b1; }
              __syncthreads();
              const int step = P.G * NWAVES; const int tok0 = P.vcu * NWAVES + P.wave;
#pragma nounroll
              for (int tok = tok0; tok < T; tok += LN2R * step) { int toks[LN2R];
#pragma unroll
                  for (int r = 0; r < LN2R; ++r) toks[r] = (tok + r * step < T) ? tok + r * step : tok;
                  ln2_rows(P, gl, toks, outf, outb); } }
        }
        if (layer == 0) SEAM(pb + 8);
    }
#undef IN
#undef SEAM
}

extern "C" void kernel_launch(void* const* d_in, const int* in_sizes, int n_in, void* d_out, int out_size, void* d_ws, size_t ws_size, hipStream_t stream) {
    static int grid = 0;
    if (grid == 0) {
        if (n_in != 21 || out_size != T * DM || ws_size < WS_END) { fprintf(stderr, "kernel_launch: unexpected problem (n_in %d, out %d, ws %zu; need ws >= %zu)\n", n_in, out_size, ws_size, (size_t)WS_END); grid = -1; return; }
        int dev = 0, cus = 0, per_cu = 0;
        if (hipGetDevice(&dev) != hipSuccess || hipDeviceGetAttribute(&cus, hipDeviceAttributeMultiprocessorCount, dev) != hipSuccess) { grid = -1; return; }
        if (hipFuncSetAttribute((const void*)mk_fwd, hipFuncAttributeMaxDynamicSharedMemorySize, LDS_BYTES) != hipSuccess) { fprintf(stderr, "kernel_launch: hipFuncSetAttribute failed\n"); grid = -1; return; }
        if (hipOccupancyMaxActiveBlocksPerMultiprocessor(&per_cu, (const void*)mk_fwd, NWAVES * 64, LDS_BYTES) != hipSuccess || per_cu < 1) fprintf(stderr, "kernel_launch: occupancy query reports %d\n", per_cu);
        (void)hipGetLastError();
        grid = cus;
    }
    if (grid < 0) return;
    (void)hipMemsetAsync((char*)d_ws + WS_CTL, 0, CTL_ZERO_BYTES, stream);
    Args a{};
    for (int i = 0; i < 21; ++i) a.in[i] = (const float*)d_in[i];
    a.out = (float*)d_out; a.ws = (unsigned char*)d_ws;
#if MK_N_LAUNCHES == 1
    a.ph_lo = 0; a.ph_hi = NPH;
    hipLaunchKernelGGL(mk_fwd, dim3(grid), dim3(NWAVES * 64), LDS_BYTES, stream, a);
#else
    for (int p = 0; p < NPH; ++p) { a.ph_lo = p; a.ph_hi = p + 1; hipLaunchKernelGGL(mk_fwd, dim3(grid), dim3(NWAVES * 64), LDS_BYTES, stream, a); }
#endif
}
```

```cpp
#include <hip/hip_runtime.h>
#include <cstdio>
#include <cstdint>

#ifndef PG8_ALIGN_EPI
#define PG8_ALIGN_EPI 1
#endif
#ifndef PROBE_EPI
#define PROBE_EPI 0
#endif
#ifndef MK_N_LAUNCHES
#define MK_N_LAUNCHES 1
#endif

#define LAS __attribute__((address_space(3)))
#define GAS __attribute__((address_space(1)))
typedef unsigned short bf16;
typedef short bf16x8 __attribute__((ext_vector_type(8)));
typedef float f32x4 __attribute__((ext_vector_type(4)));
typedef float f32x2 __attribute__((ext_vector_type(2)));
typedef unsigned u32x4 __attribute__((ext_vector_type(4)));
typedef unsigned u32x2 __attribute__((ext_vector_type(2)));
typedef int i32x4 __attribute__((ext_vector_type(4)));
typedef int i32x8 __attribute__((ext_vector_type(8)));

constexpr int BATCH = 8, SEQ = 2048, DM = 2048, T = BATCH * SEQ;
constexpr int RW = 1024, HD = 256, NPROJ = 5120;
constexpr int NE = 32, DE = 1024;
constexpr int SGRP = 64, SCH = 16, SST = 64, CS = 16, NCHUNK = SEQ / CS;
constexpr int KS5 = 384;
constexpr float LN_EPS = 1e-5f;
constexpr float ALPHA = 1.41421356237309515f;
constexpr int NPH = 19;

constexpr size_t MiB = 1u << 20;
constexpr size_t WS_CTL = 0, CTL_ZERO_BYTES = 128 * 1024;
constexpr size_t WS_WIN = 1 * MiB;
constexpr size_t WS_WOUT = WS_WIN + 40 * MiB;
constexpr size_t WS_WGLU = WS_WOUT + 16 * MiB;
constexpr size_t WS_WGU = WS_WGLU + 4 * MiB;
constexpr size_t WS_WDN = WS_WGU + 512 * MiB;
constexpr size_t WS_S5OUT = WS_WDN + 256 * MiB;
constexpr size_t WS_S5IN = WS_S5OUT + 24 * MiB;
constexpr size_t WS_S5A = WS_S5IN + 8 * MiB;
constexpr size_t WS_COS = WS_S5A + 1 * MiB;
constexpr size_t WS_SIN = WS_COS + 1 * MiB;
constexpr size_t WS_RWT = WS_SIN + 1 * MiB;
constexpr size_t WS_XB = WS_RWT + 1 * MiB;
constexpr size_t WS_XF = WS_XB + 64 * MiB;
constexpr size_t WS_Y8 = WS_XF + 32 * MiB;
constexpr size_t WS_MIX8 = WS_XF + 64 * MiB;
constexpr size_t WS_XB8 = WS_XF + 96 * MiB;
constexpr size_t WS_Q = WS_XF + 128 * MiB;
constexpr size_t WS_K = WS_Q + 32 * MiB;
constexpr size_t WS_G = WS_K + 32 * MiB;
constexpr size_t WS_VT = WS_G + 32 * MiB;
constexpr size_t WS_U2 = WS_VT + 32 * MiB;
constexpr size_t WS_Y = WS_U2 + 48 * MiB;
constexpr size_t WS_MIX = WS_Y + 32 * MiB;
constexpr size_t WS_Z = WS_MIX + 64 * MiB;
constexpr size_t WS_X1B = WS_Z + 128 * MiB;
constexpr size_t WS_LIST = WS_X1B + 64 * MiB;
constexpr size_t WS_TOK = WS_LIST + 2 * MiB;
constexpr size_t WS_H = WS_TOK + 1 * MiB;
constexpr size_t WS_YB = WS_H + 80 * MiB;
constexpr size_t WS_END = WS_YB + 160 * MiB;
constexpr int CW_BAR = 4096;
constexpr int CW_CNT = 16384;

constexpr int RING_BYTES = 131072;
constexpr int TAB_OFF = 150528;
constexpr int TST_OFF = TAB_OFF + 8192;
constexpr int MISC_OFF = TST_OFF + 1024;
constexpr int LDS_BYTES = 160768;
static_assert(MISC_OFF + 64 <= LDS_BYTES && LDS_BYTES <= 163840, "LDS map");
constexpr int NWAVES = 8;

__device__ __forceinline__ unsigned cvt_pk_bf16(float lo, float hi) { unsigned r; asm volatile("v_cvt_pk_bf16_f32 %0, %1, %2" : "=v"(r) : "v"(lo), "v"(hi)); return r; }
__device__ __forceinline__ float bflo(unsigned w) { return __uint_as_float(w << 16); }
__device__ __forceinline__ float bfhi(unsigned w) { return __uint_as_float(w & 0xffff0000u); }
__device__ __forceinline__ float sigmoid_f(float x) { return __builtin_amdgcn_rcpf(1.0f + __builtin_amdgcn_exp2f(-1.44269504089f * x)); }
__device__ __forceinline__ float silu_f(float x) { return x * sigmoid_f(x); }
__device__ __forceinline__ float gelu_tanh_f(float x) { return x * sigmoid_f(1.59576912161f * (x + 0.044715f * x * x * x)); }
__device__ __forceinline__ unsigned cvt4_fp8(float a, float b, float c, float d) { int w = __builtin_amdgcn_cvt_pk_fp8_f32(a, b, 0, false); w = __builtin_amdgcn_cvt_pk_fp8_f32(c, d, w, true); return (unsigned)w; }
constexpr float W8_SCALE = 64.0f, W8_INV = 1.0f / 64.0f;
__device__ __forceinline__ float wave_sum(float v) {
#define WS_DPP(x, ctrl) __builtin_bit_cast(float, __builtin_amdgcn_update_dpp(0, __builtin_bit_cast(int, (x)), (ctrl), 0xf, 0xf, true))
    v += WS_DPP(v, 0xB1);
    v += WS_DPP(v, 0x4E);
    v += WS_DPP(v, 0x141);
    v += WS_DPP(v, 0x140);
#undef WS_DPP
    const int b = __builtin_bit_cast(int, v);
    return (__builtin_bit_cast(float, __builtin_amdgcn_readlane(b, 0)) + __builtin_bit_cast(float, __builtin_amdgcn_readlane(b, 16)))
         + (__builtin_bit_cast(float, __builtin_amdgcn_readlane(b, 32)) + __builtin_bit_cast(float, __builtin_amdgcn_readlane(b, 48)));
}
#define VM_WAIT() asm volatile("s_waitcnt vmcnt(0)" ::: "memory")
#define LDS_WAIT() asm volatile("s_waitcnt lgkmcnt(0)" ::: "memory")

namespace pg8 {
constexpr int BM = 256, BK = 64, HALF = 128, HTB = HALF * BK * 2, STAGE_BYTES = 8 * HTB, NXCD = 8, WGM = 8;
__host__ __device__ __forceinline__ int lds_byte(int r, int c) { const int st = (r >> 4) * 2 + (c >> 5), rr = r & 15, cc = c & 31, ob = rr * 64 + cc * 2; return st * 1024 + (ob ^ (((ob >> 9) & 1) << 5)); }
__host__ __device__ __forceinline__ void stage_rc(int b, int& R, int& C) { const int st = b / 1024, sb = b % 1024, swz = sb ^ (((sb >> 9) & 1) << 5); R = (st >> 1) * 16 + swz / 64; C = (st & 1) * 32 + (swz % 64) / 2; }
__host__ __device__ __forceinline__ int perm32(int rho) { const int n = rho >> 4, i = rho & 15; return 8 * (i >> 2) + 4 * n + (i & 3); }

struct Unit { int pm, pn, e, li; };
__device__ __forceinline__ void glds16s(const char* sbase, unsigned voff, unsigned lds_dst) { unsigned keep;
    asm volatile("s_mov_b32 %0, m0\n\ts_mov_b32 m0, %3\n\ts_nop 2\n\tglobal_load_lds_dwordx4 %1, %2\n\ts_mov_b32 m0, %0" : "=&s"(keep) : "v"(voff), "s"(sbase), "s"(lds_dst) : "memory"); }

struct NoHook { static constexpr bool ON = false; __device__ __forceinline__ void operator()(int) const {} };
template <bool FP8, class Epi, class Sched, class Hook = NoHook>
__device__ __forceinline__ void gemm_phase(LAS unsigned char* lds, const int tid, const char* Abase, const int Kc, const Sched& S, const Epi& E, const Hook& H = Hook()) {
    int K = Kc; asm volatile("" : "+s"(K));
    const int wid = __builtin_amdgcn_readfirstlane(tid >> 6), lane = tid & 63, wr = wid >> 2, wc = wid & 3, fr = lane & 15, fq = lane >> 4;
    const int nt = FP8 ? K / 128 : K / BK;
    int R0, C0; stage_rc(tid * 16, R0, C0);
    const int Rb0 = Epi::PERM ? ((R0 & ~31) + perm32(R0 & 31)) : R0;
    const unsigned Cb0 = (unsigned)C0 * 2u;
    const unsigned voffB0 = FP8 ? (unsigned)(Rb0 * K) + Cb0 : (unsigned)(Rb0 * K) * 2u + Cb0;
    const size_t bstep64 = (size_t)64 * K * (FP8 ? 1 : 2);
    const size_t hstepB = 2 * bstep64;
    const unsigned ldsw = (unsigned)wid * 1024u; const unsigned ldsb = (unsigned)(size_t)lds + ldsw;
    const int aoff = lds_byte(wr * 64 + fr, fq * 8), boff = lds_byte(wc * 32 + fr, fq * 8);
    struct AOff { unsigned o0, o1, o2, o3; };
    const unsigned rb64 = Sched::GATHER ? 0u : S.rowstep() * 64u;
#define PG8_LOAD_AO(AO, U, rr) do { if constexpr (Sched::GATHER) { AO.o0 = S.rowoff(U, (rr)) + Cb0; AO.o1 = S.rowoff(U, (rr) + 64) + Cb0; AO.o2 = S.rowoff(U, (rr) + 128) + Cb0; AO.o3 = S.rowoff(U, (rr) + 192) + Cb0; } \
        else { AO.o0 = S.rowoff(U, (rr)) + Cb0; AO.o1 = 0u; AO.o2 = 0u; AO.o3 = 0u; } } while (0)
#define PG8_SA(b, h) (((b) * 2 + (h)) * HTB)
#define PG8_SB(b, h) ((4 + (b) * 2 + (h)) * HTB)
#define PG8_STAGE_B(bufoff, gbase) do { const char* gb_ = (const char*)(gbase); \
        glds16s(gb_, voffB0, ldsb + (unsigned)(bufoff)); glds16s(gb_ + bstep64, voffB0, ldsb + (unsigned)(bufoff) + 8192u); } while (0)
#define PG8_STAGE_A(bufoff, AO, h, kb) do { \
        if constexpr (Sched::GATHER) { const char* ab_ = Abase + (size_t)(kb); \
            glds16s(ab_, (h) ? AO.o2 : AO.o0, ldsb + (unsigned)(bufoff)); glds16s(ab_, (h) ? AO.o3 : AO.o1, ldsb + (unsigned)(bufoff) + 8192u); \
        } else { const char* ab_ = Abase + (size_t)(kb) + (size_t)((h) * 2) * rb64; \
            glds16s(ab_, AO.o0, ldsb + (unsigned)(bufoff)); glds16s(ab_ + rb64, AO.o0, ldsb + (unsigned)(bufoff) + 8192u); } } while (0)
#define PG8_LDA(dst, b, h) do { _Pragma("unroll") for (int m = 0; m < 4; ++m) _Pragma("unroll") for (int k = 0; k < 2; ++k) dst[m][k] = *(const LAS bf16x8*)(lds + PG8_SA(b, h) + aoff + m * 2048 + k * 1024); } while (0)
#define PG8_LDB(dst, b, h) do { _Pragma("unroll") for (int n = 0; n < 2; ++n) _Pragma("unroll") for (int k = 0; k < 2; ++k) dst[n][k] = *(const LAS bf16x8*)(lds + PG8_SB(b, h) + boff + n * 2048 + k * 1024); } while (0)
#define PG8_MMA(ai, bj, At, Bt) do { __builtin_amdgcn_s_setprio(1); _Pragma("unroll") for (int m = 0; m < 4; ++m) _Pragma("unroll") for (int n = 0; n < 2; ++n) { \
        if constexpr (FP8) { \
            const i32x8 bq_ = __builtin_shufflevector(__builtin_bit_cast(i32x4, Bt[n][0]), __builtin_bit_cast(i32x4, Bt[n][1]), 0, 1, 2, 3, 4, 5, 6, 7); \
            const i32x8 aq_ = __builtin_shufflevector(__builtin_bit_cast(i32x4, At[m][0]), __builtin_bit_cast(i32x4, At[m][1]), 0, 1, 2, 3, 4, 5, 6, 7); \
            asm volatile("s_nop 1\n\tv_mfma_f32_16x16x128_f8f6f4 %0, %1, %2, %0" : "+v"(acc[ai][bj][m][n]) : "v"(bq_), "v"(aq_));   \
        } else { _Pragma("unroll") for (int k = 0; k < 2; ++k) \
            acc[ai][bj][m][n] = __builtin_amdgcn_mfma_f32_16x16x32_bf16(Bt[n][k], At[m][k], acc[ai][bj][m][n], 0, 0, 0); } } \
        __builtin_amdgcn_s_setprio(0); } while (0)
#define PG8_WAIT_V(n) asm volatile("s_waitcnt vmcnt(" #n ")" ::: "memory")
#define PG8_WAIT_VN(n) asm volatile("s_waitcnt vmcnt(%0)" :: "n"(n) : "memory")
#define PG8_WAIT_V8F() do { if (fa) PG8_WAIT_VN(8 + Epi::NST); else PG8_WAIT_V(8); } while (0)
#define PG8_WAIT_V6F() do { if (fa) PG8_WAIT_VN(6 + Epi::NST); else PG8_WAIT_V(6); } while (0)
#define PG8_WAIT_L(n) asm volatile("s_waitcnt lgkmcnt(" #n ")" ::: "memory")
#define PG8_BAR __builtin_amdgcn_s_barrier()
#define PG8_SCHED __builtin_amdgcn_sched_barrier(0)
    Unit cur, nxt; int ui = 0;
    if (!S.next(0, cur)) return;
    f32x4 acc[2][2][4][2];
#pragma unroll
    for (int a = 0; a < 2; ++a)
#pragma unroll
        for (int b = 0; b < 2; ++b)
#pragma unroll
            for (int m = 0; m < 4; ++m)
#pragma unroll
                for (int n = 0; n < 2; ++n) acc[a][b][m][n] = (f32x4){0.f, 0.f, 0.f, 0.f};
    bf16x8 At[4][2], B0[2][2], B1[2][2];
    AOff oc; PG8_LOAD_AO(oc, cur, R0);
    const char* cB = S.bbase(cur);
    PG8_STAGE_B(PG8_SB(0, 0), cB); PG8_STAGE_B(PG8_SB(0, 1), cB + hstepB); PG8_STAGE_A(PG8_SA(0, 0), oc, 0, 0u); PG8_STAGE_A(PG8_SA(0, 1), oc, 1, 0u);
    if (wr == 1) PG8_BAR;
    PG8_WAIT_V(2); PG8_BAR;
    PG8_STAGE_B(PG8_SB(1, 0), cB + 128); PG8_STAGE_A(PG8_SA(1, 0), oc, 0, 128u); PG8_STAGE_B(PG8_SB(1, 1), cB + hstepB + 128);
    PG8_WAIT_V(6); PG8_BAR;
    for (;;) {
        const bool has_next = S.next(ui + 1, nxt);
        const char* nB = has_next ? S.bbase(nxt) : cB;
        const bool hcur = Sched::HALFABLE ? S.half(cur) : false;
        for (int t = 0; t < nt; t += 2) {
            const bool last = (t == nt - 2);
            const unsigned kb1 = (unsigned)(t + 1) * 128u, kb2 = last ? 0u : (unsigned)(t + 2) * 128u, kb3 = kb2 + 128u;
            AOff pn = oc;
            if (last && has_next) { int t_ = (int)__builtin_amdgcn_mbcnt_hi(~0u, __builtin_amdgcn_mbcnt_lo(~0u, 0u)); asm volatile("" : "+v"(t_));
                int r0_, c0_; stage_rc((wid * 64 + t_) * 16, r0_, c0_); const unsigned Cb0 = (unsigned)c0_ * 2u; PG8_LOAD_AO(pn, nxt, r0_); }
            const char* b2 = last ? nB : cB + (size_t)(t + 2) * 128; const char* b3 = b2 + 128;
            const bool fa = FP8 && (t == 0) && (ui > 0);
            PG8_LDB(B0, 0, 0); PG8_LDB(B1, 0, 1); PG8_SCHED; PG8_LDA(At, 0, 0); if (!fa) PG8_STAGE_A(PG8_SA(1, 1), oc, 1, kb1);
            PG8_WAIT_V8F(); PG8_WAIT_L(0); PG8_BAR; PG8_MMA(0, 0, At, B0); PG8_MMA(0, 1, At, B1); PG8_BAR; PG8_SCHED;
            if (!hcur) PG8_LDA(At, 0, 1); PG8_STAGE_B(PG8_SB(0, 0), b2); PG8_STAGE_B(PG8_SB(0, 1), b2 + hstepB);
            PG8_WAIT_V6F(); PG8_WAIT_L(0); PG8_BAR; if (!hcur) PG8_MMA(1, 0, At, B0); PG8_STAGE_A(PG8_SA(0, 0), pn, 0, kb2); if (!hcur) PG8_MMA(1, 1, At, B1); PG8_BAR; PG8_SCHED;
            PG8_LDB(B0, 1, 0); PG8_LDB(B1, 1, 1); PG8_SCHED; PG8_LDA(At, 1, 0); PG8_STAGE_A(PG8_SA(0, 1), pn, 1, kb2);
            PG8_WAIT_V8F(); PG8_WAIT_L(0); PG8_BAR; PG8_MMA(0, 0, At, B0); PG8_MMA(0, 1, At, B1); PG8_BAR; PG8_SCHED;
            if (!hcur) PG8_LDA(At, 1, 1); PG8_STAGE_B(PG8_SB(1, 0), b3); PG8_STAGE_B(PG8_SB(1, 1), b3 + hstepB);
            PG8_WAIT_V(6); PG8_WAIT_L(0); PG8_BAR; if (!hcur) PG8_MMA(1, 0, At, B0); PG8_STAGE_A(PG8_SA(1, 0), pn, 0, kb3); if (!hcur) PG8_MMA(1, 1, At, B1); PG8_BAR; PG8_SCHED;
            if (FP8 && last && has_next) PG8_STAGE_A(PG8_SA(1, 1), pn, 1, 128u);
        }
        if constexpr (FP8) { asm volatile("s_nop 15\n\ts_nop 15" ::: "memory"); }
        if (PG8_ALIGN_EPI) { if (wr == 0) PG8_BAR; }
        { int l_ = (int)__builtin_amdgcn_mbcnt_hi(~0u, __builtin_amdgcn_mbcnt_lo(~0u, 0u)); asm volatile("" : "+v"(l_));
          E(acc, cur, wr, wc, l_ & 15, l_ >> 4);
          if (PROBE_EPI) { asm volatile("" ::: "memory"); E(acc, cur, wr, wc, l_ & 15, l_ >> 4); } }
        if (!has_next) break;
        if constexpr (Hook::ON) { if (H.wants(ui)) { H(ui); asm volatile("s_waitcnt vmcnt(0)" ::: "memory"); } }
#pragma unroll
        for (int a = 0; a < 2; ++a)
#pragma unroll
            for (int b = 0; b < 2; ++b)
#pragma unroll
                for (int m = 0; m < 4; ++m)
#pragma unroll
                    for (int n = 0; n < 2; ++n) acc[a][b][m][n] = (f32x4){0.f, 0.f, 0.f, 0.f};
        cur = nxt; cB = nB; ++ui;
        { int t_ = (int)__builtin_amdgcn_mbcnt_hi(~0u, __builtin_amdgcn_mbcnt_lo(~0u, 0u)); asm volatile("" : "+v"(t_));
          int r0_, c0_; stage_rc((wid * 64 + t_) * 16, r0_, c0_); const unsigned Cb0 = (unsigned)c0_ * 2u; PG8_LOAD_AO(oc, cur, r0_); }
        if (PG8_ALIGN_EPI) { if (wr == 1) PG8_BAR; }
    }
    PG8_WAIT_V(0);
    if (!PG8_ALIGN_EPI) { if (wr == 0) PG8_BAR; }
    PG8_BAR;
#undef PG8_SA
#undef PG8_SB
#undef PG8_STAGE_A
#undef PG8_LOAD_AO
#undef PG8_STAGE_B
#undef PG8_LDA
#undef PG8_LDB
#undef PG8_MMA
#undef PG8_WAIT_V
#undef PG8_WAIT_VN
#undef PG8_WAIT_V8F
#undef PG8_WAIT_V6F
#undef PG8_WAIT_V6F
#undef PG8_WAIT_L
#undef PG8_BAR
#undef PG8_SCHED
}

struct DenseOrder {
    static constexpr bool GATHER = false, HALFABLE = false;
    __device__ __forceinline__ bool half(const Unit&) const { return false; }
    int nM, nN, nwg, G, c; unsigned rowbytes; const char* Bt; size_t tstepB;
    __device__ __forceinline__ unsigned rowstep() const { return rowbytes; }
    __device__ __forceinline__ void init(int M, int N, int K, int G_, int c_, const void* Bt_, int eb = 2) { nM = M / BM; nN = N / BM; nwg = nM * nN; G = G_; c = c_; rowbytes = (unsigned)(K * eb); Bt = (const char*)Bt_; tstepB = (size_t)BM * K * eb; }
    const LAS int* ulist;
    __device__ __forceinline__ bool next(int i, Unit& u) const { if (i >= 8) return false; const i32x4 v = *(const LAS i32x4*)(ulist + 4 * i); u.pm = v[0]; u.pn = v[1]; u.e = v[2]; u.li = i; return v[3] != 0; }
    __device__ __forceinline__ bool find(int i, Unit& u) const {
        const long L = (long)i * G + c; if (L >= nwg) return false;
        int wgid = (int)L; { const int q = nwg / NXCD, r = nwg % NXCD, xcd = wgid % NXCD, off = wgid / NXCD; wgid = (xcd < r ? xcd * (q + 1) : r * (q + 1) + (xcd - r) * q) + off; }
        const int nig = WGM * nN, gid = wgid / nig, fm = gid * WGM, gsz = (nM - fm) < WGM ? (nM - fm) : WGM;
        u.pm = fm + ((wgid % nig) % gsz); u.pn = (wgid % nig) / gsz; u.e = 0; u.li = i; return true;
    }
    __device__ __forceinline__ unsigned rowoff(const Unit& u, int r) const { return (unsigned)(u.pm * BM + r) * rowbytes; }
    __device__ __forceinline__ const char* bbase(const Unit& u) const { return Bt + (size_t)u.pn * tstepB; }
};
struct S5Order {
    static constexpr bool GATHER = false, HALFABLE = false;
    __device__ __forceinline__ bool half(const Unit&) const { return false; }
    int G, c; const char* Bt;
    __device__ __forceinline__ unsigned rowstep() const { return (unsigned)(KS5 * 2); }
    const LAS int* ulist;
    __device__ __forceinline__ bool next(int i, Unit& u) const { if (i >= 8) return false; const i32x4 v = *(const LAS i32x4*)(ulist + 4 * i); u.pm = v[0]; u.pn = v[1]; u.e = v[2]; u.li = i; return v[3] != 0; }
    __device__ __forceinline__ bool find(int i, Unit& u) const { const int L = i * G + c; if (L >= 256) return false; u.pm = L; u.pn = L >> 2; u.e = 0; u.li = i; return true; }
    __device__ __forceinline__ unsigned rowoff(const Unit& u, int r) const { return (unsigned)(u.pm * BM + r) * (unsigned)(KS5 * 2); }
    __device__ __forceinline__ const char* bbase(const Unit& u) const { return Bt + (size_t)u.pn * (size_t)(BM * KS5 * 2); }
};
template <bool GATHER_> struct MoeOrder {
    static constexpr bool GATHER = GATHER_, HALFABLE = true;
    int NF, NU, G, c; const LAS int* pst; const LAS int* fst; const LAS int* hst; const LAS unsigned* table; const char* Bt; size_t estepB, tstepB; unsigned rowbytes;
    __device__ __forceinline__ unsigned rowstep() const { return rowbytes; }
    const LAS int* ulist;
    __device__ __forceinline__ bool find(int i, Unit& u) const {
        const int L = i * G + c; if (L >= NU) return false;
        int e = 0;
        if (L < NF) { const int rt = L >> 3; while (e < NE - 1 && fst[e + 1] <= rt) ++e; u.pm = (pst[e] + 2 * (rt - fst[e])) * 128; u.e = e; }
        else { const int hh = (L - NF) >> 3; while (e < NE - 1 && hst[e + 1] <= hh) ++e; u.pm = (pst[e + 1] - 1) * 128; u.e = e | 256; }
        u.pn = L & 7; u.li = i; return true;
    }
    int ibeg = 0, iend = 8;
    __device__ __forceinline__ bool next(int i, Unit& u) const {
        const int j = ibeg + i; if (j >= iend) return false;
        const i32x4 v = *(const LAS i32x4*)(ulist + 4 * j);
        u.pm = v[0]; u.pn = v[1]; u.e = v[2]; u.li = j; return v[3] != 0;
    }
    __device__ __forceinline__ bool half(const Unit& u) const { return (u.e & 256) != 0; }
    __device__ __forceinline__ unsigned rowoff(const Unit& u, int r) const { if constexpr (GATHER_) return table[u.li * 256 + r]; else return (unsigned)(u.pm + r) * rowbytes; }
    __device__ __forceinline__ const char* bbase(const Unit& u) const { return Bt + (size_t)(u.e & 255) * estepB + (size_t)u.pn * tstepB; }
};

template <class MO> __device__ __forceinline__ void moe_units(const MO& S, LAS int* ulist, int tid) {
    if (tid < 8) { Unit u; u.pm = 0; u.pn = 0; u.e = 0; u.li = tid; const bool ok = S.find(tid, u); *(LAS i32x4*)(ulist + 4 * tid) = (i32x4){u.pm, u.pn, u.e, ok ? 1 : 0}; }
}

struct EpiInProj {
    static constexpr int NST = 16;
    static constexpr bool PERM = true;
    bf16 *Q, *Kk, *Gs, *U2; const float *cosT, *sinT;
    __device__ __forceinline__ void operator()(const f32x4 (&acc)[2][2][4][2], const Unit& u, int wr, int wc, int fr, int fq) const {
        const int seg = u.pn >> 2;
        const int colseg = (u.pn & 3) * 256 + wc * 32 + 8 * fq;
        const int hd_ = u.pn & 3;
        const float lgam = hd_ == 0 ? -0.045803689613f : hd_ == 1 ? -0.022720076500f : hd_ == 2 ? -0.011315313227f : -0.005646563141f;
        if (seg <= 1) {
            bf16* const O = (seg == 0) ? Q : Kk;
            float frq[2][4];
#pragma unroll
            for (int bj = 0; bj < 2; ++bj) { const int i0 = ((colseg + bj * HALF) & (HD - 1)) >> 1;
#pragma unroll
                for (int j = 0; j < 4; ++j) frq[bj][j] = __builtin_amdgcn_exp2f(-0.10381025296523f * (float)(i0 + j)) * 0.15915494309189535f; }
#pragma unroll
            for (int ai = 0; ai < 2; ++ai) {
#pragma unroll
                for (int m = 0; m < 4; ++m) { const int row = u.pm * BM + ai * HALF + wr * 64 + m * 16 + fr; const int tpos = row & (SEQ - 1); const float tf = (float)tpos;
                    const float fdec = (seg == 0) ? W8_INV * __builtin_amdgcn_exp2f(lgam * tf) : (W8_INV * 0.0625f) * __builtin_amdgcn_exp2f(-lgam * tf);
#pragma unroll
                    for (int bj = 0; bj < 2; ++bj) { const int col = colseg + bj * HALF; const f32x4 v0 = acc[ai][bj][m][0] * fdec, v1 = acc[ai][bj][m][1] * fdec; f32x4 c, sn;
#pragma unroll
                        for (int j = 0; j < 4; ++j) { const float x = __builtin_amdgcn_fractf(tf * frq[bj][j]); c[j] = __builtin_amdgcn_cosf(x); sn[j] = __builtin_amdgcn_sinf(x); }
                        u32x4 w; w.x = cvt_pk_bf16(v0[0] * c[0] - v0[1] * sn[0], v0[0] * sn[0] + v0[1] * c[0]); w.y = cvt_pk_bf16(v0[2] * c[1] - v0[3] * sn[1], v0[2] * sn[1] + v0[3] * c[1]);
                        w.z = cvt_pk_bf16(v1[0] * c[2] - v1[1] * sn[2], v1[0] * sn[2] + v1[1] * c[2]); w.w = cvt_pk_bf16(v1[2] * c[3] - v1[3] * sn[3], v1[2] * sn[3] + v1[3] * c[3]);
                        *(u32x4*)(O + (size_t)row * RW + col) = w; } }
            }
        } else {
#pragma unroll
            for (int ai = 0; ai < 2; ++ai)
#pragma unroll
                for (int m = 0; m < 4; ++m) {
                    const int row = u.pm * BM + ai * HALF + wr * 64 + m * 16 + fr; const int tpos = row & (SEQ - 1);
#pragma unroll
                    for (int bj = 0; bj < 2; ++bj) {
                        const int col = colseg + bj * HALF; const f32x4 v0 = acc[ai][bj][m][0] * W8_INV, v1 = acc[ai][bj][m][1] * W8_INV;
                        if (seg == 2) {
                            u32x4 w; w.x = cvt_pk_bf16(silu_f(v0[0]), silu_f(v0[1])); w.y = cvt_pk_bf16(silu_f(v0[2]), silu_f(v0[3])); w.z = cvt_pk_bf16(silu_f(v1[0]), silu_f(v1[1])); w.w = cvt_pk_bf16(silu_f(v1[2]), silu_f(v1[3]));
                            *(u32x4*)(Gs + (size_t)row * RW + col) = w;
                        } else {
                            const int gidx = col >> 4, ch0 = col & 15, b = row >> 11, c = tpos >> 4, tt = tpos & 15;
                            u32x4 w; w.x = cvt_pk_bf16(v0[0], v0[1]); w.y = cvt_pk_bf16(v0[2], v0[3]); w.z = cvt_pk_bf16(v1[0], v1[1]); w.w = cvt_pk_bf16(v1[2], v1[3]);
                            *(u32x4*)(U2 + (size_t)(gidx * 1024 + b * 128 + c) * KS5 + tt * 16 + ch0) = w;
                        }
                    }
                }
        }
    }
};
struct EpiBf16 {
    static constexpr int NST = 16;
    static constexpr bool PERM = true;
    bf16* O; int ldc; float sc;
    __device__ __forceinline__ void operator()(const f32x4 (&acc)[2][2][4][2], const Unit& u, int wr, int wc, int fr, int fq) const {
        const int row0 = u.pm * BM + wr * 64 + fr, col0 = u.pn * BM + wc * 32 + 8 * fq;
#pragma unroll
        for (int ai = 0; ai < 2; ++ai)
#pragma unroll
            for (int m = 0; m < 4; ++m) { bf16* rowp = O + (size_t)(row0 + ai * HALF + m * 16) * ldc + col0;
#pragma unroll
                for (int bj = 0; bj < 2; ++bj) { const f32x4 v0 = acc[ai][bj][m][0] * sc, v1 = acc[ai][bj][m][1] * sc;
                    u32x4 w; w.x = cvt_pk_bf16(v0[0], v0[1]); w.y = cvt_pk_bf16(v0[2], v0[3]); w.z = cvt_pk_bf16(v1[0], v1[1]); w.w = cvt_pk_bf16(v1[2], v1[3]);
                    *(u32x4*)(rowp + bj * HALF) = w; } }
    }
};
struct EpiF8 {
    static constexpr int NST = 8;
    static constexpr bool PERM = true;
    unsigned char* O; int ldc; float sc;
    __device__ __forceinline__ void operator()(const f32x4 (&acc)[2][2][4][2], const Unit& u, int wr, int wc, int fr, int fq) const {
        const int row0 = u.pm + wr * 64 + fr, col0 = u.pn * BM + wc * 32 + 8 * fq; const int nai = (u.e & 256) ? 1 : 2;
#pragma unroll
        for (int ai = 0; ai < 2; ++ai) if (ai < nai)
#pragma unroll
            for (int m = 0; m < 4; ++m) { unsigned char* rowp = O + (size_t)(row0 + ai * HALF + m * 16) * ldc + col0;
#pragma unroll
                for (int bj = 0; bj < 2; ++bj) { const f32x4 v0 = acc[ai][bj][m][0] * sc, v1 = acc[ai][bj][m][1] * sc;
                    u32x2 w; w.x = cvt4_fp8(v0[0], v0[1], v0[2], v0[3]); w.y = cvt4_fp8(v1[0], v1[1], v1[2], v1[3]);
                    *(u32x2*)(rowp + bj * HALF) = w; } }
    }
};
struct EpiS5Out {
    static constexpr int NST = 32;
    static constexpr bool PERM = true;
    bf16* Y; unsigned char* Y8;
    __device__ __forceinline__ void operator()(const f32x4 (&acc)[2][2][4][2], const Unit& u, int wr, int wc, int fr, int fq) const {
#pragma unroll
        for (int ai = 0; ai < 2; ++ai)
#pragma unroll
            for (int m = 0; m < 4; ++m) {
                const int R = u.pm * BM + ai * HALF + wr * 64 + m * 16 + fr; const int gidx = R >> 10, b = (R >> 7) & 7, c = R & 127;
#pragma unroll
                for (int bj = 0; bj < 2; ++bj) {
                    const int n = bj * HALF + wc * 32 + 8 * fq, tt = n >> 4, ch0 = n & 15;
                    const f32x4 v0 = acc[ai][bj][m][0], v1 = acc[ai][bj][m][1];
                    u32x4 w; w.x = cvt_pk_bf16(gelu_tanh_f(v0[0]), gelu_tanh_f(v0[1])); w.y = cvt_pk_bf16(gelu_tanh_f(v0[2]), gelu_tanh_f(v0[3]));
                    w.z = cvt_pk_bf16(gelu_tanh_f(v1[0]), gelu_tanh_f(v1[1])); w.w = cvt_pk_bf16(gelu_tanh_f(v1[2]), gelu_tanh_f(v1[3]));
                    const size_t yo = (size_t)(b * SEQ + c * CS + tt) * 1024 + gidx * 16 + ch0;
                    *(u32x4*)(Y + yo) = w;
                    u32x2 w8; w8.x = cvt4_fp8(bflo(w.x), bfhi(w.x), bflo(w.y), bfhi(w.y)); w8.y = cvt4_fp8(bflo(w.z), bfhi(w.z), bflo(w.w), bfhi(w.w));
                    *(u32x2*)(Y8 + yo) = w8;
                }
            }
    }
};
struct EpiGlu {
    static constexpr int NST = 16;
    static constexpr bool PERM = true;
    const bf16* Y; unsigned char* MIX8;
    __device__ __forceinline__ void operator()(const f32x4 (&acc)[2][2][4][2], const Unit& u, int wr, int wc, int fr, int fq) const {
        const int row0 = u.pm * BM + wr * 64 + fr, col0 = u.pn * BM + wc * 32 + 8 * fq;
        u32x4 yv[2][4][2];
#pragma unroll
        for (int ai = 0; ai < 2; ++ai)
#pragma unroll
            for (int m = 0; m < 4; ++m)
#pragma unroll
                for (int bj = 0; bj < 2; ++bj) yv[ai][m][bj] = *(const u32x4*)(Y + (size_t)(row0 + ai * HALF + m * 16) * 1024 + col0 + bj * HALF);
#pragma unroll
        for (int ai = 0; ai < 2; ++ai)
#pragma unroll
            for (int m = 0; m < 4; ++m) { const int row = row0 + ai * HALF + m * 16;
#pragma unroll
                for (int bj = 0; bj < 2; ++bj) { const int col = col0 + bj * HALF; const f32x4 v0 = acc[ai][bj][m][0] * W8_INV, v1 = acc[ai][bj][m][1] * W8_INV;
                    const u32x4 y = yv[ai][m][bj];
                    u32x2 w; w.x = cvt4_fp8(bflo(y.x) * sigmoid_f(v0[0]), bfhi(y.x) * sigmoid_f(v0[1]), bflo(y.y) * sigmoid_f(v0[2]), bfhi(y.y) * sigmoid_f(v0[3]));
                    w.y = cvt4_fp8(bflo(y.z) * sigmoid_f(v1[0]), bfhi(y.z) * sigmoid_f(v1[1]), bflo(y.w) * sigmoid_f(v1[2]), bfhi(y.w) * sigmoid_f(v1[3]));
                    *(u32x2*)(MIX8 + (size_t)row * DM + 1024 + col) = w; } }
    }
};
template <bool XF32> struct EpiResid {
    static constexpr int NST = 16;
    static constexpr bool PERM = true;
    const void* xin_; bf16* Z;
    __device__ __forceinline__ void operator()(const f32x4 (&acc)[2][2][4][2], const Unit& u, int wr, int wc, int fr, int fq) const {
        const int row0 = u.pm * BM + wr * 64 + fr, col0 = u.pn * BM + wc * 32 + 8 * fq;
#pragma unroll
        for (int ai = 0; ai < 2; ++ai) {
            f32x4 xf0[XF32 ? 4 : 1][2], xf1[XF32 ? 4 : 1][2]; u32x4 xb[XF32 ? 1 : 4][2];
#pragma unroll
            for (int m = 0; m < 4; ++m)
#pragma unroll
                for (int bj = 0; bj < 2; ++bj) { const size_t off = (size_t)(row0 + ai * HALF + m * 16) * DM + col0 + bj * HALF;
                    if constexpr (XF32) { const float* xf = (const float*)xin_ + off; xf0[m][bj] = __builtin_nontemporal_load((const f32x4*)xf); xf1[m][bj] = __builtin_nontemporal_load((const f32x4*)(xf + 4)); }
                    else xb[m][bj] = __builtin_nontemporal_load((const u32x4*)((const bf16*)xin_ + off)); }
#pragma unroll
            for (int m = 0; m < 4; ++m) { const size_t off = (size_t)(row0 + ai * HALF + m * 16) * DM + col0;
#pragma unroll
                for (int bj = 0; bj < 2; ++bj) { const f32x4 v0 = acc[ai][bj][m][0] * W8_INV, v1 = acc[ai][bj][m][1] * W8_INV;
                    u32x4 w;
                    if constexpr (XF32) { const f32x4 x0 = xf0[m][bj], x1 = xf1[m][bj];
                        w.x = cvt_pk_bf16(ALPHA * x0[0] + v0[0], ALPHA * x0[1] + v0[1]); w.y = cvt_pk_bf16(ALPHA * x0[2] + v0[2], ALPHA * x0[3] + v0[3]);
                        w.z = cvt_pk_bf16(ALPHA * x1[0] + v1[0], ALPHA * x1[1] + v1[1]); w.w = cvt_pk_bf16(ALPHA * x1[2] + v1[2], ALPHA * x1[3] + v1[3]);
                    } else { const u32x4 x = xb[m][bj];
                        w.x = cvt_pk_bf16(ALPHA * bflo(x.x) + v0[0], ALPHA * bfhi(x.x) + v0[1]); w.y = cvt_pk_bf16(ALPHA * bflo(x.y) + v0[2], ALPHA * bfhi(x.y) + v0[3]);
                        w.z = cvt_pk_bf16(ALPHA * bflo(x.z) + v1[0], ALPHA * bfhi(x.z) + v1[1]); w.w = cvt_pk_bf16(ALPHA * bflo(x.w) + v1[2], ALPHA * bfhi(x.w) + v1[3]); }
                    *(u32x4*)(Z + off + bj * HALF) = w; } }
        }
    }
};
struct EpiGateUp {
    static constexpr int NST = 4;
    static constexpr bool PERM = true;
    unsigned char* H;
    __device__ __forceinline__ void operator()(const f32x4 (&acc)[2][2][4][2], const Unit& u, int wr, int wc, int fr, int fq) const {
        const int row0 = u.pm + wr * 64 + fr, col0 = u.pn * HALF + wc * 32 + 8 * fq; const int nai = (u.e & 256) ? 1 : 2;
#pragma unroll
        for (int ai = 0; ai < 2; ++ai) if (ai < nai)
#pragma unroll
            for (int m = 0; m < 4; ++m) { const f32x4 g0 = acc[ai][0][m][0] * W8_INV, g1 = acc[ai][0][m][1] * W8_INV, u0 = acc[ai][1][m][0] * W8_INV, u1 = acc[ai][1][m][1] * W8_INV;
                u32x2 w; w.x = cvt4_fp8(silu_f(g0[0]) * u0[0], silu_f(g0[1]) * u0[1], silu_f(g0[2]) * u0[2], silu_f(g0[3]) * u0[3]);
                w.y = cvt4_fp8(silu_f(g1[0]) * u1[0], silu_f(g1[1]) * u1[1], silu_f(g1[2]) * u1[2], silu_f(g1[3]) * u1[3]);
                *(u32x2*)(H + (size_t)(row0 + ai * HALF + m * 16) * DE + col0) = w; }
    }
};
}

#define XB_TMO      128
#define XB_XCNT(j)  (256  + 64 * (j))
#define XB_XSUB(j)  (1280 + 64 * (j))
#define XB_XGEN(j)  (2304 + 64 * (j))
#define XB_TOP      3328
#define XB_TOPGEN   3392
#define XCD_BAR_WORDS 3456
#define XB_SPIN_CAP (1u << 18)

__device__ __forceinline__ unsigned xb_ld(unsigned* p)              { return __hip_atomic_load(p, __ATOMIC_RELAXED, __HIP_MEMORY_SCOPE_AGENT); }
__device__ __forceinline__ unsigned xb_add(unsigned* p, unsigned v) { return __hip_atomic_fetch_add(p, v, __ATOMIC_RELAXED, __HIP_MEMORY_SCOPE_AGENT); }
__device__ __forceinline__ unsigned xb_xcc_id() { return (unsigned)__builtin_amdgcn_s_getreg((3 << 11) | 20) & 0xFu; }
#define XB_SPIN(cond, bar) do { unsigned _sp = 0; while (cond) { __builtin_amdgcn_s_sleep(1); \
    if ((++_sp & 255u) == 0u) { if (xb_ld(&(bar)[XB_TMO])) break; if (_sp > XB_SPIN_CAP) { atomicAdd(&(bar)[XB_TMO], 1u); break; } } } } while (0)

struct XcdBarrier { unsigned* bar; unsigned x; volatile LAS unsigned* st; };

__device__ __forceinline__ XcdBarrier xcd_barrier_post(unsigned* bar, volatile LAS unsigned* st) {
    XcdBarrier b; b.bar = bar; b.x = xb_xcc_id(); b.st = st;
    if (threadIdx.x == 0) (void)xb_add(&bar[XB_XCNT(b.x)], 1u);
    return b;
}
__device__ __forceinline__ void xcd_barrier_complete(unsigned* bar, unsigned x, unsigned& nloc, unsigned& nx) {
    const unsigned G = gridDim.x * gridDim.y * gridDim.z;
    unsigned sum, cnt, mine, sp = 0u;
    for (;;) {
        sum = 0u; cnt = 0u; mine = 0u;
#pragma unroll
        for (unsigned j = 0; j < 16; ++j) { const unsigned c = xb_ld(&bar[XB_XCNT(j)]); sum += c; cnt += (c > 0u) ? 1u : 0u; mine = (j == x) ? c : mine; }
        if (sum == G) break;
        __builtin_amdgcn_s_sleep(1);
        if ((++sp & 255u) == 0u) { if (xb_ld(&bar[XB_TMO])) break; if (sp > XB_SPIN_CAP) { atomicAdd(&bar[XB_TMO], 1u); break; } }
    }
    nloc = mine > 0u ? mine : 1u; nx = cnt > 0u ? cnt : 1u;
}
__device__ __forceinline__ void xcd_barrier(const XcdBarrier& b) {
    asm volatile("s_waitcnt vmcnt(0)" ::: "memory");
    __syncthreads();
    if (threadIdx.x == 0) {
        unsigned* bar = b.bar;
        __builtin_amdgcn_s_waitcnt(0);
        unsigned nloc = b.st[0], nx = b.st[1];
        if (nloc == 0u) { xcd_barrier_complete(bar, b.x, nloc, nx); b.st[0] = nloc; b.st[1] = nx; }
        const unsigned old = xb_add(&bar[XB_XSUB(b.x)], 1u);
        const unsigned gen = old / nloc;
        if (old + 1u == (gen + 1u) * nloc) {
            __builtin_amdgcn_fence(__ATOMIC_RELEASE, "agent");
            asm volatile("s_waitcnt vmcnt(0)" ::: "memory");
            const unsigned og = xb_add(&bar[XB_TOP], 1u);
            const unsigned tg = og / nx;
            if (og + 1u == (tg + 1u) * nx) xb_add(&bar[XB_TOPGEN], 1u);
            else XB_SPIN(xb_ld(&bar[XB_TOPGEN]) == tg, bar);
            __builtin_amdgcn_fence(__ATOMIC_ACQUIRE, "agent");
            xb_add(&bar[XB_XGEN(b.x)], 1u);
            asm volatile("s_waitcnt vmcnt(0)" ::: "memory");
        } else {
            XB_SPIN(xb_ld(&bar[XB_XGEN(b.x)]) == gen, bar);
            __builtin_amdgcn_fence(__ATOMIC_ACQUIRE, "agent");
            asm volatile("s_waitcnt vmcnt(0)" ::: "memory");
        }
    }
    __syncthreads();
}

struct Args { const float* in[21]; float* out; unsigned char* ws; int ph_lo, ph_hi; };

struct Frame {
    LAS unsigned char* lds;
    int tid, lane, wave, vcu, G;
    unsigned char* ws; unsigned* ctl;
};

struct TItem { const float* src; unsigned char* dst; int srcN, dld, f8; };
__device__ __forceinline__ void titem_load(const TItem& t, f32x4 (&v)[16], int lane) {
    const float* p = t.src + (size_t)(16 * (lane >> 4)) * t.srcN + 4 * (lane & 15);
#pragma unroll
    for (int i = 0; i < 16; ++i) v[i] = __builtin_nontemporal_load((const f32x4*)(p + (size_t)i * t.srcN));
}
__device__ __forceinline__ void titem_convert_write(const TItem& t, const f32x4 (&v)[16], int lane) {
    unsigned char* d = t.dst + (size_t)(4 * (lane & 15)) * t.dld + 16 * (lane >> 4);
#pragma unroll
    for (int c = 0; c < 4; ++c) { u32x4 w;
        w.x = cvt4_fp8(v[0][c] * W8_SCALE, v[1][c] * W8_SCALE, v[2][c] * W8_SCALE, v[3][c] * W8_SCALE); w.y = cvt4_fp8(v[4][c] * W8_SCALE, v[5][c] * W8_SCALE, v[6][c] * W8_SCALE, v[7][c] * W8_SCALE);
        w.z = cvt4_fp8(v[8][c] * W8_SCALE, v[9][c] * W8_SCALE, v[10][c] * W8_SCALE, v[11][c] * W8_SCALE); w.w = cvt4_fp8(v[12][c] * W8_SCALE, v[13][c] * W8_SCALE, v[14][c] * W8_SCALE, v[15][c] * W8_SCALE);
        *(u32x4*)(d + (size_t)c * t.dld) = w; }
}
constexpr int TI_IN = 2 * 32 * 80, TI_OUT = 2 * 32 * 32, TI_GLU = 2 * 16 * 16, TI_G = 64 * 32 * 16, TI_U = TI_G, TI_D = 64 * 16 * 32;
constexpr int TI_N = TI_IN + TI_OUT + TI_GLU + TI_G + TI_U + TI_D;
__device__ __forceinline__ TItem titem_decode(const Args& a, unsigned char* ws, int it) {
    TItem t; int r = it;
    if (r < TI_IN) { const int l = r / (32 * 80), q = r % (32 * 80), kb = q / 80, nb = q % 80, n0 = nb * 64, seg = n0 >> 10;
        const int drow = (seg == 0 ? 0 : seg == 1 ? 1024 : seg == 2 ? 4096 : seg == 3 ? 2048 : 3072) + (n0 & 1023);
        t.src = a.in[1] + (size_t)l * DM * NPROJ + (size_t)kb * 64 * NPROJ + n0; t.srcN = NPROJ; t.dst = ws + WS_WIN + (((size_t)l * NPROJ + drow) * DM + kb * 64); t.dld = DM; t.f8 = 1; return t; }
    r -= TI_IN;
    if (r < TI_OUT) { const int l = r / 1024, q = r % 1024, kb = q / 32, nb = q % 32;
        t.src = a.in[2] + (size_t)l * DM * DM + (size_t)kb * 64 * DM + nb * 64; t.srcN = DM; t.dst = ws + WS_WOUT + (((size_t)l * DM + nb * 64) * DM + kb * 64); t.dld = DM; t.f8 = 1; return t; }
    r -= TI_OUT;
    if (r < TI_GLU) { const int l = r / 256, q = r % 256, kb = q / 16, nb = q % 16;
        t.src = a.in[11] + (size_t)l * 1024 * 1024 + (size_t)kb * 64 * 1024 + nb * 64; t.srcN = 1024; t.dst = ws + WS_WGLU + (((size_t)l * 1024 + nb * 64) * 1024 + kb * 64); t.dld = 1024; t.f8 = 1; return t; }
    r -= TI_GLU;
    if (r < TI_G + TI_U) { const int up = r >= TI_G ? 1 : 0; if (up) r -= TI_G; const int le = r / 512, q = r % 512, kb = ((q >> 1) / 16) * 2 + (q & 1), nb = (q >> 1) % 16, n0 = nb * 64;
        const int drow = (n0 >> 7) * 256 + up * 128 + (n0 & 127);
        t.src = (up ? a.in[19] : a.in[18]) + (size_t)le * DM * DE + (size_t)kb * 64 * DE + n0; t.srcN = DE; t.dst = ws + WS_WGU + ((size_t)le * 2048 + drow) * DM + kb * 64; t.dld = DM; t.f8 = 1; return t; }
    r -= TI_G + TI_U;
    { const int le = r / 512, q = r % 512, kb = ((q >> 1) / 32) * 2 + (q & 1), nb = (q >> 1) % 32;
        t.src = a.in[20] + (size_t)le * DE * DM + (size_t)kb * 64 * DM + nb * 64; t.srcN = DM; t.dst = ws + WS_WDN + ((size_t)le * DM + nb * 64) * DE + kb * 64; t.dld = DE; t.f8 = 1; return t; }
}

__device__ __forceinline__ void convert_items(Frame& F, const Args& a, int first, int count, int gw = -1, int NGW = 0) {
    int lane_ = F.lane; asm volatile("" : "+v"(lane_));
    if (gw < 0) { gw = F.vcu * NWAVES + F.wave; NGW = F.G * NWAVES; }
    f32x4 va[16], vb[16];
    for (int q = gw; q < count / 2; q += NGW) {
        const TItem ta = titem_decode(a, F.ws, first + 2 * q), tb = titem_decode(a, F.ws, first + 2 * q + 1);
        titem_load(ta, va, lane_); titem_load(tb, vb, lane_);
        titem_convert_write(ta, va, lane_); titem_convert_write(tb, vb, lane_);
    }
}
struct ConvHook { static constexpr bool ON = true; Frame* F; const Args* a; int first, count, gw, ngw, at;
    __device__ __forceinline__ bool wants(int ui) const { return ui == at; }
    __device__ __forceinline__ void operator()(int) const { convert_items(*F, *a, first, count, gw, ngw); } };
constexpr int TI_MOE0 = TI_IN + TI_OUT + TI_GLU;

__device__ __forceinline__ void p0_prologue(Frame& F, const Args& a) {
    LAS float* scr = (LAS float*)(F.lds + F.wave * 16640);
    const int gw = F.vcu * NWAVES + F.wave, NGW = F.G * NWAVES;
    {
        LAS float* APr = (LAS float*)(F.lds);
        LAS float* APi = APr + 17 * 64;
        LAS float* BBr = APi + 17 * 64;
        LAS float* BBi = BBr + 1024;
        LAS float* CCr = BBi + 1024;
        LAS float* CCi = CCr + 1024;
        LAS float* DD = CCi + 1024;
        LAS float* KM = DD + 16;
        for (int it = F.vcu; it < 2 * SGRP; it += F.G) {
            const int l = it / SGRP, g = it % SGRP; const size_t lg = (size_t)l * SGRP + g;
            const float dt = expf(a.in[10][lg]);
            for (int idx = F.tid; idx < 17 * 64; idx += 512) { const int tau = idx >> 6, p = idx & 63;
                const float zr = a.in[3][lg * SST + p] * dt, zi = a.in[4][lg * SST + p] * dt; const float mg = expf(zr * (float)tau); float sn, cs; sincosf(zi * (float)tau, &sn, &cs);
                APr[idx] = mg * cs; APi[idx] = mg * sn;
                if (tau == 16) { float* A16 = (float*)(F.ws + WS_S5A) + (lg * SST + p) * 2; A16[0] = mg * cs; A16[1] = mg * sn; } }
            for (int idx = F.tid; idx < 1024; idx += 512) { const int p = idx >> 4;
                const float lre = a.in[3][lg * SST + p], lim = a.in[4][lg * SST + p], zr = lre * dt, zi = lim * dt;
                float sn, cs, sh, ch_; sincosf(zi, &sn, &cs); sincosf(0.5f * zi, &sh, &ch_); (void)ch_;
                const float em = expm1f(zr), ez = em + 1.0f; const float nr = em * cs - 2.0f * sh * sh, ni = ez * sn, den = lre * lre + lim * lim;
                const float sr = (nr * lre + ni * lim) / den, si = (ni * lre - nr * lim) / den;
                const float br = a.in[5][lg * 1024 + idx], bi = a.in[6][lg * 1024 + idx];
                BBr[idx] = sr * br - si * bi; BBi[idx] = sr * bi + si * br;
                CCr[idx] = a.in[7][lg * 1024 + idx]; CCi[idx] = a.in[8][lg * 1024 + idx]; }
            if (F.tid < 16) DD[F.tid] = a.in[9][lg * SCH + F.tid];
            __syncthreads();
            { const int tau = F.tid >> 5, ch0 = ((F.tid >> 2) & 7) * 2, cp0 = (F.tid & 3) * 4; float acc[2][4];
#pragma unroll
              for (int i = 0; i < 2; ++i)
#pragma unroll
                  for (int j = 0; j < 4; ++j) acc[i][j] = 0.f;
              for (int p = 0; p < 64; ++p) { const float ar = APr[tau * 64 + p], ai = APi[tau * 64 + p];
                  const f32x4 br = *(const LAS f32x4*)(BBr + p * 16 + cp0), bi = *(const LAS f32x4*)(BBi + p * 16 + cp0);
#pragma unroll
                  for (int i = 0; i < 2; ++i) { const float cr = CCr[(ch0 + i) * 64 + p], ci = CCi[(ch0 + i) * 64 + p]; const float car = cr * ar - ci * ai, cai = cr * ai + ci * ar;
#pragma unroll
                      for (int j = 0; j < 4; ++j) acc[i][j] += car * br[j] - cai * bi[j]; } }
#pragma unroll
              for (int i = 0; i < 2; ++i)
#pragma unroll
                  for (int j = 0; j < 4; ++j) KM[(tau << 8) + ((ch0 + i) << 4) + cp0 + j] = acc[i][j]; }
            __syncthreads();
            bf16* Bout = (bf16*)(F.ws + WS_S5OUT) + lg * (size_t)(256 * KS5);
            for (int v = F.tid; v < 256 * 48; v += 512) { const int n = v / 48, k8 = (v % 48) * 8, tt = n >> 4, ch = n & 15; float o[8];
                if (k8 < 256) { const int s5 = k8 >> 4, cpb = k8 & 15;
#pragma unroll
                    for (int j = 0; j < 8; ++j) { float x = (s5 <= tt) ? KM[((tt - s5) << 8) + (ch << 4) + cpb + j] : 0.f; if (s5 == tt && cpb + j == ch) x += DD[ch]; o[j] = x; } }
                else { const int p0 = (k8 - 256) & 63; const bool im = k8 >= 320;
#pragma unroll
                    for (int j = 0; j < 8; ++j) { const int p = p0 + j; const float cr = CCr[ch * 64 + p], ci = CCi[ch * 64 + p], ar = APr[(tt + 1) * 64 + p], ai = APi[(tt + 1) * 64 + p];
                        o[j] = im ? -(cr * ai + ci * ar) : (cr * ar - ci * ai); } }
                u32x4 w; w.x = cvt_pk_bf16(o[0], o[1]); w.y = cvt_pk_bf16(o[2], o[3]); w.z = cvt_pk_bf16(o[4], o[5]); w.w = cvt_pk_bf16(o[6], o[7]);
                *(u32x4*)(Bout + (size_t)n * KS5 + k8) = w; }
            bf16* Min = (bf16*)(F.ws + WS_S5IN) + lg * (size_t)(128 * 256);
            for (int v = F.tid; v < 128 * 32; v += 512) { const int n = v >> 5, k8 = (v & 31) * 8, p = n & 63, s5 = k8 >> 4, cpb = k8 & 15; float o[8];
                const float ar = APr[(15 - s5) * 64 + p], ai = APi[(15 - s5) * 64 + p];
#pragma unroll
                for (int j = 0; j < 8; ++j) { const float br = BBr[p * 16 + cpb + j], bi = BBi[p * 16 + cpb + j]; o[j] = (n < 64) ? (ar * br - ai * bi) : (ar * bi + ai * br); }
                u32x4 w; w.x = cvt_pk_bf16(o[0], o[1]); w.y = cvt_pk_bf16(o[2], o[3]); w.z = cvt_pk_bf16(o[4], o[5]); w.w = cvt_pk_bf16(o[6], o[7]);
                *(u32x4*)(Min + (size_t)n * 256 + k8) = w; }
            __syncthreads();
        }
    }
    __syncthreads();
    convert_items(F, a, 0, TI_IN / 2);
    for (int part = 0; part < 2; ++part) { const float* x = a.in[0];
      const bool split = (F.G == 256); const size_t half = (size_t)T * DM / 16;
      if (split && part == 0 && F.vcu < 128) continue;
      const size_t i0 = split ? (size_t)part * half : 0, i1 = split ? i0 + half : (part == 0 ? 2 * half : 0);
      const size_t gwx = (split && part == 0) ? (size_t)(gw - 128 * NWAVES) : (size_t)gw, ngwx = (split && part == 0) ? (size_t)(128 * NWAVES) : (size_t)NGW;
      for (size_t i = i0 + gwx * 64 + F.lane; i < i1; i += 4 * ngwx * 64) {
          f32x4 p[4], q[4];
#pragma unroll
          for (int k = 0; k < 4; ++k) { const size_t ik = i + (size_t)k * ngwx * 64; if (ik < i1) { p[k] = __builtin_nontemporal_load((const f32x4*)(x + ik * 8)); q[k] = __builtin_nontemporal_load((const f32x4*)(x + ik * 8 + 4)); } }
#pragma unroll
          for (int k = 0; k < 4; ++k) { const size_t ik = i + (size_t)k * ngwx * 64; if (ik < i1) {
              u32x2 w8; w8.x = cvt4_fp8(p[k][0], p[k][1], p[k][2], p[k][3]); w8.y = cvt4_fp8(q[k][0], q[k][1], q[k][2], q[k][3]); *(u32x2*)(F.ws + WS_XB8 + ik * 8) = w8; } } } }
    { const float* rw = a.in[16]; bf16* hi = (bf16*)(F.ws + WS_RWT); bf16* lo = hi + NE * DM;
      for (int i = gw * 64 + F.lane; i < NE * DM; i += NGW * 64) { const int e = i >> 11, k = i & 2047; const float v = rw[k * NE + e];
          const unsigned h = cvt_pk_bf16(v, 0.f) & 0xffffu; const float r = v - __uint_as_float(h << 16);
          hi[i] = (bf16)h; lo[i] = (bf16)(cvt_pk_bf16(r, 0.f) & 0xffffu); } }
}

typedef float f32x16 __attribute__((ext_vector_type(16)));
constexpr int RK_OFF = 0, RV_OFF = 65536, RP_OFF = 131072, RX_OFF = 147456;
#define RET_BAR() do { asm volatile("s_waitcnt vmcnt(0) lgkmcnt(0)" ::: "memory"); __builtin_amdgcn_s_barrier(); asm volatile("" ::: "memory"); } while (0)
#define RET_BAR_L() do { asm volatile("s_waitcnt lgkmcnt(0)" ::: "memory"); __builtin_amdgcn_s_barrier(); asm volatile("" ::: "memory"); } while (0)
__device__ __forceinline__ void retention_qtile(Frame& F, const bf16* Q, const bf16* Kk, const bf16* VT, const bf16* Gs, unsigned char* MIX8, int b, int h, int I) {
    int lane_ = F.lane; asm volatile("" : "+v"(lane_));
    const int w = F.wave, rg = w & 3, hf = w >> 2, l31 = lane_ & 31, hh = lane_ >> 5;
    LAS unsigned char* Ks = F.lds + RK_OFF; LAS unsigned char* Vs = F.lds + RV_OFF; LAS unsigned char* Ps = F.lds + RP_OFF; LAS float* Xs = (LAS float*)(F.lds + RX_OFF);
    const int ipos = I * 128 + rg * 32 + l31; const size_t tok = (size_t)b * SEQ + ipos;
    bf16x8 qf[16];
#pragma unroll
    for (int ks = 0; ks < 16; ++ks) qf[ks] = *(const bf16x8*)(Q + tok * RW + h * HD + ks * 16 + hh * 8);
    f32x16 oacc[4];
#pragma unroll
    for (int e = 0; e < 4; ++e)
#pragma unroll
        for (int r = 0; r < 16; ++r) oacc[e][r] = 0.f;
    const int nJ = 2 * I + 2;
    const char* kbase = (const char*)(Kk + ((size_t)b * SEQ) * RW + h * HD); const char* vbase = (const char*)(VT + ((size_t)h * HD) * T + (size_t)b * SEQ);
    const int krow = w * 2 + (lane_ >> 5), vrow = w * 8 + (lane_ >> 3);
    const unsigned ko0 = (unsigned)(krow * RW * 2 + ((l31 ^ (krow & 15)) * 16)), vo0 = (unsigned)(vrow * T * 2 + (((lane_ & 7) ^ ((vrow >> 1) & 7)) * 16));
#define RET_DMA_KV(J) do { const char* kb_ = kbase + (size_t)(J) * (64 * RW * 2); const char* vb_ = vbase + (size_t)(J) * 128; const int bo_ = ((J) & 1) * 32768; \
        unsigned ko_ = ko0, vo_ = vo0; asm volatile("" : "+v"(ko_), "+v"(vo_)); \
        _Pragma("unroll") for (int k = 0; k < 4; ++k) __builtin_amdgcn_global_load_lds((const unsigned*)(kb_ + (ko_ + (unsigned)k * (unsigned)(16 * RW * 2))), (LAS unsigned*)(Ks + bo_ + (k * 512 + w * 64) * 16), 16, 0, 0); \
        _Pragma("unroll") for (int k = 0; k < 4; ++k) __builtin_amdgcn_global_load_lds((const unsigned*)(vb_ + (vo_ + (unsigned)k * (unsigned)(64 * T * 2))), (LAS unsigned*)(Vs + bo_ + (k * 512 + w * 64) * 16), 16, 0, 0); } while (0)
    const int kr = 32 * hf + l31, kx = kr & 15; const int pr = 32 * rg + l31, px = (pr >> 1) & 7; const int vx = (l31 >> 1) & 7;
    LAS unsigned char* pp = Ps + pr * 128;
    unsigned ka[8], pa[4], va[4];
#pragma unroll
    for (int m = 0; m < 8; ++m) ka[m] = (unsigned)(size_t)(Ks + kr * 512 + (((2 * m + hh) ^ kx) * 16));
#pragma unroll
    for (int m = 0; m < 4; ++m) { pa[m] = (unsigned)(size_t)(Ps + pr * 128 + (((2 * m + hh) ^ px) * 16)); va[m] = (unsigned)(size_t)(Vs + (128 * hf + l31) * 128 + (((2 * m + hh) ^ vx) * 16)); }
#define DSR128(dst, addr, off) asm volatile("ds_read_b128 %0, %1 offset:" #off : "=v"(dst) : "v"(addr) : "memory")
#define WAITL(n) do { asm volatile("s_waitcnt lgkmcnt(" #n ")" ::: "memory"); __builtin_amdgcn_sched_barrier(0); } while (0)
#define SBAR() __builtin_amdgcn_sched_barrier(0)
#define RET_DMA_K(J_) do { const char* kb_ = kbase + (size_t)(J_) * (64 * RW * 2); const int bo_ = ((J_) & 1) * 32768; unsigned ko_ = ko0; asm volatile("" : "+v"(ko_)); \
        _Pragma("unroll") for (int k = 0; k < 4; ++k) __builtin_amdgcn_global_load_lds((const unsigned*)(kb_ + (ko_ + (unsigned)k * (unsigned)(16 * RW * 2))), (LAS unsigned*)(Ks + bo_ + (k * 512 + w * 64) * 16), 16, 0, 0); } while (0)
#define RET_DMA_V(J_) do { const char* vb_ = vbase + (size_t)(J_) * 128; const int bo_ = ((J_) & 1) * 32768; unsigned vo_ = vo0; asm volatile("" : "+v"(vo_)); \
        _Pragma("unroll") for (int k = 0; k < 4; ++k) __builtin_amdgcn_global_load_lds((const unsigned*)(vb_ + (vo_ + (unsigned)k * (unsigned)(64 * T * 2))), (LAS unsigned*)(Vs + bo_ + (k * 512 + w * 64) * 16), 16, 0, 0); } while (0)
#define RET_BARV(n) do { asm volatile("s_waitcnt vmcnt(" #n ")" ::: "memory"); __builtin_amdgcn_s_barrier(); asm volatile("" ::: "memory"); } while (0)
    bf16x8 f0, f1, f2, f3;
    RET_DMA_K(0); RET_DMA_V(0); RET_DMA_K(1);
    RET_BARV(8);
    SBAR(); DSR128(f0, ka[0], 0); DSR128(f1, ka[1], 0); DSR128(f2, ka[2], 0); DSR128(f3, ka[3], 0); SBAR();
    for (int J = 0; J < nJ; ++J) {
        const bool hasn = (J + 1 < nJ);
        if (hasn) RET_BARV(4); else RET_BARV(0);
        if (hasn) RET_DMA_V(J + 1);
        const unsigned bofs = (unsigned)((J & 1) * 32768);
        unsigned kaj[8], vaj[4];
#pragma unroll
        for (int m = 0; m < 8; ++m) kaj[m] = ka[m] + bofs;
#pragma unroll
        for (int m = 0; m < 4; ++m) vaj[m] = va[m] + bofs;
        f32x16 sacc;
#pragma unroll
        for (int r = 0; r < 16; ++r) sacc[r] = 0.f;
        {
#define RET_S1(fr, ks, cnt, nxt) WAITL(cnt); sacc = __builtin_amdgcn_mfma_f32_32x32x16_bf16(fr, qf[ks], sacc, 0, 0, 0); SBAR(); nxt; SBAR();
            RET_S1(f0, 0, 3, DSR128(f0, kaj[4], 0)) RET_S1(f1, 1, 3, DSR128(f1, kaj[5], 0)) RET_S1(f2, 2, 3, DSR128(f2, kaj[6], 0)) RET_S1(f3, 3, 3, DSR128(f3, kaj[7], 0))
            RET_S1(f0, 4, 3, DSR128(f0, kaj[0], 256)) RET_S1(f1, 5, 3, DSR128(f1, kaj[1], 256)) RET_S1(f2, 6, 3, DSR128(f2, kaj[2], 256)) RET_S1(f3, 7, 3, DSR128(f3, kaj[3], 256))
            RET_S1(f0, 8, 3, DSR128(f0, kaj[4], 256)) RET_S1(f1, 9, 3, DSR128(f1, kaj[5], 256)) RET_S1(f2, 10, 3, DSR128(f2, kaj[6], 256)) RET_S1(f3, 11, 3, DSR128(f3, kaj[7], 256))
            RET_S1(f0, 12, 3, (void)0) RET_S1(f1, 13, 2, (void)0) RET_S1(f2, 14, 1, (void)0) RET_S1(f3, 15, 0, (void)0)
#undef RET_S1
        }
        if (J * 64 + 63 > I * 128 + rg * 32) { const int d0 = ipos - J * 64 - 32 * hf - 4 * hh;
#pragma unroll
            for (int r = 0; r < 16; ++r) sacc[r] = (d0 >= (r & 3) + 8 * (r >> 2)) ? sacc[r] : 0.f; }
#pragma unroll
        for (int q = 0; q < 4; ++q) { u32x2 pw; pw.x = cvt_pk_bf16(sacc[4 * q], sacc[4 * q + 1]); pw.y = cvt_pk_bf16(sacc[4 * q + 2], sacc[4 * q + 3]);
            *(LAS u32x2*)(pp + (((4 * hf + q) ^ px) * 16) + 8 * hh) = pw; }
        bf16x8 pA, pB, v0, v1, v2, v3;
        SBAR(); DSR128(v0, vaj[0], 0); DSR128(v1, vaj[0], 4096); DSR128(v2, vaj[0], 8192); DSR128(v3, vaj[0], 12288); SBAR();
        asm volatile("s_waitcnt lgkmcnt(4)" ::: "memory");
        RET_BARV(4);
        if (J + 2 < nJ) RET_DMA_K(J + 2);
        {
            SBAR(); DSR128(pA, pa[0], 0); DSR128(pB, pa[1], 0);
#define RET_S2(vr, pr_, et, cnt, nxt) WAITL(cnt); oacc[et] = __builtin_amdgcn_mfma_f32_32x32x16_bf16(vr, pr_, oacc[et], 0, 0, 0); SBAR(); nxt; SBAR();
            RET_S2(v0, pA, 0, 1, DSR128(v0, vaj[1], 0)) RET_S2(v1, pA, 1, 2, DSR128(v1, vaj[1], 4096)) RET_S2(v2, pA, 2, 3, DSR128(v2, vaj[1], 8192)) RET_S2(v3, pA, 3, 4, DSR128(v3, vaj[1], 12288))
            SBAR(); DSR128(pA, pa[2], 0);
            RET_S2(v0, pB, 0, 4, DSR128(v0, vaj[2], 0)) RET_S2(v1, pB, 1, 4, DSR128(v1, vaj[2], 4096)) RET_S2(v2, pB, 2, 4, DSR128(v2, vaj[2], 8192)) RET_S2(v3, pB, 3, 4, DSR128(v3, vaj[2], 12288))
            SBAR(); DSR128(pB, pa[3], 0);
            RET_S2(v0, pA, 0, 4, DSR128(v0, vaj[3], 0)) RET_S2(v1, pA, 1, 4, DSR128(v1, vaj[3], 4096)) RET_S2(v2, pA, 2, 4, DSR128(v2, vaj[3], 8192)) RET_S2(v3, pA, 3, 4, DSR128(v3, vaj[3], 12288))
            RET_S2(v0, pB, 0, 3, (void)0) RET_S2(v1, pB, 1, 2, (void)0) RET_S2(v2, pB, 2, 1, (void)0) RET_S2(v3, pB, 3, 0, (void)0)
#undef RET_S2
        }
        if (hasn) { const unsigned bn = (unsigned)(((J + 1) & 1) * 32768);
            SBAR(); DSR128(f0, ka[0] + bn, 0); DSR128(f1, ka[1] + bn, 0); DSR128(f2, ka[2] + bn, 0); DSR128(f3, ka[3] + bn, 0); SBAR(); }
    }
#undef RET_DMA_K
#undef RET_DMA_V
#undef RET_BARV
#undef RET_DMA_KV
#undef DSR128
#undef WAITL
#undef SBAR
    float s1 = 0.f, s2 = 0.f;
#pragma unroll
    for (int et = 0; et < 4; ++et)
#pragma unroll
        for (int r = 0; r < 16; ++r) { s1 += oacc[et][r]; s2 += oacc[et][r] * oacc[et][r]; }
    s1 += __shfl_xor(s1, 32); s2 += __shfl_xor(s2, 32);
    if (hh == 0) { Xs[(hf * 128 + pr) * 2] = s1; Xs[(hf * 128 + pr) * 2 + 1] = s2; }
    RET_BAR();
    s1 += Xs[((hf ^ 1) * 128 + pr) * 2]; s2 += Xs[((hf ^ 1) * 128 + pr) * 2 + 1];
    const float mean = s1 * (1.0f / 256.0f); const float var = fmaxf(s2 * (1.0f / 256.0f) - mean * mean, 0.f);
    const float rstd = 1.0f / sqrtf(var + LN_EPS);
    u32x2 gvv[4][4];
#pragma unroll
    for (int et = 0; et < 4; ++et)
#pragma unroll
        for (int q = 0; q < 4; ++q) gvv[et][q] = *(const u32x2*)(Gs + tok * RW + h * HD + 128 * hf + 32 * et + 8 * q + 4 * hh);
#pragma unroll
    for (int et = 0; et < 4; ++et)
#pragma unroll
        for (int q = 0; q < 4; ++q) { const int e = h * HD + 128 * hf + 32 * et + 8 * q + 4 * hh;
            const u32x2 gv = gvv[et][q];
            *(unsigned*)(MIX8 + tok * DM + e) = cvt4_fp8((oacc[et][4 * q] - mean) * rstd * bflo(gv.x), (oacc[et][4 * q + 1] - mean) * rstd * bfhi(gv.x),
                                                         (oacc[et][4 * q + 2] - mean) * rstd * bflo(gv.y), (oacc[et][4 * q + 3] - mean) * rstd * bfhi(gv.y)); }
    RET_BAR();
}

constexpr int S5A_OFF = 0, S5I_OFF = 65536, S5E_OFF = S5I_OFF + 128 * 129 * 4;
__device__ __forceinline__ void s5in_pair(Frame& F, bf16* U2, const bf16* Min, const float* A16, int g, int b0) {
    const int l15 = F.lane & 15, g4 = F.lane >> 4, w = F.wave;
    LAS unsigned char* As = F.lds + S5A_OFF; LAS float* inc = (LAS float*)(F.lds + S5I_OFF); LAS float* Es = (LAS float*)(F.lds + S5E_OFF);
#define S5_STAGE(bb) do { const char* ub = (const char*)(U2 + (size_t)(g * 1024 + (bb) * 128) * KS5); const int row0 = w * 2 + (F.lane >> 5); \
      const unsigned so = (unsigned)(row0 * KS5 * 2 + (((F.lane & 31) ^ (row0 & 15)) * 16)); \
      _Pragma("unroll") for (int k = 0; k < 8; ++k) pg8::glds16s(ub + (size_t)k * (16 * KS5 * 2), so, (unsigned)(size_t)As + (unsigned)((k * 512 + w * 64) * 16)); } while (0)
    S5_STAGE(b0);
    bf16x8 bfr[8];
#pragma unroll
    for (int ks = 0; ks < 8; ++ks) bfr[ks] = *(const bf16x8*)(Min + (size_t)(w * 16 + l15) * 256 + ks * 32 + g4 * 8);
    const float a16r = A16[F.lane * 2], a16i = A16[F.lane * 2 + 1];
#pragma nounroll
    for (int ub_ = 0; ub_ < 2; ++ub_) { const int b = b0 + ub_;
    asm volatile("s_waitcnt vmcnt(0)" ::: "memory"); __syncthreads();
#pragma unroll 2
    for (int ct = 0; ct < 8; ++ct) { f32x4 acc = (f32x4){0.f, 0.f, 0.f, 0.f}; const int row = ct * 16 + l15;
#pragma unroll
        for (int ks = 0; ks < 8; ++ks) { const bf16x8 af = *(const LAS bf16x8*)(As + row * 512 + (((4 * ks + g4) ^ (row & 15)) * 16));
            acc = __builtin_amdgcn_mfma_f32_16x16x32_bf16(af, bfr[ks], acc, 0, 0, 0); }
#pragma unroll
        for (int r = 0; r < 4; ++r) inc[(ct * 16 + 4 * g4 + r) * 129 + w * 16 + l15] = acc[r]; }
    __syncthreads();
    if (ub_ == 0) S5_STAGE(b0 + 1);
    { const int p = F.lane, seg = w; const float ar = a16r, ai = a16i;
      float hr = 0.f, hi = 0.f;
#pragma unroll 4
      for (int j = 0; j < 16; ++j) { const int c = seg * 16 + j; const float ir = inc[c * 129 + p], ii = inc[c * 129 + 64 + p];
          const float nr = ar * hr - ai * hi + ir, ni = ar * hi + ai * hr + ii; hr = nr; hi = ni; }
      Es[(seg * 64 + p) * 2] = hr; Es[(seg * 64 + p) * 2 + 1] = hi;
      float pr = ar, pi = ai;
#pragma unroll
      for (int q = 0; q < 4; ++q) { const float t = pr * pr - pi * pi; pi = 2.f * pr * pi; pr = t; }
      LDS_WAIT(); __builtin_amdgcn_s_barrier(); asm volatile("" ::: "memory");
      float sr = 0.f, si = 0.f;
      for (int j = 0; j < seg; ++j) { const float er = Es[(j * 64 + p) * 2], ei = Es[(j * 64 + p) * 2 + 1]; const float nr = pr * sr - pi * si + er, ni = pr * si + pi * sr + ei; sr = nr; si = ni; }
      hr = sr; hi = si;
      bf16* row = U2 + (size_t)(g * 1024 + b * 128 + seg * 16) * KS5 + 256 + p;
#pragma unroll 4
      for (int j = 0; j < 16; ++j) { const int c = seg * 16 + j;
          row[(size_t)j * KS5] = (bf16)(cvt_pk_bf16(hr, 0.f) & 0xffffu); row[(size_t)j * KS5 + 64] = (bf16)(cvt_pk_bf16(hi, 0.f) & 0xffffu);
          const float ir = inc[c * 129 + p], ii = inc[c * 129 + 64 + p];
          const float nr = ar * hr - ai * hi + ir, ni = ar * hi + ai * hr + ii; hr = nr; hi = ni; }
    }
    LDS_WAIT(); __builtin_amdgcn_s_barrier(); asm volatile("" ::: "memory");
    }
    asm volatile("s_waitcnt vmcnt(0)" ::: "memory"); __syncthreads();
#undef S5_STAGE
}

__device__ __forceinline__ void ln1_router_unit(Frame& F, const Args& a, int layer, int unit) {
    const int l15 = F.lane & 15, g4 = F.lane >> 4, w = F.wave;
    const bf16* Zb = (const bf16*)(F.ws + WS_Z); unsigned char* X1F8 = F.ws + WS_XF; float* stats = (float*)(F.ws + WS_Z + 64 * MiB);
    const float* gam = a.in[12] + layer * DM; const float* bet = a.in[13] + layer * DM;
    LAS int* lcnt = (LAS int*)(F.lds + TST_OFF + 640); LAS int* lbase = lcnt + 32;
    if (F.tid < 32) lcnt[F.tid] = 0;
    const int r0 = unit * 64;
    LAS unsigned char* x1s = F.lds;
    LAS float* gl = (LAS float*)(F.lds + 131584);
    const f32x4 gst = *(const f32x4*)(gam + 4 * F.tid), bst = *(const f32x4*)(bet + 4 * F.tid);
    LAS float* sts = (LAS float*)(F.lds + 147968);
    f32x4 acc[4][2];
#pragma unroll
    for (int rt = 0; rt < 4; ++rt) { acc[rt][0] = (f32x4){0.f, 0.f, 0.f, 0.f}; acc[rt][1] = (f32x4){0.f, 0.f, 0.f, 0.f}; }
    {
        u32x4 xin[8][4];
#pragma unroll
        for (int rr = 0; rr < 8; ++rr)
#pragma unroll
            for (int j = 0; j < 4; ++j) xin[rr][j] = __builtin_nontemporal_load((const u32x4*)(Zb + (size_t)(r0 + 32 * (rr >> 2) + 4 * w + (rr & 3)) * DM + 8 * F.lane + 512 * j));
        *(LAS f32x4*)(gl + 4 * F.tid) = gst; *(LAS f32x4*)(gl + DM + 4 * F.tid) = bst;
        LDS_WAIT(); __builtin_amdgcn_s_barrier(); asm volatile("" ::: "memory");
        size_t zo_ = 0; asm volatile("" : "+s"(zo_));
        const bf16* rwh = (const bf16*)(F.ws + WS_RWT) + zo_ + (size_t)l15 * DM + w * 256 + g4 * 8; const bf16* rwl = rwh + NE * DM;
#pragma unroll
        for (int p = 0; p < 2; ++p) {
#pragma unroll
            for (int q4 = 0; q4 < 4; ++q4) { const int rr = 4 * p + q4; const int lr = 4 * w + q4; float v[4][8]; float s = 0.f;
                unsigned go_ = (unsigned)(8 * F.lane); asm volatile("" : "+v"(go_));
#pragma unroll
                for (int j = 0; j < 4; ++j) { const u32x4 x = xin[rr][j];
                    v[j][0] = bflo(x.x); v[j][1] = bfhi(x.x); v[j][2] = bflo(x.y); v[j][3] = bfhi(x.y); v[j][4] = bflo(x.z); v[j][5] = bfhi(x.z); v[j][6] = bflo(x.w); v[j][7] = bfhi(x.w);
#pragma unroll
                    for (int q = 0; q < 8; ++q) s += v[j][q]; }
                const float mean = wave_sum(s) * (1.0f / DM); float s2 = 0.f;
#pragma unroll
                for (int j = 0; j < 4; ++j)
#pragma unroll
                    for (int q = 0; q < 8; ++q) { v[j][q] -= mean; s2 += v[j][q] * v[j][q]; }
                const float rstd = 1.0f / sqrtf(wave_sum(s2) * (1.0f / DM) + LN_EPS);
                if (F.lane == 0) { sts[(32 * p + lr) * 2] = mean; sts[(32 * p + lr) * 2 + 1] = rstd; }
#pragma unroll
                for (int j = 0; j < 4; ++j) { const f32x4 g0 = *(const LAS f32x4*)(gl + go_ + 512 * j), g1 = *(const LAS f32x4*)(gl + go_ + 512 * j + 4), b0 = *(const LAS f32x4*)(gl + DM + go_ + 512 * j), b1 = *(const LAS f32x4*)(gl + DM + go_ + 512 * j + 4);
                    u32x4 pk; pk.x = cvt_pk_bf16(v[j][0] * rstd * g0[0] + b0[0], v[j][1] * rstd * g0[1] + b0[1]); pk.y = cvt_pk_bf16(v[j][2] * rstd * g0[2] + b0[2], v[j][3] * rstd * g0[3] + b0[3]);
                    pk.z = cvt_pk_bf16(v[j][4] * rstd * g1[0] + b1[0], v[j][5] * rstd * g1[1] + b1[1]); pk.w = cvt_pk_bf16(v[j][6] * rstd * g1[2] + b1[2], v[j][7] * rstd * g1[3] + b1[3]);
                    *(LAS u32x4*)(x1s + lr * 4112 + (8 * F.lane + 512 * j) * 2) = pk;
                    u32x2 p8; p8.x = cvt4_fp8(bflo(pk.x), bfhi(pk.x), bflo(pk.y), bfhi(pk.y)); p8.y = cvt4_fp8(bflo(pk.z), bfhi(pk.z), bflo(pk.w), bfhi(pk.w));
                    *(u32x2*)(X1F8 + (size_t)(r0 + 32 * p + lr) * DM + 8 * F.lane + 512 * j) = p8; }
            }
            LDS_WAIT(); __builtin_amdgcn_s_barrier(); asm volatile("" ::: "memory");
#pragma nounroll
            for (int s0 = 0; s0 < 8; s0 += 4) {
                bf16x8 ah[4][2], bh[4][2], bl[4][2];
#pragma unroll
                for (int i = 0; i < 4; ++i) {
#pragma unroll
                    for (int t = 0; t < 2; ++t) ah[i][t] = *(const LAS bf16x8*)(x1s + (t * 16 + l15) * 4112 + (w * 256 + (s0 + i) * 32 + g4 * 8) * 2);
#pragma unroll
                    for (int n = 0; n < 2; ++n) { bh[i][n] = *(const bf16x8*)(rwh + (size_t)n * 16 * DM + (s0 + i) * 32); bl[i][n] = *(const bf16x8*)(rwl + (size_t)n * 16 * DM + (s0 + i) * 32); } }
#pragma unroll
                for (int i = 0; i < 4; ++i)
#pragma unroll
                    for (int t = 0; t < 2; ++t)
#pragma unroll
                        for (int n = 0; n < 2; ++n) { acc[2 * p + t][n] = __builtin_amdgcn_mfma_f32_16x16x32_bf16(ah[i][t], bh[i][n], acc[2 * p + t][n], 0, 0, 0);
                            acc[2 * p + t][n] = __builtin_amdgcn_mfma_f32_16x16x32_bf16(ah[i][t], bl[i][n], acc[2 * p + t][n], 0, 0, 0); } }
            LDS_WAIT(); __builtin_amdgcn_s_barrier(); asm volatile("" ::: "memory");
        }
    }
    {
      LAS float* part = (LAS float*)F.lds;
#pragma unroll
      for (int rt = 0; rt < 4; ++rt)
#pragma unroll
          for (int n = 0; n < 2; ++n)
#pragma unroll
              for (int r = 0; r < 4; ++r) part[(w * 64 + rt * 16 + 4 * g4 + r) * 33 + n * 16 + l15] = acc[rt][n][r];
    }
    __syncthreads();
    { LAS float* part = (LAS float*)F.lds; LAS float* lsum = part + 8 * 64 * 33;
      const int row = F.tid >> 3, eb = (F.tid & 7) * 4;
#pragma unroll
      for (int j = 0; j < 4; ++j) { float sacc_ = 0.f;
#pragma unroll
          for (int k = 0; k < 8; ++k) sacc_ += part[(k * 64 + row) * 33 + eb + j];
          lsum[row * 33 + eb + j] = sacc_; } }
    __syncthreads();
    int e0 = 0, e1 = 0, rk0 = 0, rk1 = 0; float w0 = 0.f, w1 = 0.f;
    if (F.tid < 64) { const LAS float* part = (const LAS float*)F.lds; const float* rb = a.in[17];
        float lgt[32]; float mx = -3.0e38f;
#pragma unroll
        for (int e = 0; e < 32; ++e) { lgt[e] = part[(8 * 64 + F.tid) * 33 + e] + rb[e]; mx = fmaxf(mx, lgt[e]); }
        float bs = -1.f; float ba1 = 0.f, ba2 = 0.f; int bi1 = 0, bi2 = 0;
#pragma unroll
        for (int gi = 0; gi < 4; ++gi) { float a1 = -3.0e38f, a2 = -3.0e38f; int i1 = 0, i2 = 0;
#pragma unroll
            for (int j = 0; j < 8; ++j) { const float v = lgt[gi * 8 + j]; if (v > a1) { a2 = a1; i2 = i1; a1 = v; i1 = gi * 8 + j; } else if (v > a2) { a2 = v; i2 = gi * 8 + j; } }
            const float p1 = __expf(a1 - mx), p2 = __expf(a2 - mx), sc = p1 + p2;
            if (sc > bs) { bs = sc; ba1 = p1; ba2 = p2; bi1 = i1; bi2 = i2; } }
        e0 = bi1; e1 = bi2; w0 = ba1 / (ba1 + ba2); w1 = ba2 / (ba1 + ba2);
        rk0 = __hip_atomic_fetch_add(lcnt + e0, 1, __ATOMIC_RELAXED, __HIP_MEMORY_SCOPE_WORKGROUP);
        rk1 = __hip_atomic_fetch_add(lcnt + e1, 1, __ATOMIC_RELAXED, __HIP_MEMORY_SCOPE_WORKGROUP);
    }
    __syncthreads();
    if (F.tid < 32) lbase[F.tid] = (int)__hip_atomic_fetch_add(F.ctl + CW_CNT + (layer * NE + F.tid) * 64, (unsigned)lcnt[F.tid], __ATOMIC_RELAXED, __HIP_MEMORY_SCOPE_AGENT);
    __syncthreads();
    if (F.tid < 64) { const int tok = r0 + F.tid; const int s0 = lbase[e0] + rk0, s1 = lbase[e1] + rk1;
        int* list = (int*)(F.ws + WS_LIST); list[e0 * T + s0] = tok; list[e1 * T + s1] = tok;
        i32x4* ti = (i32x4*)(F.ws + WS_TOK) + (size_t)tok * 2;
        ti[0] = (i32x4){e0, s0, e1, s1}; ti[1] = (i32x4){(int)__float_as_uint(w0), (int)__float_as_uint(w1), 0, 0}; }
    if (F.tid < 64) { f32x2 st; st[0] = sts[F.tid * 2]; st[1] = sts[F.tid * 2 + 1]; *(f32x2*)(stats + (size_t)(r0 + F.tid) * 2) = st; }
    __syncthreads();
}

__device__ __forceinline__ void moe_setup(Frame& F, int layer) {
    LAS int* cnt = (LAS int*)(F.lds + TST_OFF); LAS int* pst = cnt + 32; LAS int* fst = pst + 33; LAS int* hst = fst + 33;
    __syncthreads();
    if (F.tid < 32) cnt[F.tid] = (int)__hip_atomic_load(F.ctl + CW_CNT + (layer * NE + F.tid) * 64, __ATOMIC_RELAXED, __HIP_MEMORY_SCOPE_AGENT);
    __syncthreads();
    if (F.tid < 64) {
        const int e = F.tid; int c = e < NE ? cnt[e & 31] : 0; c = c < 0 ? 0 : (c > T ? T : c); const int t = (c + 127) >> 7, f = t >> 1, hb = t & 1;
        int st = t, sf = f, sh = hb;
#pragma unroll
        for (int o = 1; o < 32; o <<= 1) { const int a = __shfl_up(st, o), b = __shfl_up(sf, o), d = __shfl_up(sh, o); if (e >= o) { st += a; sf += b; sh += d; } }
        if (e < NE) { pst[e] = st - t; fst[e] = sf - f; hst[e] = sh - hb; }
        if (e == NE - 1) { pst[NE] = st; fst[NE] = sf; hst[NE] = sh; } }
    __syncthreads();
}

constexpr int LN2R = 2;
__device__ __forceinline__ void ln2_rows(Frame& F, const LAS float* gl, const int (&toks)[LN2R], float* outf, bf16* outb) {
    const LAS int* pst = (const LAS int*)(F.lds + TST_OFF) + 32;
    i32x4 inf[LN2R][2];
#pragma unroll
    for (int r = 0; r < LN2R; ++r) { const i32x4* ti = (const i32x4*)(F.ws + WS_TOK) + (size_t)toks[r] * 2; inf[r][0] = ti[0]; inf[r][1] = ti[1]; }
    u32x4 xx[LN2R][4]; u32x2 pa[LN2R][4], pb[LN2R][4]; f32x2 stv[LN2R];
#pragma unroll
    for (int r = 0; r < LN2R; ++r) { const int tok = toks[r]; const int e0 = inf[r][0][0] & 31, e1 = inf[r][0][2] & 31;
        const size_t ra = (size_t)pst[e0] * 128 + inf[r][0][1], rb = (size_t)pst[e1] * 128 + inf[r][0][3];
        const bf16* x1 = (const bf16*)(F.ws + WS_Z) + (size_t)tok * DM + 8 * F.lane;
        stv[r] = *(const f32x2*)((const float*)(F.ws + WS_Z + 64 * MiB) + (size_t)tok * 2);
        const unsigned char* ya = F.ws + WS_YB + ra * DM + 8 * F.lane; const unsigned char* yb = F.ws + WS_YB + rb * DM + 8 * F.lane;
#pragma unroll
        for (int j = 0; j < 4; ++j) { xx[r][j] = __builtin_nontemporal_load((const u32x4*)(x1 + 512 * j)); pa[r][j] = __builtin_nontemporal_load((const u32x2*)(ya + 512 * j)); pb[r][j] = __builtin_nontemporal_load((const u32x2*)(yb + 512 * j)); } }
    float wts[LN2R][2];
#pragma unroll
    for (int r = 0; r < LN2R; ++r) { wts[r][0] = __uint_as_float((unsigned)inf[r][1][0]) * 0.0625f; wts[r][1] = __uint_as_float((unsigned)inf[r][1][1]) * 0.0625f; }
#pragma unroll
    for (int r = 0; r < LN2R; ++r) { const int tok = toks[r];
        const float w0 = wts[r][0], w1 = wts[r][1];
        float v[4][8]; float s = 0.f;
        const float m1 = stv[r][0], r1 = stv[r][1];
        unsigned g1o_ = (unsigned)(8 * F.lane); asm volatile("" : "+v"(g1o_));
#pragma unroll
        for (int j = 0; j < 4; ++j) { const u32x4 x = xx[r][j]; const u32x2 p = pa[r][j], q = pb[r][j];
            const f32x4 ga = *(const LAS f32x4*)(gl + 2 * DM + g1o_ + 512 * j), gb = *(const LAS f32x4*)(gl + 2 * DM + g1o_ + 512 * j + 4), ba = *(const LAS f32x4*)(gl + 3 * DM + g1o_ + 512 * j), bb = *(const LAS f32x4*)(gl + 3 * DM + g1o_ + 512 * j + 4);
            float x1v[8];
            x1v[0] = (bflo(x.x) - m1) * r1 * ga[0] + ba[0]; x1v[1] = (bfhi(x.x) - m1) * r1 * ga[1] + ba[1]; x1v[2] = (bflo(x.y) - m1) * r1 * ga[2] + ba[2]; x1v[3] = (bfhi(x.y) - m1) * r1 * ga[3] + ba[3];
            x1v[4] = (bflo(x.z) - m1) * r1 * gb[0] + bb[0]; x1v[5] = (bfhi(x.z) - m1) * r1 * gb[1] + bb[1]; x1v[6] = (bflo(x.w) - m1) * r1 * gb[2] + bb[2]; x1v[7] = (bfhi(x.w) - m1) * r1 * gb[3] + bb[3];
            const f32x2 p0 = __builtin_amdgcn_cvt_pk_f32_fp8((int)p.x, false), p1 = __builtin_amdgcn_cvt_pk_f32_fp8((int)p.x, true), p2 = __builtin_amdgcn_cvt_pk_f32_fp8((int)p.y, false), p3 = __builtin_amdgcn_cvt_pk_f32_fp8((int)p.y, true);
            const f32x2 q0 = __builtin_amdgcn_cvt_pk_f32_fp8((int)q.x, false), q1 = __builtin_amdgcn_cvt_pk_f32_fp8((int)q.x, true), q2 = __builtin_amdgcn_cvt_pk_f32_fp8((int)q.y, false), q3 = __builtin_amdgcn_cvt_pk_f32_fp8((int)q.y, true);
            v[j][0] = ALPHA * x1v[0] + w0 * p0[0] + w1 * q0[0]; v[j][1] = ALPHA * x1v[1] + w0 * p0[1] + w1 * q0[1];
            v[j][2] = ALPHA * x1v[2] + w0 * p1[0] + w1 * q1[0]; v[j][3] = ALPHA * x1v[3] + w0 * p1[1] + w1 * q1[1];
            v[j][4] = ALPHA * x1v[4] + w0 * p2[0] + w1 * q2[0]; v[j][5] = ALPHA * x1v[5] + w0 * p2[1] + w1 * q2[1];
            v[j][6] = ALPHA * x1v[6] + w0 * p3[0] + w1 * q3[0]; v[j][7] = ALPHA * x1v[7] + w0 * p3[1] + w1 * q3[1];
#pragma unroll
            for (int t = 0; t < 8; ++t) s += v[j][t]; }
        const float mean = wave_sum(s) * (1.0f / DM); float s2 = 0.f;
#pragma unroll
        for (int j = 0; j < 4; ++j)
#pragma unroll
            for (int t = 0; t < 8; ++t) { v[j][t] -= mean; s2 += v[j][t] * v[j][t]; }
        const float rstd = 1.0f / sqrtf(wave_sum(s2) * (1.0f / DM) + LN_EPS);
        unsigned go_ = (unsigned)(8 * F.lane); asm volatile("" : "+v"(go_));
#pragma unroll
        for (int j = 0; j < 4; ++j) { const f32x4 g0 = *(const LAS f32x4*)(gl + go_ + 512 * j), g1 = *(const LAS f32x4*)(gl + go_ + 512 * j + 4), b0 = *(const LAS f32x4*)(gl + DM + go_ + 512 * j), b1 = *(const LAS f32x4*)(gl + DM + go_ + 512 * j + 4);
            f32x4 o0, o1;
#pragma unroll
            for (int t = 0; t < 4; ++t) { o0[t] = v[j][t] * rstd * g0[t] + b0[t]; o1[t] = v[j][4 + t] * rstd * g1[t] + b1[t]; }
            if (outf) { float* op = outf + (size_t)tok * DM + 8 * F.lane + 512 * j; __builtin_nontemporal_store(o0, (f32x4*)op); __builtin_nontemporal_store(o1, (f32x4*)(op + 4)); }
            if (outb) { u32x4 pk; pk.x = cvt_pk_bf16(o0[0], o0[1]); pk.y = cvt_pk_bf16(o0[2], o0[3]); pk.z = cvt_pk_bf16(o1[0], o1[1]); pk.w = cvt_pk_bf16(o1[2], o1[3]);
                __builtin_nontemporal_store(pk, (u32x4*)(outb + (size_t)tok * DM + 8 * F.lane + 512 * j));
                u32x2 p8; p8.x = cvt4_fp8(o0[0], o0[1], o0[2], o0[3]); p8.y = cvt4_fp8(o1[0], o1[1], o1[2], o1[3]); *(u32x2*)(F.ws + WS_XB8 + (size_t)tok * DM + 8 * F.lane + 512 * j) = p8; } }
    }
}

__global__ void __launch_bounds__(NWAVES * 64, 2) mk_fwd(Args args) {
    extern __shared__ __attribute__((aligned(16))) unsigned char lds_raw[];
    Frame F;
    F.lds = (LAS unsigned char*)lds_raw;
    F.tid = threadIdx.x; F.lane = F.tid & 63; F.wave = __builtin_amdgcn_readfirstlane(F.tid >> 6);
    F.G = gridDim.x; { const int bx = blockIdx.x; F.vcu = (F.G % 8 == 0) ? (bx % 8) * (F.G / 8) + bx / 8 : bx; }
    F.ws = args.ws; F.ctl = (unsigned*)(args.ws + WS_CTL);
    volatile LAS unsigned* MISC = (volatile LAS unsigned*)(F.lds + MISC_OFF);
    if (F.tid < 4) MISC[F.tid] = 0u;
    __syncthreads();
    XcdBarrier bar; bar.bar = F.ctl + CW_BAR; bar.x = 0; bar.st = MISC;
    if (MK_N_LAUNCHES == 1) bar = xcd_barrier_post(F.ctl + CW_BAR, MISC);
    const int lo = args.ph_lo, hi = args.ph_hi;
#ifndef ONLY_PHASE
#define ONLY_PHASE -1
#endif
#define PON(k) (ONLY_PHASE < 0 || ONLY_PHASE == (k))
#ifndef PROBE_PHASE
#define PROBE_PHASE -1
#endif
#define RPT(k) ((PROBE_PHASE == (k)) ? 2 : 1)
#define IN(k) (lo <= (k) && (k) < hi)
#define PHASE_FRAME Frame P = F; { size_t z_ = 0; asm volatile("" : "+s"(z_)); P.ws = F.ws + z_; P.wave = F.wave + (int)z_; } P.lane = (int)__builtin_amdgcn_mbcnt_hi(~0u, __builtin_amdgcn_mbcnt_lo(~0u, 0u)); asm volatile("" : "+v"(P.lane)); P.tid = P.wave * 64 + P.lane; P.ctl = (unsigned*)(P.ws + WS_CTL)
#define SEAM(k) do { if (IN(k) && IN((k) + 1)) xcd_barrier(bar); } while (0)

    if (PON(0) && IN(0)) { PHASE_FRAME; p0_prologue(P, args); __syncthreads(); }
    if (PROBE_PHASE == 0 && PON(0) && IN(0)) { PHASE_FRAME; p0_prologue(P, args); __syncthreads(); }
    SEAM(0);

    for (int layer = 0; layer < 2; ++layer) {
        const int pb = 1 + 9 * layer;
#define MIXCONV() do { const int c_ = P.vcu & 1, ng_ = (P.G >> 1) * NWAVES, g0_ = (P.vcu >> 1) * NWAVES + P.wave; \
            convert_items(P, args, TI_IN / 2 + c_ * (TI_IN / 4), TI_IN / 4, g0_, ng_); \
            convert_items(P, args, TI_IN + c_ * (TI_OUT / 2), TI_OUT / 2, (g0_ + ng_ - (TI_IN / 8) % ng_) % ng_, ng_); \
            convert_items(P, args, TI_IN + TI_OUT + c_ * (TI_GLU / 2), TI_GLU / 2, (g0_ + 2 * ng_ - (TI_IN / 8 + TI_OUT / 4) % ng_) % ng_, ng_); } while (0)
        if (PON(1) && IN(pb + 0)) for (int rp_ = 0; rp_ < RPT(1); ++rp_) {
            PHASE_FRAME;
            bf16* XB = (bf16*)(P.ws + WS_XB); float* XF = (float*)(P.ws + WS_XF);
            bf16* Qb = (bf16*)(P.ws + WS_Q); bf16* Kb = (bf16*)(P.ws + WS_K); bf16* Gb = (bf16*)(P.ws + WS_G); bf16* VT = (bf16*)(P.ws + WS_VT);
            bf16* U2 = (bf16*)(P.ws + WS_U2); bf16* Yb = (bf16*)(P.ws + WS_Y); bf16* MIX = (bf16*)(P.ws + WS_MIX); float* Z = (float*)(P.ws + WS_Z);
            bf16* X1B = (bf16*)(P.ws + WS_X1B); bf16* Hb = (bf16*)(P.ws + WS_H); bf16* YB = (bf16*)(P.ws + WS_YB);
            const bf16* Win = (const bf16*)(P.ws + WS_WIN) + (size_t)layer * NPROJ * DM;
            (void)XB; (void)XF; (void)Qb; (void)Kb; (void)Gb; (void)VT; (void)U2; (void)Yb; (void)MIX; (void)Z; (void)X1B; (void)Hb; (void)YB; (void)Win;
            { pg8::DenseOrder S; S.init(T, 4096, DM, P.G, (int)blockIdx.x, P.ws + WS_WIN + (size_t)layer * NPROJ * DM, 1);
              pg8::EpiInProj E{Qb, Kb, Gb, U2, (const float*)(P.ws + WS_COS), (const float*)(P.ws + WS_SIN)};
              if (layer == 0 && (P.vcu & 1) != 0) { MIXCONV(); __syncthreads(); }
              S.ulist = (const LAS int*)(P.lds + TST_OFF + 896); __syncthreads(); pg8::moe_units(S, (LAS int*)(P.lds + TST_OFF + 896), P.tid); __syncthreads();
              pg8::gemm_phase<true>(P.lds, P.tid, (const char*)(P.ws + WS_XB8), DM, S, E); }
            { pg8::DenseOrder S; S.init(1024, T, DM, P.G, (int)blockIdx.x, P.ws + WS_XB8, 1);
              pg8::EpiBf16 E{VT, T, W8_INV};
              S.ulist = (const LAS int*)(P.lds + TST_OFF + 896); __syncthreads(); pg8::moe_units(S, (LAS int*)(P.lds + TST_OFF + 896), P.tid); __syncthreads();
              pg8::gemm_phase<true>(P.lds, P.tid, (const char*)(P.ws + WS_WIN + ((size_t)layer * NPROJ + 4096) * DM), DM, S, E); }
            if (layer == 0 && (P.vcu & 1) == 0) { __syncthreads(); MIXCONV(); }
        }
        SEAM(pb + 0);

        if (PON(2) && IN(pb + 1)) for (int rp_ = 0; rp_ < RPT(2); ++rp_) {
            PHASE_FRAME;
            bf16* XB = (bf16*)(P.ws + WS_XB); float* XF = (float*)(P.ws + WS_XF);
            bf16* Qb = (bf16*)(P.ws + WS_Q); bf16* Kb = (bf16*)(P.ws + WS_K); bf16* Gb = (bf16*)(P.ws + WS_G); bf16* VT = (bf16*)(P.ws + WS_VT);
            bf16* U2 = (bf16*)(P.ws + WS_U2); bf16* Yb = (bf16*)(P.ws + WS_Y); bf16* MIX = (bf16*)(P.ws + WS_MIX); float* Z = (float*)(P.ws + WS_Z);
            bf16* X1B = (bf16*)(P.ws + WS_X1B); bf16* Hb = (bf16*)(P.ws + WS_H); bf16* YB = (bf16*)(P.ws + WS_YB);
            const bf16* Win = (const bf16*)(P.ws + WS_WIN) + (size_t)layer * NPROJ * DM;
            (void)XB; (void)XF; (void)Qb; (void)Kb; (void)Gb; (void)VT; (void)U2; (void)Yb; (void)MIX; (void)Z; (void)X1B; (void)Hb; (void)YB; (void)Win;
            const int cpos = P.vcu & 3, ufirst4 = TI_MOE0 + TI_G + layer * (TI_U / 2) + cpos * (TI_U / 8), cgw4 = (P.vcu >> 2) * NWAVES + P.wave, cngw4 = (P.G >> 2) * NWAVES;
            for (int rq_ = 0; rq_ < (PROBE_PHASE == 21 ? 2 : 1); ++rq_)
            for (int u = P.vcu; u < 256; u += P.G) { const int bh = u >> 3, p = u & 7, b = bh >> 2, h = bh & 3;
                if (cpos == 0) { convert_items(P, args, ufirst4, TI_U / 8, cgw4, cngw4); __syncthreads(); }
                retention_qtile(P, Qb, Kb, VT, Gb, P.ws + WS_MIX8, b, h, 15 - p); __syncthreads();
                if (cpos == 1) { convert_items(P, args, ufirst4, TI_U / 8, cgw4, cngw4); __syncthreads(); }
                retention_qtile(P, Qb, Kb, VT, Gb, P.ws + WS_MIX8, b, h, p); __syncthreads();
                if (cpos == 2) { convert_items(P, args, ufirst4, TI_U / 8, cgw4, cngw4); __syncthreads(); } }
            for (int rq_ = 0; rq_ < (PROBE_PHASE == 22 ? 2 : 1); ++rq_)
            for (int u2 = P.vcu * 2; u2 < 512; u2 += 2 * P.G) { const int g = u2 >> 3, b0 = u2 & 7;
                s5in_pair(P, U2, (const bf16*)(P.ws + WS_S5IN) + ((size_t)layer * SGRP + g) * (128 * 256), (const float*)(P.ws + WS_S5A) + ((size_t)layer * SGRP + g) * SST * 2, g, b0); }
            if (cpos == 3) { __syncthreads(); convert_items(P, args, ufirst4, TI_U / 8, cgw4, cngw4); __syncthreads(); }
        }
        if (F.G == 256) { if (IN(pb + 1) && IN(pb + 2)) { VM_WAIT(); __syncthreads(); } } else SEAM(pb + 1);

        if (PON(3) && IN(pb + 2)) for (int rp_ = 0; rp_ < RPT(3); ++rp_) {
            PHASE_FRAME;
            bf16* XB = (bf16*)(P.ws + WS_XB); float* XF = (float*)(P.ws + WS_XF);
            bf16* Qb = (bf16*)(P.ws + WS_Q); bf16* Kb = (bf16*)(P.ws + WS_K); bf16* Gb = (bf16*)(P.ws + WS_G); bf16* VT = (bf16*)(P.ws + WS_VT);
            bf16* U2 = (bf16*)(P.ws + WS_U2); bf16* Yb = (bf16*)(P.ws + WS_Y); bf16* MIX = (bf16*)(P.ws + WS_MIX); float* Z = (float*)(P.ws + WS_Z);
            bf16* X1B = (bf16*)(P.ws + WS_X1B); bf16* Hb = (bf16*)(P.ws + WS_H); bf16* YB = (bf16*)(P.ws + WS_YB);
            const bf16* Win = (const bf16*)(P.ws + WS_WIN) + (size_t)layer * NPROJ * DM;
            (void)XB; (void)XF; (void)Qb; (void)Kb; (void)Gb; (void)VT; (void)U2; (void)Yb; (void)MIX; (void)Z; (void)X1B; (void)Hb; (void)YB; (void)Win;
            pg8::S5Order S; S.G = P.G; S.c = P.vcu; S.Bt = (const char*)((const bf16*)(P.ws + WS_S5OUT) + (size_t)layer * SGRP * 256 * KS5);
            pg8::EpiS5Out E{Yb, P.ws + WS_Y8};
            int k5 = KS5; asm volatile("" : "+s"(k5));
            S.ulist = (const LAS int*)(P.lds + TST_OFF + 896); __syncthreads(); pg8::moe_units(S, (LAS int*)(P.lds + TST_OFF + 896), P.tid); __syncthreads();
            pg8::gemm_phase<false>(P.lds, P.tid, (const char*)U2, k5, S, E);
        }
        SEAM(pb + 2);

        if (PON(4) && IN(pb + 3)) for (int rp_ = 0; rp_ < RPT(4); ++rp_) {
            PHASE_FRAME;
            bf16* XB = (bf16*)(P.ws + WS_XB); float* XF = (float*)(P.ws + WS_XF);
            bf16* Qb = (bf16*)(P.ws + WS_Q); bf16* Kb = (bf16*)(P.ws + WS_K); bf16* Gb = (bf16*)(P.ws + WS_G); bf16* VT = (bf16*)(P.ws + WS_VT);
            bf16* U2 = (bf16*)(P.ws + WS_U2); bf16* Yb = (bf16*)(P.ws + WS_Y); bf16* MIX = (bf16*)(P.ws + WS_MIX); float* Z = (float*)(P.ws + WS_Z);
            bf16* X1B = (bf16*)(P.ws + WS_X1B); bf16* Hb = (bf16*)(P.ws + WS_H); bf16* YB = (bf16*)(P.ws + WS_YB);
            const bf16* Win = (const bf16*)(P.ws + WS_WIN) + (size_t)layer * NPROJ * DM;
            (void)XB; (void)XF; (void)Qb; (void)Kb; (void)Gb; (void)VT; (void)U2; (void)Yb; (void)MIX; (void)Z; (void)X1B; (void)Hb; (void)YB; (void)Win;
            pg8::DenseOrder S; S.init(T, 1024, 1024, P.G, (int)blockIdx.x, P.ws + WS_WGLU + (size_t)layer * 1024 * 1024, 1);
            pg8::EpiGlu E{Yb, P.ws + WS_MIX8};
            S.ulist = (const LAS int*)(P.lds + TST_OFF + 896); __syncthreads(); pg8::moe_units(S, (LAS int*)(P.lds + TST_OFF + 896), P.tid); __syncthreads();
            pg8::gemm_phase<true>(P.lds, P.tid, (const char*)(P.ws + WS_Y8), 1024, S, E);
        }
        SEAM(pb + 3);

        if (PON(5) && IN(pb + 4)) for (int rp_ = 0; rp_ < RPT(5); ++rp_) {
            PHASE_FRAME;
            bf16* XB = (bf16*)(P.ws + WS_XB); float* XF = (float*)(P.ws + WS_XF);
            bf16* Qb = (bf16*)(P.ws + WS_Q); bf16* Kb = (bf16*)(P.ws + WS_K); bf16* Gb = (bf16*)(P.ws + WS_G); bf16* VT = (bf16*)(P.ws + WS_VT);
            bf16* U2 = (bf16*)(P.ws + WS_U2); bf16* Yb = (bf16*)(P.ws + WS_Y); bf16* MIX = (bf16*)(P.ws + WS_MIX); float* Z = (float*)(P.ws + WS_Z);
            bf16* X1B = (bf16*)(P.ws + WS_X1B); bf16* Hb = (bf16*)(P.ws + WS_H); bf16* YB = (bf16*)(P.ws + WS_YB);
            const bf16* Win = (const bf16*)(P.ws + WS_WIN) + (size_t)layer * NPROJ * DM;
            (void)XB; (void)XF; (void)Qb; (void)Kb; (void)Gb; (void)VT; (void)U2; (void)Yb; (void)MIX; (void)Z; (void)X1B; (void)Hb; (void)YB; (void)Win;
            pg8::DenseOrder S; S.init(T, DM, DM, P.G, (int)blockIdx.x, P.ws + WS_WOUT + (size_t)layer * DM * DM, 1);

            constexpr int GC0 = 5462, GC1 = 5462, GC2 = TI_G / 2 - GC0 - GC1;
            const int gcls = P.vcu % 3, gfirst = TI_MOE0 + layer * (TI_G / 2) + (gcls == 0 ? 0 : (gcls == 1 ? GC0 : GC0 + GC1)), gcount = gcls == 0 ? GC0 : (gcls == 1 ? GC1 : GC2);
            const int cgw = (P.vcu / 3) * NWAVES + P.wave, cngw = ((P.G - gcls + 2) / 3) * NWAVES;
            if (gcls == 0) convert_items(P, args, gfirst, gcount, cgw, cngw);
            S.ulist = (const LAS int*)(P.lds + TST_OFF + 896); __syncthreads(); pg8::moe_units(S, (LAS int*)(P.lds + TST_OFF + 896), P.tid); __syncthreads();
            const ConvHook H{&P, &args, gfirst, gcount, cgw, cngw, gcls == 1 ? 0 : -1};
            if (layer == 0) { pg8::EpiResid<true> E{(const void*)args.in[0], (bf16*)Z}; pg8::gemm_phase<true>(P.lds, P.tid, (const char*)(P.ws + WS_MIX8), DM, S, E, H); }
            else { pg8::EpiResid<false> E{(const void*)XB, (bf16*)Z}; pg8::gemm_phase<true>(P.lds, P.tid, (const char*)(P.ws + WS_MIX8), DM, S, E, H); }
            if (gcls == 2) convert_items(P, args, gfirst, gcount, cgw, cngw);
        }
        SEAM(pb + 4);

        if (PON(6) && IN(pb + 5)) for (int rp_ = 0; rp_ < RPT(6); ++rp_) {
            PHASE_FRAME;
            bf16* XB = (bf16*)(P.ws + WS_XB); float* XF = (float*)(P.ws + WS_XF);
            bf16* Qb = (bf16*)(P.ws + WS_Q); bf16* Kb = (bf16*)(P.ws + WS_K); bf16* Gb = (bf16*)(P.ws + WS_G); bf16* VT = (bf16*)(P.ws + WS_VT);
            bf16* U2 = (bf16*)(P.ws + WS_U2); bf16* Yb = (bf16*)(P.ws + WS_Y); bf16* MIX = (bf16*)(P.ws + WS_MIX); float* Z = (float*)(P.ws + WS_Z);
            bf16* X1B = (bf16*)(P.ws + WS_X1B); bf16* Hb = (bf16*)(P.ws + WS_H); bf16* YB = (bf16*)(P.ws + WS_YB);
            const bf16* Win = (const bf16*)(P.ws + WS_WIN) + (size_t)layer * NPROJ * DM;
            (void)XB; (void)XF; (void)Qb; (void)Kb; (void)Gb; (void)VT; (void)U2; (void)Yb; (void)MIX; (void)Z; (void)X1B; (void)Hb; (void)YB; (void)Win;
            for (int u = P.vcu; u < T / 64; u += P.G) ln1_router_unit(P, args, layer, u);

        }
        SEAM(pb + 5);

        if (PON(7) && IN(pb + 6)) for (int rp_ = 0; rp_ < RPT(7); ++rp_) {
            PHASE_FRAME;
            bf16* XB = (bf16*)(P.ws + WS_XB); float* XF = (float*)(P.ws + WS_XF);
            bf16* Qb = (bf16*)(P.ws + WS_Q); bf16* Kb = (bf16*)(P.ws + WS_K); bf16* Gb = (bf16*)(P.ws + WS_G); bf16* VT = (bf16*)(P.ws + WS_VT);
            bf16* U2 = (bf16*)(P.ws + WS_U2); bf16* Yb = (bf16*)(P.ws + WS_Y); bf16* MIX = (bf16*)(P.ws + WS_MIX); float* Z = (float*)(P.ws + WS_Z);
            bf16* X1B = (bf16*)(P.ws + WS_X1B); bf16* Hb = (bf16*)(P.ws + WS_H); bf16* YB = (bf16*)(P.ws + WS_YB);
            const bf16* Win = (const bf16*)(P.ws + WS_WIN) + (size_t)layer * NPROJ * DM;
            (void)XB; (void)XF; (void)Qb; (void)Kb; (void)Gb; (void)VT; (void)U2; (void)Yb; (void)MIX; (void)Z; (void)X1B; (void)Hb; (void)YB; (void)Win;
            moe_setup(P, layer);
            const LAS int* cnt = (const LAS int*)(P.lds + TST_OFF); const LAS int* pst = cnt + 32; const LAS int* fst = pst + 33; const LAS int* hst = fst + 33;
            LAS unsigned* table = (LAS unsigned*)(P.lds + TAB_OFF);
            pg8::MoeOrder<true> S; S.NF = fst[NE] * 8; S.NU = S.NF + hst[NE] * 8; S.G = P.G; S.c = P.vcu; S.pst = pst; S.fst = fst; S.hst = hst; S.table = table; S.rowbytes = 0;
            S.Bt = (const char*)(P.ws + WS_WGU) + (size_t)layer * NE * 2048 * DM; S.estepB = (size_t)2048 * DM; S.tstepB = (size_t)256 * DM;
            S.ulist = (const LAS int*)(P.lds + TST_OFF + 896); pg8::moe_units(S, (LAS int*)(P.lds + TST_OFF + 896), P.tid); __syncthreads();
            { const int* list = (const int*)(P.ws + WS_LIST); int tk[8]; bool okk[8];
#pragma unroll
              for (int i = 0; i < 8; ++i) { pg8::Unit u; okk[i] = S.next(i, u) && (P.tid < 256); int tok = 0;
                  if (okk[i]) { const int e = u.e & 255; const int slot = (u.pm - pst[e] * 128) + P.tid; if (slot < cnt[e]) tok = list[e * T + slot]; }
                  tk[i] = tok; }
#pragma unroll
              for (int i = 0; i < 8; ++i) if (okk[i]) { int tok = tk[i]; tok = tok < 0 ? 0 : (tok >= T ? T - 1 : tok); table[i * 256 + P.tid] = (unsigned)tok * (unsigned)DM; } }
            __syncthreads();
            const int dcls = P.vcu & 3, dk = P.vcu >> 2, nclass = P.G >> 2;
            int dfirst = TI_MOE0 + 2 * TI_G + layer * (TI_D / 2) + dcls * (TI_D / 8), dcount = TI_D / 8, dgw = dk * NWAVES + P.wave, dngw = nclass * NWAVES;
            { const int ntall = S.NU - 4 * P.G; int nt = ntall > dcls ? (ntall - dcls + 3) >> 2 : 0; nt = nt > nclass ? nclass : nt;
              const int wtot = 3 * nt + 5 * (nclass - nt), c0 = 3 * (dk < nt ? dk : nt) + 5 * (dk > nt ? dk - nt : 0), c1 = c0 + (dk < nt ? 3 : 5);
              const int npc = TI_D / 16;
              const int p0 = (int)(((long)npc * c0) / wtot), p1 = (int)(((long)npc * c1) / wtot);
              dfirst += 2 * p0; dcount = 2 * (p1 - p0); dgw = P.wave; dngw = NWAVES; }
            pg8::EpiGateUp E{(unsigned char*)Hb};
            if (dcls == 0) convert_items(P, args, dfirst, dcount, dgw, dngw);
            { const ConvHook H{&P, &args, dfirst, dcount, dgw, dngw, dcls == 1 ? 0 : (dcls == 2 ? 2 : -1)};
              pg8::gemm_phase<true>(P.lds, P.tid, (const char*)(P.ws + WS_XF), DM, S, E, H); }
            if (dcls == 3) convert_items(P, args, dfirst, dcount, dgw, dngw);
        }
        SEAM(pb + 6);

        if (PON(8) && IN(pb + 7)) for (int rp_ = 0; rp_ < RPT(8); ++rp_) {
            PHASE_FRAME;
            bf16* XB = (bf16*)(P.ws + WS_XB); float* XF = (float*)(P.ws + WS_XF);
            bf16* Qb = (bf16*)(P.ws + WS_Q); bf16* Kb = (bf16*)(P.ws + WS_K); bf16* Gb = (bf16*)(P.ws + WS_G); bf16* VT = (bf16*)(P.ws + WS_VT);
            bf16* U2 = (bf16*)(P.ws + WS_U2); bf16* Yb = (bf16*)(P.ws + WS_Y); bf16* MIX = (bf16*)(P.ws + WS_MIX); float* Z = (float*)(P.ws + WS_Z);
            bf16* X1B = (bf16*)(P.ws + WS_X1B); bf16* Hb = (bf16*)(P.ws + WS_H); bf16* YB = (bf16*)(P.ws + WS_YB);
            const bf16* Win = (const bf16*)(P.ws + WS_WIN) + (size_t)layer * NPROJ * DM;
            (void)XB; (void)XF; (void)Qb; (void)Kb; (void)Gb; (void)VT; (void)U2; (void)Yb; (void)MIX; (void)Z; (void)X1B; (void)Hb; (void)YB; (void)Win;
            moe_setup(P, layer);
            const LAS int* pst = (const LAS int*)(P.lds + TST_OFF) + 32; const LAS int* fst = pst + 33; const LAS int* hst = fst + 33;
            pg8::MoeOrder<false> S; S.NF = fst[NE] * 8; S.NU = S.NF + hst[NE] * 8; S.G = P.G; S.c = P.vcu; S.pst = pst; S.fst = fst; S.hst = hst; S.table = (const LAS unsigned*)(P.lds + TAB_OFF); S.rowbytes = DE;
            S.ulist = (const LAS int*)(P.lds + TST_OFF + 896);
            S.Bt = (const char*)(P.ws + WS_WDN) + (size_t)layer * NE * DM * DE; S.estepB = (size_t)DM * DE; S.tstepB = (size_t)256 * DE;
            pg8::moe_units(S, (LAS int*)(P.lds + TST_OFF + 896), P.tid); __syncthreads();
            pg8::EpiF8 E{(unsigned char*)YB, DM, W8_INV * 16.0f};
            pg8::gemm_phase<true>(P.lds, P.tid, (const char*)Hb, DE, S, E);
        }
        SEAM(pb + 7);

        if (PON(9) && IN(pb + 8)) for (int rp_ = 0; rp_ < RPT(9); ++rp_) {
            PHASE_FRAME;
            bf16* XB = (bf16*)(P.ws + WS_XB); float* XF = (float*)(P.ws + WS_XF);
            bf16* Qb = (bf16*)(P.ws + WS_Q); bf16* Kb = (bf16*)(P.ws + WS_K); bf16* Gb = (bf16*)(P.ws + WS_G); bf16* VT = (bf16*)(P.ws + WS_VT);
            bf16* U2 = (bf16*)(P.ws + WS_U2); bf16* Yb = (bf16*)(P.ws + WS_Y); bf16* MIX = (bf16*)(P.ws + WS_MIX); float* Z = (float*)(P.ws + WS_Z);
            bf16* X1B = (bf16*)(P.ws + WS_X1B); bf16* Hb = (bf16*)(P.ws + WS_H); bf16* YB = (bf16*)(P.ws + WS_YB);
            const bf16* Win = (const bf16*)(P.ws + WS_WIN) + (size_t)layer * NPROJ * DM;
            (void)XB; (void)XF; (void)Qb; (void)Kb; (void)Gb; (void)VT; (void)U2; (void)Yb; (void)MIX; (void)Z; (void)X1B; (void)Hb; (void)YB; (void)Win;
            moe_setup(P, layer);
            float* outf = layer == 1 ? args.out : (float*)nullptr; bf16* outb = layer == 1 ? (bf16*)nullptr : XB;
            { LAS float* gl = (LAS float*)P.lds;
              { const f32x4 g = *(const f32x4*)(args.in[14] + layer * DM + 4 * P.tid), b = *(const f32x4*)(args.in[15] + layer * DM + 4 * P.tid); *(LAS f32x4*)(gl + 4 * P.tid) = g; *(LAS f32x4*)(gl + DM + 4 * P.tid) = b;
                const f32x4 g1 = *(const f32x4*)(args.in[12] + layer * DM + 4 * P.tid), b1 = *(const f32x4*)(args.in[13] + layer * DM + 4 * P.tid); *(LAS f32x4*)(gl + 2 * DM + 4 * P.tid) = g1; *(LAS f32x4*)(gl + 3 * DM + 4 * P.tid) = b1; }
              __syncthreads();
              const int step = P.G * NWAVES; const int tok0 = P.vcu * NWAVES + P.wave;
#pragma nounroll
              for (int tok = tok0; tok < T; tok += LN2R * step) { int toks[LN2R];
#pragma unroll
                  for (int r = 0; r < LN2R; ++r) toks[r] = (tok + r * step < T) ? tok + r * step : tok;
                  ln2_rows(P, gl, toks, outf, outb); } }
        }
        if (layer == 0) SEAM(pb + 8);
    }
#undef IN
#undef SEAM
}

extern "C" void kernel_launch(void* const* d_in, const int* in_sizes, int n_in, void* d_out, int out_size, void* d_ws, size_t ws_size, hipStream_t stream) {
    static int grid = 0;
    if (grid == 0) {
        if (n_in != 21 || out_size != T * DM || ws_size < WS_END) { fprintf(stderr, "kernel_launch: unexpected problem (n_in %d, out %d, ws %zu; need ws >= %zu)\n", n_in, out_size, ws_size, (size_t)WS_END); grid = -1; return; }
        int dev = 0, cus = 0, per_cu = 0;
        if (hipGetDevice(&dev) != hipSuccess || hipDeviceGetAttribute(&cus, hipDeviceAttributeMultiprocessorCount, dev) != hipSuccess) { grid = -1; return; }
        if (hipFuncSetAttribute((const void*)mk_fwd, hipFuncAttributeMaxDynamicSharedMemorySize, LDS_BYTES) != hipSuccess) { fprintf(stderr, "kernel_launch: hipFuncSetAttribute failed\n"); grid = -1; return; }
        if (hipOccupancyMaxActiveBlocksPerMultiprocessor(&per_cu, (const void*)mk_fwd, NWAVES * 64, LDS_BYTES) != hipSuccess || per_cu < 1) fprintf(stderr, "kernel_launch: occupancy query reports %d\n", per_cu);
        (void)hipGetLastError();
        grid = cus;
    }
    if (grid < 0) return;
    (void)hipMemsetAsync((char*)d_ws + WS_CTL, 0, CTL_ZERO_BYTES, stream);
    Args a{};
    for (int i = 0; i < 21; ++i) a.in[i] = (const float*)d_in[i];
    a.out = (float*)d_out; a.ws = (unsigned char*)d_ws;
#if MK_N_LAUNCHES == 1
    a.ph_lo = 0; a.ph_hi = NPH;
    hipLaunchKernelGGL(mk_fwd, dim3(grid), dim3(NWAVES * 64), LDS_BYTES, stream, a);
#else
    for (int p = 0; p < NPH; ++p) { a.ph_lo = p; a.ph_hi = p + 1; hipLaunchKernelGGL(mk_fwd, dim3(grid), dim3(NWAVES * 64), LDS_BYTES, stream, a); }
#endif
}
```

```cpp
#include <hip/hip_runtime.h>
#include <cstdio>
#include <cstdint>

#ifndef PG8_ALIGN_EPI
#define PG8_ALIGN_EPI 1
#endif
#ifndef PROBE_EPI
#define PROBE_EPI 0
#endif
#ifndef MK_N_LAUNCHES
#define MK_N_LAUNCHES 1
#endif

#define LAS __attribute__((address_space(3)))
#define GAS __attribute__((address_space(1)))
typedef unsigned short bf16;
typedef short bf16x8 __attribute__((ext_vector_type(8)));
typedef float f32x4 __attribute__((ext_vector_type(4)));
typedef float f32x2 __attribute__((ext_vector_type(2)));
typedef unsigned u32x4 __attribute__((ext_vector_type(4)));
typedef unsigned u32x2 __attribute__((ext_vector_type(2)));
typedef int i32x4 __attribute__((ext_vector_type(4)));
typedef int i32x8 __attribute__((ext_vector_type(8)));

constexpr int BATCH = 8, SEQ = 2048, DM = 2048, T = BATCH * SEQ;
constexpr int RW = 1024, HD = 256, NPROJ = 5120;
constexpr int NE = 32, DE = 1024;
constexpr int SGRP = 64, SCH = 16, SST = 64, CS = 16, NCHUNK = SEQ / CS;
constexpr int KS5 = 384;
constexpr float LN_EPS = 1e-5f;
constexpr float ALPHA = 1.41421356237309515f;
constexpr int NPH = 19;

constexpr size_t MiB = 1u << 20;
constexpr size_t WS_CTL = 0, CTL_ZERO_BYTES = 128 * 1024;
constexpr size_t WS_WIN = 1 * MiB;
constexpr size_t WS_WOUT = WS_WIN + 40 * MiB;
constexpr size_t WS_WGLU = WS_WOUT + 16 * MiB;
constexpr size_t WS_WGU = WS_WGLU + 4 * MiB;
constexpr size_t WS_WDN = WS_WGU + 512 * MiB;
constexpr size_t WS_S5OUT = WS_WDN + 256 * MiB;
constexpr size_t WS_S5IN = WS_S5OUT + 24 * MiB;
constexpr size_t WS_S5A = WS_S5IN + 8 * MiB;
constexpr size_t WS_COS = WS_S5A + 1 * MiB;
constexpr size_t WS_SIN = WS_COS + 1 * MiB;
constexpr size_t WS_RWT = WS_SIN + 1 * MiB;
constexpr size_t WS_XB = WS_RWT + 1 * MiB;
constexpr size_t WS_XF = WS_XB + 64 * MiB;
constexpr size_t WS_Y8 = WS_XF + 32 * MiB;
constexpr size_t WS_MIX8 = WS_XF + 64 * MiB;
constexpr size_t WS_XB8 = WS_XF + 96 * MiB;
constexpr size_t WS_Q = WS_XF + 128 * MiB;
constexpr size_t WS_K = WS_Q + 32 * MiB;
constexpr size_t WS_G = WS_K + 32 * MiB;
constexpr size_t WS_VT = WS_G + 32 * MiB;
constexpr size_t WS_U2 = WS_VT + 32 * MiB;
constexpr size_t WS_Y = WS_U2 + 48 * MiB;
constexpr size_t WS_MIX = WS_Y + 32 * MiB;
constexpr size_t WS_Z = WS_MIX + 64 * MiB;
constexpr size_t WS_X1B = WS_Z + 128 * MiB;
constexpr size_t WS_LIST = WS_X1B + 64 * MiB;
constexpr size_t WS_TOK = WS_LIST + 2 * MiB;
constexpr size_t WS_H = WS_TOK + 1 * MiB;
constexpr size_t WS_YB = WS_H + 80 * MiB;
constexpr size_t WS_END = WS_YB + 160 * MiB;
constexpr int CW_BAR = 4096;
constexpr int CW_CNT = 16384;

constexpr int RING_BYTES = 131072;
constexpr int TAB_OFF = 150528;
constexpr int TST_OFF = TAB_OFF + 8192;
constexpr int MISC_OFF = TST_OFF + 1024;
constexpr int LDS_BYTES = 160768;
static_assert(MISC_OFF + 64 <= LDS_BYTES && LDS_BYTES <= 163840, "LDS map");
constexpr int NWAVES = 8;

__device__ __forceinline__ unsigned cvt_pk_bf16(float lo, float hi) { unsigned r; asm volatile("v_cvt_pk_bf16_f32 %0, %1, %2" : "=v"(r) : "v"(lo), "v"(hi)); return r; }
__device__ __forceinline__ float bflo(unsigned w) { return __uint_as_float(w << 16); }
__device__ __forceinline__ float bfhi(unsigned w) { return __uint_as_float(w & 0xffff0000u); }
__device__ __forceinline__ float sigmoid_f(float x) { return __builtin_amdgcn_rcpf(1.0f + __builtin_amdgcn_exp2f(-1.44269504089f * x)); }
__device__ __forceinline__ float silu_f(float x) { return x * sigmoid_f(x); }
__device__ __forceinline__ float gelu_tanh_f(float x) { return x * sigmoid_f(1.59576912161f * (x + 0.044715f * x * x * x)); }
__device__ __forceinline__ unsigned cvt4_fp8(float a, float b, float c, float d) { int w = __builtin_amdgcn_cvt_pk_fp8_f32(a, b, 0, false); w = __builtin_amdgcn_cvt_pk_fp8_f32(c, d, w, true); return (unsigned)w; }
constexpr float W8_SCALE = 64.0f, W8_INV = 1.0f / 64.0f;
__device__ __forceinline__ float wave_sum(float v) {
#define WS_DPP(x, ctrl) __builtin_bit_cast(float, __builtin_amdgcn_update_dpp(0, __builtin_bit_cast(int, (x)), (ctrl), 0xf, 0xf, true))
    v += WS_DPP(v, 0xB1);
    v += WS_DPP(v, 0x4E);
    v += WS_DPP(v, 0x141);
    v += WS_DPP(v, 0x140);
#undef WS_DPP
    const int b = __builtin_bit_cast(int, v);
    return (__builtin_bit_cast(float, __builtin_amdgcn_readlane(b, 0)) + __builtin_bit_cast(float, __builtin_amdgcn_readlane(b, 16)))
         + (__builtin_bit_cast(float, __builtin_amdgcn_readlane(b, 32)) + __builtin_bit_cast(float, __builtin_amdgcn_readlane(b, 48)));
}
#define VM_WAIT() asm volatile("s_waitcnt vmcnt(0)" ::: "memory")
#define LDS_WAIT() asm volatile("s_waitcnt lgkmcnt(0)" ::: "memory")

namespace pg8 {
constexpr int BM = 256, BK = 64, HALF = 128, HTB = HALF * BK * 2, STAGE_BYTES = 8 * HTB, NXCD = 8, WGM = 8;
__host__ __device__ __forceinline__ int lds_byte(int r, int c) { const int st = (r >> 4) * 2 + (c >> 5), rr = r & 15, cc = c & 31, ob = rr * 64 + cc * 2; return st * 1024 + (ob ^ (((ob >> 9) & 1) << 5)); }
__host__ __device__ __forceinline__ void stage_rc(int b, int& R, int& C) { const int st = b / 1024, sb = b % 1024, swz = sb ^ (((sb >> 9) & 1) << 5); R = (st >> 1) * 16 + swz / 64; C = (st & 1) * 32 + (swz % 64) / 2; }
__host__ __device__ __forceinline__ int perm32(int rho) { const int n = rho >> 4, i = rho & 15; return 8 * (i >> 2) + 4 * n + (i & 3); }

struct Unit { int pm, pn, e, li; };
__device__ __forceinline__ void glds16s(const char* sbase, unsigned voff, unsigned lds_dst) { unsigned keep;
    asm volatile("s_mov_b32 %0, m0\n\ts_mov_b32 m0, %3\n\ts_nop 2\n\tglobal_load_lds_dwordx4 %1, %2\n\ts_mov_b32 m0, %0" : "=&s"(keep) : "v"(voff), "s"(sbase), "s"(lds_dst) : "memory"); }

struct NoHook { static constexpr bool ON = false; __device__ __forceinline__ void operator()(int) const {} };
template <bool FP8, class Epi, class Sched, class Hook = NoHook>
__device__ __forceinline__ void gemm_phase(LAS unsigned char* lds, const int tid, const char* Abase, const int Kc, const Sched& S, const Epi& E, const Hook& H = Hook()) {
    int K = Kc; asm volatile("" : "+s"(K));
    const int wid = __builtin_amdgcn_readfirstlane(tid >> 6), lane = tid & 63, wr = wid >> 2, wc = wid & 3, fr = lane & 15, fq = lane >> 4;
    const int nt = FP8 ? K / 128 : K / BK;
    int R0, C0; stage_rc(tid * 16, R0, C0);
    const int Rb0 = Epi::PERM ? ((R0 & ~31) + perm32(R0 & 31)) : R0;
    const unsigned Cb0 = (unsigned)C0 * 2u;
    const unsigned voffB0 = FP8 ? (unsigned)(Rb0 * K) + Cb0 : (unsigned)(Rb0 * K) * 2u + Cb0;
    const size_t bstep64 = (size_t)64 * K * (FP8 ? 1 : 2);
    const size_t hstepB = 2 * bstep64;
    const unsigned ldsw = (unsigned)wid * 1024u; const unsigned ldsb = (unsigned)(size_t)lds + ldsw;
    const int aoff = lds_byte(wr * 64 + fr, fq * 8), boff = lds_byte(wc * 32 + fr, fq * 8);
    struct AOff { unsigned o0, o1, o2, o3; };
    const unsigned rb64 = Sched::GATHER ? 0u : S.rowstep() * 64u;
#define PG8_LOAD_AO(AO, U, rr) do { if constexpr (Sched::GATHER) { AO.o0 = S.rowoff(U, (rr)) + Cb0; AO.o1 = S.rowoff(U, (rr) + 64) + Cb0; AO.o2 = S.rowoff(U, (rr) + 128) + Cb0; AO.o3 = S.rowoff(U, (rr) + 192) + Cb0; } \
        else { AO.o0 = S.rowoff(U, (rr)) + Cb0; AO.o1 = 0u; AO.o2 = 0u; AO.o3 = 0u; } } while (0)
#define PG8_SA(b, h) (((b) * 2 + (h)) * HTB)
#define PG8_SB(b, h) ((4 + (b) * 2 + (h)) * HTB)
#define PG8_STAGE_B(bufoff, gbase) do { const char* gb_ = (const char*)(gbase); \
        glds16s(gb_, voffB0, ldsb + (unsigned)(bufoff)); glds16s(gb_ + bstep64, voffB0, ldsb + (unsigned)(bufoff) + 8192u); } while (0)
#define PG8_STAGE_A(bufoff, AO, h, kb) do { \
        if constexpr (Sched::GATHER) { const char* ab_ = Abase + (size_t)(kb); \
            glds16s(ab_, (h) ? AO.o2 : AO.o0, ldsb + (unsigned)(bufoff)); glds16s(ab_, (h) ? AO.o3 : AO.o1, ldsb + (unsigned)(bufoff) + 8192u); \
        } else { const char* ab_ = Abase + (size_t)(kb) + (size_t)((h) * 2) * rb64; \
            glds16s(ab_, AO.o0, ldsb + (unsigned)(bufoff)); glds16s(ab_ + rb64, AO.o0, ldsb + (unsigned)(bufoff) + 8192u); } } while (0)
#define PG8_LDA(dst, b, h) do { _Pragma("unroll") for (int m = 0; m < 4; ++m) _Pragma("unroll") for (int k = 0; k < 2; ++k) dst[m][k] = *(const LAS bf16x8*)(lds + PG8_SA(b, h) + aoff + m * 2048 + k * 1024); } while (0)
#define PG8_LDB(dst, b, h) do { _Pragma("unroll") for (int n = 0; n < 2; ++n) _Pragma("unroll") for (int k = 0; k < 2; ++k) dst[n][k] = *(const LAS bf16x8*)(lds + PG8_SB(b, h) + boff + n * 2048 + k * 1024); } while (0)
#define PG8_MMA(ai, bj, At, Bt) do { __builtin_amdgcn_s_setprio(1); _Pragma("unroll") for (int m = 0; m < 4; ++m) _Pragma("unroll") for (int n = 0; n < 2; ++n) { \
        if constexpr (FP8) { \
            const i32x8 bq_ = __builtin_shufflevector(__builtin_bit_cast(i32x4, Bt[n][0]), __builtin_bit_cast(i32x4, Bt[n][1]), 0, 1, 2, 3, 4, 5, 6, 7); \
            const i32x8 aq_ = __builtin_shufflevector(__builtin_bit_cast(i32x4, At[m][0]), __builtin_bit_cast(i32x4, At[m][1]), 0, 1, 2, 3, 4, 5, 6, 7); \
            asm volatile("s_nop 1\n\tv_mfma_f32_16x16x128_f8f6f4 %0, %1, %2, %0" : "+v"(acc[ai][bj][m][n]) : "v"(bq_), "v"(aq_));   \
        } else { _Pragma("unroll") for (int k = 0; k < 2; ++k) { const i32x4 bq_ = __builtin_bit_cast(i32x4, Bt[n][k]), aq_ = __builtin_bit_cast(i32x4, At[m][k]); \
            asm volatile("s_nop 1\n\tv_mfma_f32_16x16x32_bf16 %0, %1, %2, %0" : "+v"(acc[ai][bj][m][n]) : "v"(bq_), "v"(aq_)); } } }   \
        __builtin_amdgcn_s_setprio(0); } while (0)
#define PG8_WAIT_V(n) asm volatile("s_waitcnt vmcnt(" #n ")" ::: "memory")
#define PG8_WAIT_VN(n) asm volatile("s_waitcnt vmcnt(%0)" :: "n"(n) : "memory")
#define PG8_WAIT_V8F() do { if (fa) PG8_WAIT_VN(8 + Epi::NST); else PG8_WAIT_V(8); } while (0)
#define PG8_WAIT_V6F() do { if (fa) PG8_WAIT_VN(6 + Epi::NST); else PG8_WAIT_V(6); } while (0)
#define PG8_WAIT_L(n) asm volatile("s_waitcnt lgkmcnt(" #n ")" ::: "memory")
#define PG8_BAR __builtin_amdgcn_s_barrier()
#define PG8_SCHED __builtin_amdgcn_sched_barrier(0)
    Unit cur, nxt; int ui = 0;
    if (!S.next(0, cur)) return;
    f32x4 acc[2][2][4][2];
#pragma unroll
    for (int a = 0; a < 2; ++a)
#pragma unroll
        for (int b = 0; b < 2; ++b)
#pragma unroll
            for (int m = 0; m < 4; ++m)
#pragma unroll
                for (int n = 0; n < 2; ++n) acc[a][b][m][n] = (f32x4){0.f, 0.f, 0.f, 0.f};
    bf16x8 At[4][2], B0[2][2], B1[2][2];
    AOff oc; PG8_LOAD_AO(oc, cur, R0);
    const char* cB = S.bbase(cur);
    PG8_STAGE_B(PG8_SB(0, 0), cB); PG8_STAGE_B(PG8_SB(0, 1), cB + hstepB); PG8_STAGE_A(PG8_SA(0, 0), oc, 0, 0u); PG8_STAGE_A(PG8_SA(0, 1), oc, 1, 0u);
    if (wr == 1) PG8_BAR;
    PG8_WAIT_V(2); PG8_BAR;
    PG8_STAGE_B(PG8_SB(1, 0), cB + 128); PG8_STAGE_A(PG8_SA(1, 0), oc, 0, 128u); PG8_STAGE_B(PG8_SB(1, 1), cB + hstepB + 128);
    PG8_WAIT_V(6); PG8_BAR;
    for (;;) {
        const bool has_next = S.next(ui + 1, nxt);
        const char* nB = has_next ? S.bbase(nxt) : cB;
        const bool hcur = Sched::HALFABLE ? S.half(cur) : false;
        for (int t = 0; t < nt; t += 2) {
            const bool last = (t == nt - 2);
            const unsigned kb1 = (unsigned)(t + 1) * 128u, kb2 = last ? 0u : (unsigned)(t + 2) * 128u, kb3 = kb2 + 128u;
            AOff pn = oc;
            if (last && has_next) { int t_ = (int)__builtin_amdgcn_mbcnt_hi(~0u, __builtin_amdgcn_mbcnt_lo(~0u, 0u)); asm volatile("" : "+v"(t_));
                int r0_, c0_; stage_rc((wid * 64 + t_) * 16, r0_, c0_); const unsigned Cb0 = (unsigned)c0_ * 2u; PG8_LOAD_AO(pn, nxt, r0_); }
            const char* b2 = last ? nB : cB + (size_t)(t + 2) * 128; const char* b3 = b2 + 128;
            const bool fa = FP8 && (t == 0) && (ui > 0);
            PG8_LDB(B0, 0, 0); PG8_LDB(B1, 0, 1); PG8_SCHED; PG8_LDA(At, 0, 0); if (!fa) PG8_STAGE_A(PG8_SA(1, 1), oc, 1, kb1);
            PG8_WAIT_V8F(); PG8_WAIT_L(0); PG8_BAR; PG8_MMA(0, 0, At, B0); PG8_MMA(0, 1, At, B1); PG8_BAR; PG8_SCHED;
            if (!hcur) PG8_LDA(At, 0, 1); PG8_STAGE_B(PG8_SB(0, 0), b2); PG8_STAGE_B(PG8_SB(0, 1), b2 + hstepB);
            PG8_WAIT_V6F(); PG8_WAIT_L(0); PG8_BAR; if (!hcur) PG8_MMA(1, 0, At, B0); PG8_STAGE_A(PG8_SA(0, 0), pn, 0, kb2); if (!hcur) PG8_MMA(1, 1, At, B1); PG8_BAR; PG8_SCHED;
            PG8_LDB(B0, 1, 0); PG8_LDB(B1, 1, 1); PG8_SCHED; PG8_LDA(At, 1, 0); PG8_STAGE_A(PG8_SA(0, 1), pn, 1, kb2);
            PG8_WAIT_V8F(); PG8_WAIT_L(0); PG8_BAR; PG8_MMA(0, 0, At, B0); PG8_MMA(0, 1, At, B1); PG8_BAR; PG8_SCHED;
            if (!hcur) PG8_LDA(At, 1, 1); PG8_STAGE_B(PG8_SB(1, 0), b3); PG8_STAGE_B(PG8_SB(1, 1), b3 + hstepB);
            PG8_WAIT_V(6); PG8_WAIT_L(0); PG8_BAR; if (!hcur) PG8_MMA(1, 0, At, B0); PG8_STAGE_A(PG8_SA(1, 0), pn, 0, kb3); if (!hcur) PG8_MMA(1, 1, At, B1); PG8_BAR; PG8_SCHED;
            if (FP8 && last && has_next) PG8_STAGE_A(PG8_SA(1, 1), pn, 1, 128u);
        }
        asm volatile("s_nop 15\n\ts_nop 15" ::: "memory");
        if (PG8_ALIGN_EPI) { if (wr == 0) PG8_BAR; }
        { int l_ = (int)__builtin_amdgcn_mbcnt_hi(~0u, __builtin_amdgcn_mbcnt_lo(~0u, 0u)); asm volatile("" : "+v"(l_));
          E(acc, cur, wr, wc, l_ & 15, l_ >> 4);
          if (PROBE_EPI) { asm volatile("" ::: "memory"); E(acc, cur, wr, wc, l_ & 15, l_ >> 4); } }
        if (!has_next) break;
        if constexpr (Hook::ON) { if (H.wants(ui)) { H(ui); asm volatile("s_waitcnt vmcnt(0)" ::: "memory"); } }
#pragma unroll
        for (int a = 0; a < 2; ++a)
#pragma unroll
            for (int b = 0; b < 2; ++b)
#pragma unroll
                for (int m = 0; m < 4; ++m)
#pragma unroll
                    for (int n = 0; n < 2; ++n) acc[a][b][m][n] = (f32x4){0.f, 0.f, 0.f, 0.f};
        cur = nxt; cB = nB; ++ui;
        { int t_ = (int)__builtin_amdgcn_mbcnt_hi(~0u, __builtin_amdgcn_mbcnt_lo(~0u, 0u)); asm volatile("" : "+v"(t_));
          int r0_, c0_; stage_rc((wid * 64 + t_) * 16, r0_, c0_); const unsigned Cb0 = (unsigned)c0_ * 2u; PG8_LOAD_AO(oc, cur, r0_); }
        if (PG8_ALIGN_EPI) { if (wr == 1) PG8_BAR; }
    }
    PG8_WAIT_V(0);
    if (!PG8_ALIGN_EPI) { if (wr == 0) PG8_BAR; }
    PG8_BAR;
#undef PG8_SA
#undef PG8_SB
#undef PG8_STAGE_A
#undef PG8_LOAD_AO
#undef PG8_STAGE_B
#undef PG8_LDA
#undef PG8_LDB
#undef PG8_MMA
#undef PG8_WAIT_V
#undef PG8_WAIT_VN
#undef PG8_WAIT_V8F
#undef PG8_WAIT_V6F
#undef PG8_WAIT_V6F
#undef PG8_WAIT_L
#undef PG8_BAR
#undef PG8_SCHED
}

struct DenseOrder {
    static constexpr bool GATHER = false, HALFABLE = false;
    __device__ __forceinline__ bool half(const Unit&) const { return false; }
    int nM, nN, nwg, G, c; unsigned rowbytes; const char* Bt; size_t tstepB;
    __device__ __forceinline__ unsigned rowstep() const { return rowbytes; }
    __device__ __forceinline__ void init(int M, int N, int K, int G_, int c_, const void* Bt_, int eb = 2) { nM = M / BM; nN = N / BM; nwg = nM * nN; G = G_; c = c_; rowbytes = (unsigned)(K * eb); Bt = (const char*)Bt_; tstepB = (size_t)BM * K * eb; }
    const LAS int* ulist;
    __device__ __forceinline__ bool next(int i, Unit& u) const { if (i >= 8) return false; const i32x4 v = *(const LAS i32x4*)(ulist + 4 * i); u.pm = v[0]; u.pn = v[1]; u.e = v[2]; u.li = i; return v[3] != 0; }
    __device__ __forceinline__ bool find(int i, Unit& u) const {
        const long L = (long)i * G + c; if (L >= nwg) return false;
        int wgid = (int)L; { const int q = nwg / NXCD, r = nwg % NXCD, xcd = wgid % NXCD, off = wgid / NXCD; wgid = (xcd < r ? xcd * (q + 1) : r * (q + 1) + (xcd - r) * q) + off; }
        const int nig = WGM * nN, gid = wgid / nig, fm = gid * WGM, gsz = (nM - fm) < WGM ? (nM - fm) : WGM;
        u.pm = fm + ((wgid % nig) % gsz); u.pn = (wgid % nig) / gsz; u.e = 0; u.li = i; return true;
    }
    __device__ __forceinline__ unsigned rowoff(const Unit& u, int r) const { return (unsigned)(u.pm * BM + r) * rowbytes; }
    __device__ __forceinline__ const char* bbase(const Unit& u) const { return Bt + (size_t)u.pn * tstepB; }
};
struct S5Order {
    static constexpr bool GATHER = false, HALFABLE = false;
    __device__ __forceinline__ bool half(const Unit&) const { return false; }
    int G, c; const char* Bt;
    __device__ __forceinline__ unsigned rowstep() const { return (unsigned)(KS5 * 2); }
    const LAS int* ulist;
    __device__ __forceinline__ bool next(int i, Unit& u) const { if (i >= 8) return false; const i32x4 v = *(const LAS i32x4*)(ulist + 4 * i); u.pm = v[0]; u.pn = v[1]; u.e = v[2]; u.li = i; return v[3] != 0; }
    __device__ __forceinline__ bool find(int i, Unit& u) const { const int L = i * G + c; if (L >= 256) return false; u.pm = L; u.pn = L >> 2; u.e = 0; u.li = i; return true; }
    __device__ __forceinline__ unsigned rowoff(const Unit& u, int r) const { return (unsigned)(u.pm * BM + r) * (unsigned)(KS5 * 2); }
    __device__ __forceinline__ const char* bbase(const Unit& u) const { return Bt + (size_t)u.pn * (size_t)(BM * KS5 * 2); }
};
template <bool GATHER_> struct MoeOrder {
    static constexpr bool GATHER = GATHER_, HALFABLE = true;
    int NF, NU, G, c; const LAS int* pst; const LAS int* fst; const LAS int* hst; const LAS unsigned* table; const char* Bt; size_t estepB, tstepB; unsigned rowbytes;
    __device__ __forceinline__ unsigned rowstep() const { return rowbytes; }
    const LAS int* ulist;
    __device__ __forceinline__ bool find(int i, Unit& u) const {
        const int L = i * G + c; if (L >= NU) return false;
        int e = 0;
        if (L < NF) { const int rt = L >> 3; while (e < NE - 1 && fst[e + 1] <= rt) ++e; u.pm = (pst[e] + 2 * (rt - fst[e])) * 128; u.e = e; }
        else { const int hh = (L - NF) >> 3; while (e < NE - 1 && hst[e + 1] <= hh) ++e; u.pm = (pst[e + 1] - 1) * 128; u.e = e | 256; }
        u.pn = L & 7; u.li = i; return true;
    }
    int ibeg = 0, iend = 8;
    __device__ __forceinline__ bool next(int i, Unit& u) const {
        const int j = ibeg + i; if (j >= iend) return false;
        const i32x4 v = *(const LAS i32x4*)(ulist + 4 * j);
        u.pm = v[0]; u.pn = v[1]; u.e = v[2]; u.li = j; return v[3] != 0;
    }
    __device__ __forceinline__ bool half(const Unit& u) const { return (u.e & 256) != 0; }
    __device__ __forceinline__ unsigned rowoff(const Unit& u, int r) const { if constexpr (GATHER_) return table[u.li * 256 + r]; else return (unsigned)(u.pm + r) * rowbytes; }
    __device__ __forceinline__ const char* bbase(const Unit& u) const { return Bt + (size_t)(u.e & 255) * estepB + (size_t)u.pn * tstepB; }
};

template <class MO> __device__ __forceinline__ void moe_units(const MO& S, LAS int* ulist, int tid) {
    if (tid < 8) { Unit u; u.pm = 0; u.pn = 0; u.e = 0; u.li = tid; const bool ok = S.find(tid, u); *(LAS i32x4*)(ulist + 4 * tid) = (i32x4){u.pm, u.pn, u.e, ok ? 1 : 0}; }
}

struct EpiInProj {
    static constexpr int NST = 16;
    static constexpr bool PERM = true;
    bf16 *Q, *Kk, *Gs, *U2; const float *cosT, *sinT;
    __device__ __forceinline__ void operator()(const f32x4 (&acc)[2][2][4][2], const Unit& u, int wr, int wc, int fr, int fq) const {
        const int seg = u.pn >> 2;
        const int colseg = (u.pn & 3) * 256 + wc * 32 + 8 * fq;
        const int hd_ = u.pn & 3;
        const float lgam = hd_ == 0 ? -0.045803689613f : hd_ == 1 ? -0.022720076500f : hd_ == 2 ? -0.011315313227f : -0.005646563141f;
        if (seg <= 1) {
            bf16* const O = (seg == 0) ? Q : Kk;
            float frq[2][4];
#pragma unroll
            for (int bj = 0; bj < 2; ++bj) { const int i0 = ((colseg + bj * HALF) & (HD - 1)) >> 1;
#pragma unroll
                for (int j = 0; j < 4; ++j) frq[bj][j] = __builtin_amdgcn_exp2f(-0.10381025296523f * (float)(i0 + j)) * 0.15915494309189535f; }
#pragma unroll
            for (int ai = 0; ai < 2; ++ai) {
#pragma unroll
                for (int m = 0; m < 4; ++m) { const int row = u.pm * BM + ai * HALF + wr * 64 + m * 16 + fr; const int tpos = row & (SEQ - 1); const float tf = (float)tpos;
                    const float fdec = (seg == 0) ? W8_INV * __builtin_amdgcn_exp2f(lgam * tf) : (W8_INV * 0.0625f) * __builtin_amdgcn_exp2f(-lgam * tf);
#pragma unroll
                    for (int bj = 0; bj < 2; ++bj) { const int col = colseg + bj * HALF; const f32x4 v0 = acc[ai][bj][m][0] * fdec, v1 = acc[ai][bj][m][1] * fdec; f32x4 c, sn;
#pragma unroll
                        for (int j = 0; j < 4; ++j) { const float x = __builtin_amdgcn_fractf(tf * frq[bj][j]); c[j] = __builtin_amdgcn_cosf(x); sn[j] = __builtin_amdgcn_sinf(x); }
                        u32x4 w; w.x = cvt_pk_bf16(v0[0] * c[0] - v0[1] * sn[0], v0[0] * sn[0] + v0[1] * c[0]); w.y = cvt_pk_bf16(v0[2] * c[1] - v0[3] * sn[1], v0[2] * sn[1] + v0[3] * c[1]);
                        w.z = cvt_pk_bf16(v1[0] * c[2] - v1[1] * sn[2], v1[0] * sn[2] + v1[1] * c[2]); w.w = cvt_pk_bf16(v1[2] * c[3] - v1[3] * sn[3], v1[2] * sn[3] + v1[3] * c[3]);
                        *(u32x4*)(O + (size_t)row * RW + col) = w; } }
            }
        } else {
#pragma unroll
            for (int ai = 0; ai < 2; ++ai)
#pragma unroll
                for (int m = 0; m < 4; ++m) {
                    const int row = u.pm * BM + ai * HALF + wr * 64 + m * 16 + fr; const int tpos = row & (SEQ - 1);
#pragma unroll
                    for (int bj = 0; bj < 2; ++bj) {
                        const int col = colseg + bj * HALF; const f32x4 v0 = acc[ai][bj][m][0] * W8_INV, v1 = acc[ai][bj][m][1] * W8_INV;
                        if (seg == 2) {
                            u32x4 w; w.x = cvt_pk_bf16(silu_f(v0[0]), silu_f(v0[1])); w.y = cvt_pk_bf16(silu_f(v0[2]), silu_f(v0[3])); w.z = cvt_pk_bf16(silu_f(v1[0]), silu_f(v1[1])); w.w = cvt_pk_bf16(silu_f(v1[2]), silu_f(v1[3]));
                            *(u32x4*)(Gs + (size_t)row * RW + col) = w;
                        } else {
                            const int gidx = col >> 4, ch0 = col & 15, b = row >> 11, c = tpos >> 4, tt = tpos & 15;
                            u32x4 w; w.x = cvt_pk_bf16(v0[0], v0[1]); w.y = cvt_pk_bf16(v0[2], v0[3]); w.z = cvt_pk_bf16(v1[0], v1[1]); w.w = cvt_pk_bf16(v1[2], v1[3]);
                            *(u32x4*)(U2 + (size_t)(gidx * 1024 + b * 128 + c) * KS5 + tt * 16 + ch0) = w;
                        }
                    }
                }
        }
    }
};
struct EpiBf16 {
    static constexpr int NST = 16;
    static constexpr bool PERM = true;
    bf16* O; int ldc; float sc;
    __device__ __forceinline__ void operator()(const f32x4 (&acc)[2][2][4][2], const Unit& u, int wr, int wc, int fr, int fq) const {
        const int row0 = u.pm * BM + wr * 64 + fr, col0 = u.pn * BM + wc * 32 + 8 * fq;
#pragma unroll
        for (int ai = 0; ai < 2; ++ai)
#pragma unroll
            for (int m = 0; m < 4; ++m) { bf16* rowp = O + (size_t)(row0 + ai * HALF + m * 16) * ldc + col0;
#pragma unroll
                for (int bj = 0; bj < 2; ++bj) { const f32x4 v0 = acc[ai][bj][m][0] * sc, v1 = acc[ai][bj][m][1] * sc;
                    u32x4 w; w.x = cvt_pk_bf16(v0[0], v0[1]); w.y = cvt_pk_bf16(v0[2], v0[3]); w.z = cvt_pk_bf16(v1[0], v1[1]); w.w = cvt_pk_bf16(v1[2], v1[3]);
                    *(u32x4*)(rowp + bj * HALF) = w; } }
    }
};
struct EpiF8 {
    static constexpr int NST = 8;
    static constexpr bool PERM = true;
    unsigned char* O; int ldc; float sc;
    __device__ __forceinline__ void operator()(const f32x4 (&acc)[2][2][4][2], const Unit& u, int wr, int wc, int fr, int fq) const {
        const int row0 = u.pm + wr * 64 + fr, col0 = u.pn * BM + wc * 32 + 8 * fq; const int nai = (u.e & 256) ? 1 : 2;
#pragma unroll
        for (int ai = 0; ai < 2; ++ai) if (ai < nai)
#pragma unroll
            for (int m = 0; m < 4; ++m) { unsigned char* rowp = O + (size_t)(row0 + ai * HALF + m * 16) * ldc + col0;
#pragma unroll
                for (int bj = 0; bj < 2; ++bj) { const f32x4 v0 = acc[ai][bj][m][0] * sc, v1 = acc[ai][bj][m][1] * sc;
                    u32x2 w; w.x = cvt4_fp8(v0[0], v0[1], v0[2], v0[3]); w.y = cvt4_fp8(v1[0], v1[1], v1[2], v1[3]);
                    *(u32x2*)(rowp + bj * HALF) = w; } }
    }
};
struct EpiS5Out {
    static constexpr int NST = 32;
    static constexpr bool PERM = true;
    bf16* Y; unsigned char* Y8;
    __device__ __forceinline__ void operator()(const f32x4 (&acc)[2][2][4][2], const Unit& u, int wr, int wc, int fr, int fq) const {
#pragma unroll
        for (int ai = 0; ai < 2; ++ai)
#pragma unroll
            for (int m = 0; m < 4; ++m) {
                const int R = u.pm * BM + ai * HALF + wr * 64 + m * 16 + fr; const int gidx = R >> 10, b = (R >> 7) & 7, c = R & 127;
#pragma unroll
                for (int bj = 0; bj < 2; ++bj) {
                    const int n = bj * HALF + wc * 32 + 8 * fq, tt = n >> 4, ch0 = n & 15;
                    const f32x4 v0 = acc[ai][bj][m][0], v1 = acc[ai][bj][m][1];
                    u32x4 w; w.x = cvt_pk_bf16(gelu_tanh_f(v0[0]), gelu_tanh_f(v0[1])); w.y = cvt_pk_bf16(gelu_tanh_f(v0[2]), gelu_tanh_f(v0[3]));
                    w.z = cvt_pk_bf16(gelu_tanh_f(v1[0]), gelu_tanh_f(v1[1])); w.w = cvt_pk_bf16(gelu_tanh_f(v1[2]), gelu_tanh_f(v1[3]));
                    const size_t yo = (size_t)(b * SEQ + c * CS + tt) * 1024 + gidx * 16 + ch0;
                    *(u32x4*)(Y + yo) = w;
                    u32x2 w8; w8.x = cvt4_fp8(bflo(w.x), bfhi(w.x), bflo(w.y), bfhi(w.y)); w8.y = cvt4_fp8(bflo(w.z), bfhi(w.z), bflo(w.w), bfhi(w.w));
                    *(u32x2*)(Y8 + yo) = w8;
                }
            }
    }
};
struct EpiGlu {
    static constexpr int NST = 16;
    static constexpr bool PERM = true;
    const bf16* Y; unsigned char* MIX8;
    __device__ __forceinline__ void operator()(const f32x4 (&acc)[2][2][4][2], const Unit& u, int wr, int wc, int fr, int fq) const {
        const int row0 = u.pm * BM + wr * 64 + fr, col0 = u.pn * BM + wc * 32 + 8 * fq;
        u32x4 yv[2][4][2];
#pragma unroll
        for (int ai = 0; ai < 2; ++ai)
#pragma unroll
            for (int m = 0; m < 4; ++m)
#pragma unroll
                for (int bj = 0; bj < 2; ++bj) yv[ai][m][bj] = *(const u32x4*)(Y + (size_t)(row0 + ai * HALF + m * 16) * 1024 + col0 + bj * HALF);
#pragma unroll
        for (int ai = 0; ai < 2; ++ai)
#pragma unroll
            for (int m = 0; m < 4; ++m) { const int row = row0 + ai * HALF + m * 16;
#pragma unroll
                for (int bj = 0; bj < 2; ++bj) { const int col = col0 + bj * HALF; const f32x4 v0 = acc[ai][bj][m][0] * W8_INV, v1 = acc[ai][bj][m][1] * W8_INV;
                    const u32x4 y = yv[ai][m][bj];
                    u32x2 w; w.x = cvt4_fp8(bflo(y.x) * sigmoid_f(v0[0]), bfhi(y.x) * sigmoid_f(v0[1]), bflo(y.y) * sigmoid_f(v0[2]), bfhi(y.y) * sigmoid_f(v0[3]));
                    w.y = cvt4_fp8(bflo(y.z) * sigmoid_f(v1[0]), bfhi(y.z) * sigmoid_f(v1[1]), bflo(y.w) * sigmoid_f(v1[2]), bfhi(y.w) * sigmoid_f(v1[3]));
                    *(u32x2*)(MIX8 + (size_t)row * DM + 1024 + col) = w; } }
    }
};
template <bool XF32> struct EpiResid {
    static constexpr int NST = 16;
    static constexpr bool PERM = true;
    const void* xin_; bf16* Z;
    __device__ __forceinline__ void operator()(const f32x4 (&acc)[2][2][4][2], const Unit& u, int wr, int wc, int fr, int fq) const {
        const int row0 = u.pm * BM + wr * 64 + fr, col0 = u.pn * BM + wc * 32 + 8 * fq;
#pragma unroll
        for (int ai = 0; ai < 2; ++ai) {
            f32x4 xf0[XF32 ? 4 : 1][2], xf1[XF32 ? 4 : 1][2]; u32x4 xb[XF32 ? 1 : 4][2];
#pragma unroll
            for (int m = 0; m < 4; ++m)
#pragma unroll
                for (int bj = 0; bj < 2; ++bj) { const size_t off = (size_t)(row0 + ai * HALF + m * 16) * DM + col0 + bj * HALF;
                    if constexpr (XF32) { const float* xf = (const float*)xin_ + off; xf0[m][bj] = __builtin_nontemporal_load((const f32x4*)xf); xf1[m][bj] = __builtin_nontemporal_load((const f32x4*)(xf + 4)); }
                    else xb[m][bj] = __builtin_nontemporal_load((const u32x4*)((const bf16*)xin_ + off)); }
#pragma unroll
            for (int m = 0; m < 4; ++m) { const size_t off = (size_t)(row0 + ai * HALF + m * 16) * DM + col0;
#pragma unroll
                for (int bj = 0; bj < 2; ++bj) { const f32x4 v0 = acc[ai][bj][m][0] * W8_INV, v1 = acc[ai][bj][m][1] * W8_INV;
                    u32x4 w;
                    if constexpr (XF32) { const f32x4 x0 = xf0[m][bj], x1 = xf1[m][bj];
                        w.x = cvt_pk_bf16(ALPHA * x0[0] + v0[0], ALPHA * x0[1] + v0[1]); w.y = cvt_pk_bf16(ALPHA * x0[2] + v0[2], ALPHA * x0[3] + v0[3]);
                        w.z = cvt_pk_bf16(ALPHA * x1[0] + v1[0], ALPHA * x1[1] + v1[1]); w.w = cvt_pk_bf16(ALPHA * x1[2] + v1[2], ALPHA * x1[3] + v1[3]);
                    } else { const u32x4 x = xb[m][bj];
                        w.x = cvt_pk_bf16(ALPHA * bflo(x.x) + v0[0], ALPHA * bfhi(x.x) + v0[1]); w.y = cvt_pk_bf16(ALPHA * bflo(x.y) + v0[2], ALPHA * bfhi(x.y) + v0[3]);
                        w.z = cvt_pk_bf16(ALPHA * bflo(x.z) + v1[0], ALPHA * bfhi(x.z) + v1[1]); w.w = cvt_pk_bf16(ALPHA * bflo(x.w) + v1[2], ALPHA * bfhi(x.w) + v1[3]); }
                    *(u32x4*)(Z + off + bj * HALF) = w; } }
        }
    }
};
struct EpiGateUp {
    static constexpr int NST = 4;
    static constexpr bool PERM = true;
    unsigned char* H;
    __device__ __forceinline__ void operator()(const f32x4 (&acc)[2][2][4][2], const Unit& u, int wr, int wc, int fr, int fq) const {
        const int row0 = u.pm + wr * 64 + fr, col0 = u.pn * HALF + wc * 32 + 8 * fq; const int nai = (u.e & 256) ? 1 : 2;
#pragma unroll
        for (int ai = 0; ai < 2; ++ai) if (ai < nai)
#pragma unroll
            for (int m = 0; m < 4; ++m) { const f32x4 g0 = acc[ai][0][m][0] * W8_INV, g1 = acc[ai][0][m][1] * W8_INV, u0 = acc[ai][1][m][0] * W8_INV, u1 = acc[ai][1][m][1] * W8_INV;
                u32x2 w; w.x = cvt4_fp8(silu_f(g0[0]) * u0[0], silu_f(g0[1]) * u0[1], silu_f(g0[2]) * u0[2], silu_f(g0[3]) * u0[3]);
                w.y = cvt4_fp8(silu_f(g1[0]) * u1[0], silu_f(g1[1]) * u1[1], silu_f(g1[2]) * u1[2], silu_f(g1[3]) * u1[3]);
                *(u32x2*)(H + (size_t)(row0 + ai * HALF + m * 16) * DE + col0) = w; }
    }
};
}

#define XB_TMO      128
#define XB_XCNT(j)  (256  + 64 * (j))
#define XB_XSUB(j)  (1280 + 64 * (j))
#define XB_XGEN(j)  (2304 + 64 * (j))
#define XB_TOP      3328
#define XB_TOPGEN   3392
#define XCD_BAR_WORDS 3456
#define XB_SPIN_CAP (1u << 18)

__device__ __forceinline__ unsigned xb_ld(unsigned* p)              { return __hip_atomic_load(p, __ATOMIC_RELAXED, __HIP_MEMORY_SCOPE_AGENT); }
__device__ __forceinline__ unsigned xb_add(unsigned* p, unsigned v) { return __hip_atomic_fetch_add(p, v, __ATOMIC_RELAXED, __HIP_MEMORY_SCOPE_AGENT); }
__device__ __forceinline__ unsigned xb_xcc_id() { return (unsigned)__builtin_amdgcn_s_getreg((3 << 11) | 20) & 0xFu; }
#define XB_SPIN(cond, bar) do { unsigned _sp = 0; while (cond) { __builtin_amdgcn_s_sleep(1); \
    if ((++_sp & 255u) == 0u) { if (xb_ld(&(bar)[XB_TMO])) break; if (_sp > XB_SPIN_CAP) { atomicAdd(&(bar)[XB_TMO], 1u); break; } } } } while (0)

struct XcdBarrier { unsigned* bar; unsigned x; volatile LAS unsigned* st; };

__device__ __forceinline__ XcdBarrier xcd_barrier_post(unsigned* bar, volatile LAS unsigned* st) {
    XcdBarrier b; b.bar = bar; b.x = xb_xcc_id(); b.st = st;
    if (threadIdx.x == 0) (void)xb_add(&bar[XB_XCNT(b.x)], 1u);
    return b;
}
__device__ __forceinline__ void xcd_barrier_complete(unsigned* bar, unsigned x, unsigned& nloc, unsigned& nx) {
    const unsigned G = gridDim.x * gridDim.y * gridDim.z;
    unsigned sum, cnt, mine, sp = 0u;
    for (;;) {
        sum = 0u; cnt = 0u; mine = 0u;
#pragma unroll
        for (unsigned j = 0; j < 16; ++j) { const unsigned c = xb_ld(&bar[XB_XCNT(j)]); sum += c; cnt += (c > 0u) ? 1u : 0u; mine = (j == x) ? c : mine; }
        if (sum == G) break;
        __builtin_amdgcn_s_sleep(1);
        if ((++sp & 255u) == 0u) { if (xb_ld(&bar[XB_TMO])) break; if (sp > XB_SPIN_CAP) { atomicAdd(&bar[XB_TMO], 1u); break; } }
    }
    nloc = mine > 0u ? mine : 1u; nx = cnt > 0u ? cnt : 1u;
}
__device__ __forceinline__ void xcd_barrier(const XcdBarrier& b) {
    asm volatile("s_waitcnt vmcnt(0)" ::: "memory");
    __syncthreads();
    if (threadIdx.x == 0) {
        unsigned* bar = b.bar;
        __builtin_amdgcn_s_waitcnt(0);
        unsigned nloc = b.st[0], nx = b.st[1];
        if (nloc == 0u) { xcd_barrier_complete(bar, b.x, nloc, nx); b.st[0] = nloc; b.st[1] = nx; }
        const unsigned old = xb_add(&bar[XB_XSUB(b.x)], 1u);
        const unsigned gen = old / nloc;
        if (old + 1u == (gen + 1u) * nloc) {
            __builtin_amdgcn_fence(__ATOMIC_RELEASE, "agent");
            asm volatile("s_waitcnt vmcnt(0)" ::: "memory");
            const unsigned og = xb_add(&bar[XB_TOP], 1u);
            const unsigned tg = og / nx;
            if (og + 1u == (tg + 1u) * nx) xb_add(&bar[XB_TOPGEN], 1u);
            else XB_SPIN(xb_ld(&bar[XB_TOPGEN]) == tg, bar);
            __builtin_amdgcn_fence(__ATOMIC_ACQUIRE, "agent");
            xb_add(&bar[XB_XGEN(b.x)], 1u);
            asm volatile("s_waitcnt vmcnt(0)" ::: "memory");
        } else {
            XB_SPIN(xb_ld(&bar[XB_XGEN(b.x)]) == gen, bar);
            __builtin_amdgcn_fence(__ATOMIC_ACQUIRE, "agent");
            asm volatile("s_waitcnt vmcnt(0)" ::: "memory");
        }
    }
    __syncthreads();
}

struct Args { const float* in[21]; float* out; unsigned char* ws; int ph_lo, ph_hi; };

struct Frame {
    LAS unsigned char* lds;
    int tid, lane, wave, vcu, G;
    unsigned char* ws; unsigned* ctl;
};

struct TItem { const float* src; unsigned char* dst; int srcN, dld, f8; };
__device__ __forceinline__ void titem_load(const TItem& t, f32x4 (&v)[16], int lane) {
    const float* p = t.src + (size_t)(16 * (lane >> 4)) * t.srcN + 4 * (lane & 15);
#pragma unroll
    for (int i = 0; i < 16; ++i) v[i] = __builtin_nontemporal_load((const f32x4*)(p + (size_t)i * t.srcN));
}
__device__ __forceinline__ void titem_convert_write(const TItem& t, const f32x4 (&v)[16], int lane) {
    unsigned char* d = t.dst + (size_t)(4 * (lane & 15)) * t.dld + 16 * (lane >> 4);
#pragma unroll
    for (int c = 0; c < 4; ++c) { u32x4 w;
        w.x = cvt4_fp8(v[0][c] * W8_SCALE, v[1][c] * W8_SCALE, v[2][c] * W8_SCALE, v[3][c] * W8_SCALE); w.y = cvt4_fp8(v[4][c] * W8_SCALE, v[5][c] * W8_SCALE, v[6][c] * W8_SCALE, v[7][c] * W8_SCALE);
        w.z = cvt4_fp8(v[8][c] * W8_SCALE, v[9][c] * W8_SCALE, v[10][c] * W8_SCALE, v[11][c] * W8_SCALE); w.w = cvt4_fp8(v[12][c] * W8_SCALE, v[13][c] * W8_SCALE, v[14][c] * W8_SCALE, v[15][c] * W8_SCALE);
        *(u32x4*)(d + (size_t)c * t.dld) = w; }
}
constexpr int TI_IN = 2 * 32 * 80, TI_OUT = 2 * 32 * 32, TI_GLU = 2 * 16 * 16, TI_G = 64 * 32 * 16, TI_U = TI_G, TI_D = 64 * 16 * 32;
constexpr int TI_N = TI_IN + TI_OUT + TI_GLU + TI_G + TI_U + TI_D;
__device__ __forceinline__ TItem titem_decode(const Args& a, unsigned char* ws, int it) {
    TItem t; int r = it;
    if (r < TI_IN) { const int l = r / (32 * 80), q = r % (32 * 80), kb = q / 80, nb = q % 80, n0 = nb * 64, seg = n0 >> 10;
        const int drow = (seg == 0 ? 0 : seg == 1 ? 1024 : seg == 2 ? 4096 : seg == 3 ? 2048 : 3072) + (n0 & 1023);
        t.src = a.in[1] + (size_t)l * DM * NPROJ + (size_t)kb * 64 * NPROJ + n0; t.srcN = NPROJ; t.dst = ws + WS_WIN + (((size_t)l * NPROJ + drow) * DM + kb * 64); t.dld = DM; t.f8 = 1; return t; }
    r -= TI_IN;
    if (r < TI_OUT) { const int l = r / 1024, q = r % 1024, kb = q / 32, nb = q % 32;
        t.src = a.in[2] + (size_t)l * DM * DM + (size_t)kb * 64 * DM + nb * 64; t.srcN = DM; t.dst = ws + WS_WOUT + (((size_t)l * DM + nb * 64) * DM + kb * 64); t.dld = DM; t.f8 = 1; return t; }
    r -= TI_OUT;
    if (r < TI_GLU) { const int l = r / 256, q = r % 256, kb = q / 16, nb = q % 16;
        t.src = a.in[11] + (size_t)l * 1024 * 1024 + (size_t)kb * 64 * 1024 + nb * 64; t.srcN = 1024; t.dst = ws + WS_WGLU + (((size_t)l * 1024 + nb * 64) * 1024 + kb * 64); t.dld = 1024; t.f8 = 1; return t; }
    r -= TI_GLU;
    if (r < TI_G + TI_U) { const int up = r >= TI_G ? 1 : 0; if (up) r -= TI_G; const int le = r / 512, q = r % 512, kb = ((q >> 1) / 16) * 2 + (q & 1), nb = (q >> 1) % 16, n0 = nb * 64;
        const int drow = (n0 >> 7) * 256 + up * 128 + (n0 & 127);
        t.src = (up ? a.in[19] : a.in[18]) + (size_t)le * DM * DE + (size_t)kb * 64 * DE + n0; t.srcN = DE; t.dst = ws + WS_WGU + ((size_t)le * 2048 + drow) * DM + kb * 64; t.dld = DM; t.f8 = 1; return t; }
    r -= TI_G + TI_U;
    { const int le = r / 512, q = r % 512, kb = ((q >> 1) / 32) * 2 + (q & 1), nb = (q >> 1) % 32;
        t.src = a.in[20] + (size_t)le * DE * DM + (size_t)kb * 64 * DM + nb * 64; t.srcN = DM; t.dst = ws + WS_WDN + ((size_t)le * DM + nb * 64) * DE + kb * 64; t.dld = DE; t.f8 = 1; return t; }
}

__device__ __forceinline__ void convert_items(Frame& F, const Args& a, int first, int count, int gw = -1, int NGW = 0) {
    int lane_ = F.lane; asm volatile("" : "+v"(lane_));
    if (gw < 0) { gw = F.vcu * NWAVES + F.wave; NGW = F.G * NWAVES; }
    f32x4 va[16], vb[16];
    for (int q = gw; q < count / 2; q += NGW) {
        const TItem ta = titem_decode(a, F.ws, first + 2 * q), tb = titem_decode(a, F.ws, first + 2 * q + 1);
        titem_load(ta, va, lane_); titem_load(tb, vb, lane_);
        titem_convert_write(ta, va, lane_); titem_convert_write(tb, vb, lane_);
    }
}
struct ConvHook { static constexpr bool ON = true; Frame* F; const Args* a; int first, count, gw, ngw, at;
    __device__ __forceinline__ bool wants(int ui) const { return ui == at; }
    __device__ __forceinline__ void operator()(int) const { convert_items(*F, *a, first, count, gw, ngw); } };
constexpr int TI_MOE0 = TI_IN + TI_OUT + TI_GLU;

__device__ __forceinline__ void p0_prologue(Frame& F, const Args& a) {
    LAS float* scr = (LAS float*)(F.lds + F.wave * 16640);
    const int gw = F.vcu * NWAVES + F.wave, NGW = F.G * NWAVES;
    {
        LAS float* APr = (LAS float*)(F.lds);
        LAS float* APi = APr + 17 * 64;
        LAS float* BBr = APi + 17 * 64;
        LAS float* BBi = BBr + 1024;
        LAS float* CCr = BBi + 1024;
        LAS float* CCi = CCr + 1024;
        LAS float* DD = CCi + 1024;
        LAS float* KM = DD + 16;
        for (int it = F.vcu; it < 2 * SGRP; it += F.G) {
            const int l = it / SGRP, g = it % SGRP; const size_t lg = (size_t)l * SGRP + g;
            const float dt = expf(a.in[10][lg]);
            for (int idx = F.tid; idx < 17 * 64; idx += 512) { const int tau = idx >> 6, p = idx & 63;
                const float zr = a.in[3][lg * SST + p] * dt, zi = a.in[4][lg * SST + p] * dt; const float mg = expf(zr * (float)tau); float sn, cs; sincosf(zi * (float)tau, &sn, &cs);
                APr[idx] = mg * cs; APi[idx] = mg * sn;
                if (tau == 16) { float* A16 = (float*)(F.ws + WS_S5A) + (lg * SST + p) * 2; A16[0] = mg * cs; A16[1] = mg * sn; } }
            for (int idx = F.tid; idx < 1024; idx += 512) { const int p = idx >> 4;
                const float lre = a.in[3][lg * SST + p], lim = a.in[4][lg * SST + p], zr = lre * dt, zi = lim * dt;
                float sn, cs, sh, ch_; sincosf(zi, &sn, &cs); sincosf(0.5f * zi, &sh, &ch_); (void)ch_;
                const float em = expm1f(zr), ez = em + 1.0f; const float nr = em * cs - 2.0f * sh * sh, ni = ez * sn, den = lre * lre + lim * lim;
                const float sr = (nr * lre + ni * lim) / den, si = (ni * lre - nr * lim) / den;
                const float br = a.in[5][lg * 1024 + idx], bi = a.in[6][lg * 1024 + idx];
                BBr[idx] = sr * br - si * bi; BBi[idx] = sr * bi + si * br;
                CCr[idx] = a.in[7][lg * 1024 + idx]; CCi[idx] = a.in[8][lg * 1024 + idx]; }
            if (F.tid < 16) DD[F.tid] = a.in[9][lg * SCH + F.tid];
            __syncthreads();
            { const int tau = F.tid >> 5, ch0 = ((F.tid >> 2) & 7) * 2, cp0 = (F.tid & 3) * 4; float acc[2][4];
#pragma unroll
              for (int i = 0; i < 2; ++i)
#pragma unroll
                  for (int j = 0; j < 4; ++j) acc[i][j] = 0.f;
              for (int p = 0; p < 64; ++p) { const float ar = APr[tau * 64 + p], ai = APi[tau * 64 + p];
                  const f32x4 br = *(const LAS f32x4*)(BBr + p * 16 + cp0), bi = *(const LAS f32x4*)(BBi + p * 16 + cp0);
#pragma unroll
                  for (int i = 0; i < 2; ++i) { const float cr = CCr[(ch0 + i) * 64 + p], ci = CCi[(ch0 + i) * 64 + p]; const float car = cr * ar - ci * ai, cai = cr * ai + ci * ar;
#pragma unroll
                      for (int j = 0; j < 4; ++j) acc[i][j] += car * br[j] - cai * bi[j]; } }
#pragma unroll
              for (int i = 0; i < 2; ++i)
#pragma unroll
                  for (int j = 0; j < 4; ++j) KM[(tau << 8) + ((ch0 + i) << 4) + cp0 + j] = acc[i][j]; }
            __syncthreads();
            bf16* Bout = (bf16*)(F.ws + WS_S5OUT) + lg * (size_t)(256 * KS5);
            for (int v = F.tid; v < 256 * 48; v += 512) { const int n = v / 48, k8 = (v % 48) * 8, tt = n >> 4, ch = n & 15; float o[8];
                if (k8 < 256) { const int s5 = k8 >> 4, cpb = k8 & 15;
#pragma unroll
                    for (int j = 0; j < 8; ++j) { float x = (s5 <= tt) ? KM[((tt - s5) << 8) + (ch << 4) + cpb + j] : 0.f; if (s5 == tt && cpb + j == ch) x += DD[ch]; o[j] = x; } }
                else { const int p0 = (k8 - 256) & 63; const bool im = k8 >= 320;
#pragma unroll
                    for (int j = 0; j < 8; ++j) { const int p = p0 + j; const float cr = CCr[ch * 64 + p], ci = CCi[ch * 64 + p], ar = APr[(tt + 1) * 64 + p], ai = APi[(tt + 1) * 64 + p];
                        o[j] = im ? -(cr * ai + ci * ar) : (cr * ar - ci * ai); } }
                u32x4 w; w.x = cvt_pk_bf16(o[0], o[1]); w.y = cvt_pk_bf16(o[2], o[3]); w.z = cvt_pk_bf16(o[4], o[5]); w.w = cvt_pk_bf16(o[6], o[7]);
                *(u32x4*)(Bout + (size_t)n * KS5 + k8) = w; }
            bf16* Min = (bf16*)(F.ws + WS_S5IN) + lg * (size_t)(128 * 256);
            for (int v = F.tid; v < 128 * 32; v += 512) { const int n = v >> 5, k8 = (v & 31) * 8, p = n & 63, s5 = k8 >> 4, cpb = k8 & 15; float o[8];
                const float ar = APr[(15 - s5) * 64 + p], ai = APi[(15 - s5) * 64 + p];
#pragma unroll
                for (int j = 0; j < 8; ++j) { const float br = BBr[p * 16 + cpb + j], bi = BBi[p * 16 + cpb + j]; o[j] = (n < 64) ? (ar * br - ai * bi) : (ar * bi + ai * br); }
                u32x4 w; w.x = cvt_pk_bf16(o[0], o[1]); w.y = cvt_pk_bf16(o[2], o[3]); w.z = cvt_pk_bf16(o[4], o[5]); w.w = cvt_pk_bf16(o[6], o[7]);
                *(u32x4*)(Min + (size_t)n * 256 + k8) = w; }
            __syncthreads();
        }
    }
    __syncthreads();
    convert_items(F, a, 0, TI_IN / 2);
    for (int part = 0; part < 2; ++part) { const float* x = a.in[0];
      const bool split = (F.G == 256); const size_t half = (size_t)T * DM / 16;
      if (split && part == 0 && F.vcu < 128) continue;
      const size_t i0 = split ? (size_t)part * half : 0, i1 = split ? i0 + half : (part == 0 ? 2 * half : 0);
      const size_t gwx = (split && part == 0) ? (size_t)(gw - 128 * NWAVES) : (size_t)gw, ngwx = (split && part == 0) ? (size_t)(128 * NWAVES) : (size_t)NGW;
      for (size_t i = i0 + gwx * 64 + F.lane; i < i1; i += 4 * ngwx * 64) {
          f32x4 p[4], q[4];
#pragma unroll
          for (int k = 0; k < 4; ++k) { const size_t ik = i + (size_t)k * ngwx * 64; if (ik < i1) { p[k] = __builtin_nontemporal_load((const f32x4*)(x + ik * 8)); q[k] = __builtin_nontemporal_load((const f32x4*)(x + ik * 8 + 4)); } }
#pragma unroll
          for (int k = 0; k < 4; ++k) { const size_t ik = i + (size_t)k * ngwx * 64; if (ik < i1) {
              u32x2 w8; w8.x = cvt4_fp8(p[k][0], p[k][1], p[k][2], p[k][3]); w8.y = cvt4_fp8(q[k][0], q[k][1], q[k][2], q[k][3]); *(u32x2*)(F.ws + WS_XB8 + ik * 8) = w8; } } } }
    { const float* rw = a.in[16]; bf16* hi = (bf16*)(F.ws + WS_RWT); bf16* lo = hi + NE * DM;
      for (int i = gw * 64 + F.lane; i < NE * DM; i += NGW * 64) { const int e = i >> 11, k = i & 2047; const float v = rw[k * NE + e];
          const unsigned h = cvt_pk_bf16(v, 0.f) & 0xffffu; const float r = v - __uint_as_float(h << 16);
          hi[i] = (bf16)h; lo[i] = (bf16)(cvt_pk_bf16(r, 0.f) & 0xffffu); } }
}

typedef float f32x16 __attribute__((ext_vector_type(16)));
constexpr int RK_OFF = 0, RV_OFF = 65536, RP_OFF = 131072, RX_OFF = 147456;
#define RET_BAR() do { asm volatile("s_waitcnt vmcnt(0) lgkmcnt(0)" ::: "memory"); __builtin_amdgcn_s_barrier(); asm volatile("" ::: "memory"); } while (0)
#define RET_BAR_L() do { asm volatile("s_waitcnt lgkmcnt(0)" ::: "memory"); __builtin_amdgcn_s_barrier(); asm volatile("" ::: "memory"); } while (0)
__device__ __forceinline__ void retention_qtile(Frame& F, const bf16* Q, const bf16* Kk, const bf16* VT, const bf16* Gs, unsigned char* MIX8, int b, int h, int I) {
    int lane_ = F.lane; asm volatile("" : "+v"(lane_));
    const int w = F.wave, rg = w & 3, hf = w >> 2, l31 = lane_ & 31, hh = lane_ >> 5;
    LAS unsigned char* Ks = F.lds + RK_OFF; LAS unsigned char* Vs = F.lds + RV_OFF; LAS unsigned char* Ps = F.lds + RP_OFF; LAS float* Xs = (LAS float*)(F.lds + RX_OFF);
    const int ipos = I * 128 + rg * 32 + l31; const size_t tok = (size_t)b * SEQ + ipos;
    bf16x8 qf[16];
#pragma unroll
    for (int ks = 0; ks < 16; ++ks) qf[ks] = *(const bf16x8*)(Q + tok * RW + h * HD + ks * 16 + hh * 8);
    f32x16 oacc[4];
#pragma unroll
    for (int e = 0; e < 4; ++e)
#pragma unroll
        for (int r = 0; r < 16; ++r) oacc[e][r] = 0.f;
    const int nJ = 2 * I + 2;
    const char* kbase = (const char*)(Kk + ((size_t)b * SEQ) * RW + h * HD); const char* vbase = (const char*)(VT + ((size_t)h * HD) * T + (size_t)b * SEQ);
    const int krow = w * 2 + (lane_ >> 5), vrow = w * 8 + (lane_ >> 3);
    const unsigned ko0 = (unsigned)(krow * RW * 2 + ((l31 ^ (krow & 15)) * 16)), vo0 = (unsigned)(vrow * T * 2 + (((lane_ & 7) ^ ((vrow >> 1) & 7)) * 16));
#define RET_DMA_KV(J) do { const char* kb_ = kbase + (size_t)(J) * (64 * RW * 2); const char* vb_ = vbase + (size_t)(J) * 128; const int bo_ = ((J) & 1) * 32768; \
        unsigned ko_ = ko0, vo_ = vo0; asm volatile("" : "+v"(ko_), "+v"(vo_)); \
        _Pragma("unroll") for (int k = 0; k < 4; ++k) __builtin_amdgcn_global_load_lds((const unsigned*)(kb_ + (ko_ + (unsigned)k * (unsigned)(16 * RW * 2))), (LAS unsigned*)(Ks + bo_ + (k * 512 + w * 64) * 16), 16, 0, 0); \
        _Pragma("unroll") for (int k = 0; k < 4; ++k) __builtin_amdgcn_global_load_lds((const unsigned*)(vb_ + (vo_ + (unsigned)k * (unsigned)(64 * T * 2))), (LAS unsigned*)(Vs + bo_ + (k * 512 + w * 64) * 16), 16, 0, 0); } while (0)
    const int kr = 32 * hf + l31, kx = kr & 15; const int pr = 32 * rg + l31, px = (pr >> 1) & 7; const int vx = (l31 >> 1) & 7;
    LAS unsigned char* pp = Ps + pr * 128;
    unsigned ka[8], pa[4], va[4];
#pragma unroll
    for (int m = 0; m < 8; ++m) ka[m] = (unsigned)(size_t)(Ks + kr * 512 + (((2 * m + hh) ^ kx) * 16));
#pragma unroll
    for (int m = 0; m < 4; ++m) { pa[m] = (unsigned)(size_t)(Ps + pr * 128 + (((2 * m + hh) ^ px) * 16)); va[m] = (unsigned)(size_t)(Vs + (128 * hf + l31) * 128 + (((2 * m + hh) ^ vx) * 16)); }
#define DSR128(dst, addr, off) asm volatile("ds_read_b128 %0, %1 offset:" #off : "=v"(dst) : "v"(addr) : "memory")
#define WAITL(n) do { asm volatile("s_waitcnt lgkmcnt(" #n ")" ::: "memory"); __builtin_amdgcn_sched_barrier(0); } while (0)
#define SBAR() __builtin_amdgcn_sched_barrier(0)
#define RET_DMA_K(J_) do { const char* kb_ = kbase + (size_t)(J_) * (64 * RW * 2); const int bo_ = ((J_) & 1) * 32768; unsigned ko_ = ko0; asm volatile("" : "+v"(ko_)); \
        _Pragma("unroll") for (int k = 0; k < 4; ++k) __builtin_amdgcn_global_load_lds((const unsigned*)(kb_ + (ko_ + (unsigned)k * (unsigned)(16 * RW * 2))), (LAS unsigned*)(Ks + bo_ + (k * 512 + w * 64) * 16), 16, 0, 0); } while (0)
#define RET_DMA_V(J_) do { const char* vb_ = vbase + (size_t)(J_) * 128; const int bo_ = ((J_) & 1) * 32768; unsigned vo_ = vo0; asm volatile("" : "+v"(vo_)); \
        _Pragma("unroll") for (int k = 0; k < 4; ++k) __builtin_amdgcn_global_load_lds((const unsigned*)(vb_ + (vo_ + (unsigned)k * (unsigned)(64 * T * 2))), (LAS unsigned*)(Vs + bo_ + (k * 512 + w * 64) * 16), 16, 0, 0); } while (0)
#define RET_BARV(n) do { asm volatile("s_waitcnt vmcnt(" #n ")" ::: "memory"); __builtin_amdgcn_s_barrier(); asm volatile("" ::: "memory"); } while (0)
    bf16x8 f0, f1, f2, f3;
    RET_DMA_K(0); RET_DMA_V(0); RET_DMA_K(1);
    RET_BARV(8);
    SBAR(); DSR128(f0, ka[0], 0); DSR128(f1, ka[1], 0); DSR128(f2, ka[2], 0); DSR128(f3, ka[3], 0); SBAR();
    for (int J = 0; J < nJ; ++J) {
        const bool hasn = (J + 1 < nJ);
        if (hasn) RET_BARV(4); else RET_BARV(0);
        if (hasn) RET_DMA_V(J + 1);
        const unsigned bofs = (unsigned)((J & 1) * 32768);
        unsigned kaj[8], vaj[4];
#pragma unroll
        for (int m = 0; m < 8; ++m) kaj[m] = ka[m] + bofs;
#pragma unroll
        for (int m = 0; m < 4; ++m) vaj[m] = va[m] + bofs;
        f32x16 sacc;
#pragma unroll
        for (int r = 0; r < 16; ++r) sacc[r] = 0.f;
        {
#define RET_S1(fr, ks, cnt, nxt) WAITL(cnt); sacc = __builtin_amdgcn_mfma_f32_32x32x16_bf16(fr, qf[ks], sacc, 0, 0, 0); SBAR(); nxt; SBAR();
            RET_S1(f0, 0, 3, DSR128(f0, kaj[4], 0)) RET_S1(f1, 1, 3, DSR128(f1, kaj[5], 0)) RET_S1(f2, 2, 3, DSR128(f2, kaj[6], 0)) RET_S1(f3, 3, 3, DSR128(f3, kaj[7], 0))
            RET_S1(f0, 4, 3, DSR128(f0, kaj[0], 256)) RET_S1(f1, 5, 3, DSR128(f1, kaj[1], 256)) RET_S1(f2, 6, 3, DSR128(f2, kaj[2], 256)) RET_S1(f3, 7, 3, DSR128(f3, kaj[3], 256))
            RET_S1(f0, 8, 3, DSR128(f0, kaj[4], 256)) RET_S1(f1, 9, 3, DSR128(f1, kaj[5], 256)) RET_S1(f2, 10, 3, DSR128(f2, kaj[6], 256)) RET_S1(f3, 11, 3, DSR128(f3, kaj[7], 256))
            RET_S1(f0, 12, 3, (void)0) RET_S1(f1, 13, 2, (void)0) RET_S1(f2, 14, 1, (void)0) RET_S1(f3, 15, 0, (void)0)
#undef RET_S1
        }
        if (J * 64 + 63 > I * 128 + rg * 32) { const int d0 = ipos - J * 64 - 32 * hf - 4 * hh;
#pragma unroll
            for (int r = 0; r < 16; ++r) sacc[r] = (d0 >= (r & 3) + 8 * (r >> 2)) ? sacc[r] : 0.f; }
#pragma unroll
        for (int q = 0; q < 4; ++q) { u32x2 pw; pw.x = cvt_pk_bf16(sacc[4 * q], sacc[4 * q + 1]); pw.y = cvt_pk_bf16(sacc[4 * q + 2], sacc[4 * q + 3]);
            *(LAS u32x2*)(pp + (((4 * hf + q) ^ px) * 16) + 8 * hh) = pw; }
        bf16x8 pA, pB, v0, v1, v2, v3;
        SBAR(); DSR128(v0, vaj[0], 0); DSR128(v1, vaj[0], 4096); DSR128(v2, vaj[0], 8192); DSR128(v3, vaj[0], 12288); SBAR();
        asm volatile("s_waitcnt lgkmcnt(4)" ::: "memory");
        RET_BARV(4);
        if (J + 2 < nJ) RET_DMA_K(J + 2);
        {
            SBAR(); DSR128(pA, pa[0], 0); DSR128(pB, pa[1], 0);
#define RET_S2(vr, pr_, et, cnt, nxt) WAITL(cnt); oacc[et] = __builtin_amdgcn_mfma_f32_32x32x16_bf16(vr, pr_, oacc[et], 0, 0, 0); SBAR(); nxt; SBAR();
            RET_S2(v0, pA, 0, 1, DSR128(v0, vaj[1], 0)) RET_S2(v1, pA, 1, 2, DSR128(v1, vaj[1], 4096)) RET_S2(v2, pA, 2, 3, DSR128(v2, vaj[1], 8192)) RET_S2(v3, pA, 3, 4, DSR128(v3, vaj[1], 12288))
            SBAR(); DSR128(pA, pa[2], 0);
            RET_S2(v0, pB, 0, 4, DSR128(v0, vaj[2], 0)) RET_S2(v1, pB, 1, 4, DSR128(v1, vaj[2], 4096)) RET_S2(v2, pB, 2, 4, DSR128(v2, vaj[2], 8192)) RET_S2(v3, pB, 3, 4, DSR128(v3, vaj[2], 12288))
            SBAR(); DSR128(pB, pa[3], 0);
            RET_S2(v0, pA, 0, 4, DSR128(v0, vaj[3], 0)) RET_S2(v1, pA, 1, 4, DSR128(v1, vaj[3], 4096)) RET_S2(v2, pA, 2, 4, DSR128(v2, vaj[3], 8192)) RET_S2(v3, pA, 3, 4, DSR128(v3, vaj[3], 12288))
            RET_S2(v0, pB, 0, 3, (void)0) RET_S2(v1, pB, 1, 2, (void)0) RET_S2(v2, pB, 2, 1, (void)0) RET_S2(v3, pB, 3, 0, (void)0)
#undef RET_S2
        }
        if (hasn) { const unsigned bn = (unsigned)(((J + 1) & 1) * 32768);
            SBAR(); DSR128(f0, ka[0] + bn, 0); DSR128(f1, ka[1] + bn, 0); DSR128(f2, ka[2] + bn, 0); DSR128(f3, ka[3] + bn, 0); SBAR(); }
    }
#undef RET_DMA_K
#undef RET_DMA_V
#undef RET_BARV
#undef RET_DMA_KV
#undef DSR128
#undef WAITL
#undef SBAR
    float s1 = 0.f, s2 = 0.f;
#pragma unroll
    for (int et = 0; et < 4; ++et)
#pragma unroll
        for (int r = 0; r < 16; ++r) { s1 += oacc[et][r]; s2 += oacc[et][r] * oacc[et][r]; }
    s1 += __shfl_xor(s1, 32); s2 += __shfl_xor(s2, 32);
    if (hh == 0) { Xs[(hf * 128 + pr) * 2] = s1; Xs[(hf * 128 + pr) * 2 + 1] = s2; }
    RET_BAR();
    s1 += Xs[((hf ^ 1) * 128 + pr) * 2]; s2 += Xs[((hf ^ 1) * 128 + pr) * 2 + 1];
    const float mean = s1 * (1.0f / 256.0f); const float var = fmaxf(s2 * (1.0f / 256.0f) - mean * mean, 0.f);
    const float rstd = 1.0f / sqrtf(var + LN_EPS);
    u32x2 gvv[4][4];
#pragma unroll
    for (int et = 0; et < 4; ++et)
#pragma unroll
        for (int q = 0; q < 4; ++q) gvv[et][q] = *(const u32x2*)(Gs + tok * RW + h * HD + 128 * hf + 32 * et + 8 * q + 4 * hh);
#pragma unroll
    for (int et = 0; et < 4; ++et)
#pragma unroll
        for (int q = 0; q < 4; ++q) { const int e = h * HD + 128 * hf + 32 * et + 8 * q + 4 * hh;
            const u32x2 gv = gvv[et][q];
            *(unsigned*)(MIX8 + tok * DM + e) = cvt4_fp8((oacc[et][4 * q] - mean) * rstd * bflo(gv.x), (oacc[et][4 * q + 1] - mean) * rstd * bfhi(gv.x),
                                                         (oacc[et][4 * q + 2] - mean) * rstd * bflo(gv.y), (oacc[et][4 * q + 3] - mean) * rstd * bfhi(gv.y)); }
    RET_BAR();
}

constexpr int S5A_OFF = 0, S5I_OFF = 65536, S5E_OFF = S5I_OFF + 128 * 129 * 4;
__device__ __forceinline__ void s5in_pair(Frame& F, bf16* U2, const bf16* Min, const float* A16, int g, int b0) {
    const int l15 = F.lane & 15, g4 = F.lane >> 4, w = F.wave;
    LAS unsigned char* As = F.lds + S5A_OFF; LAS float* inc = (LAS float*)(F.lds + S5I_OFF); LAS float* Es = (LAS float*)(F.lds + S5E_OFF);
#define S5_STAGE(bb) do { const char* ub = (const char*)(U2 + (size_t)(g * 1024 + (bb) * 128) * KS5); const int row0 = w * 2 + (F.lane >> 5); \
      const unsigned so = (unsigned)(row0 * KS5 * 2 + (((F.lane & 31) ^ (row0 & 15)) * 16)); \
      _Pragma("unroll") for (int k = 0; k < 8; ++k) pg8::glds16s(ub + (size_t)k * (16 * KS5 * 2), so, (unsigned)(size_t)As + (unsigned)((k * 512 + w * 64) * 16)); } while (0)
    S5_STAGE(b0);
    bf16x8 bfr[8];
#pragma unroll
    for (int ks = 0; ks < 8; ++ks) bfr[ks] = *(const bf16x8*)(Min + (size_t)(w * 16 + l15) * 256 + ks * 32 + g4 * 8);
    const float a16r = A16[F.lane * 2], a16i = A16[F.lane * 2 + 1];
#pragma nounroll
    for (int ub_ = 0; ub_ < 2; ++ub_) { const int b = b0 + ub_;
    asm volatile("s_waitcnt vmcnt(0)" ::: "memory"); __syncthreads();
#pragma unroll 2
    for (int ct = 0; ct < 8; ++ct) { f32x4 acc = (f32x4){0.f, 0.f, 0.f, 0.f}; const int row = ct * 16 + l15;
#pragma unroll
        for (int ks = 0; ks < 8; ++ks) { const bf16x8 af = *(const LAS bf16x8*)(As + row * 512 + (((4 * ks + g4) ^ (row & 15)) * 16));
            acc = __builtin_amdgcn_mfma_f32_16x16x32_bf16(af, bfr[ks], acc, 0, 0, 0); }
#pragma unroll
        for (int r = 0; r < 4; ++r) inc[(ct * 16 + 4 * g4 + r) * 129 + w * 16 + l15] = acc[r]; }
    __syncthreads();
    if (ub_ == 0) S5_STAGE(b0 + 1);
    { const int p = F.lane, seg = w; const float ar = a16r, ai = a16i;
      float hr = 0.f, hi = 0.f;
#pragma unroll 4
      for (int j = 0; j < 16; ++j) { const int c = seg * 16 + j; const float ir = inc[c * 129 + p], ii = inc[c * 129 + 64 + p];
          const float nr = ar * hr - ai * hi + ir, ni = ar * hi + ai * hr + ii; hr = nr; hi = ni; }
      Es[(seg * 64 + p) * 2] = hr; Es[(seg * 64 + p) * 2 + 1] = hi;
      float pr = ar, pi = ai;
#pragma unroll
      for (int q = 0; q < 4; ++q) { const float t = pr * pr - pi * pi; pi = 2.f * pr * pi; pr = t; }
      LDS_WAIT(); __builtin_amdgcn_s_barrier(); asm volatile("" ::: "memory");
      float sr = 0.f, si = 0.f;
      for (int j = 0; j < seg; ++j) { const float er = Es[(j * 64 + p) * 2], ei = Es[(j * 64 + p) * 2 + 1]; const float nr = pr * sr - pi * si + er, ni = pr * si + pi * sr + ei; sr = nr; si = ni; }
      hr = sr; hi = si;
      bf16* row = U2 + (size_t)(g * 1024 + b * 128 + seg * 16) * KS5 + 256 + p;
#pragma unroll 4
      for (int j = 0; j < 16; ++j) { const int c = seg * 16 + j;
          row[(size_t)j * KS5] = (bf16)(cvt_pk_bf16(hr, 0.f) & 0xffffu); row[(size_t)j * KS5 + 64] = (bf16)(cvt_pk_bf16(hi, 0.f) & 0xffffu);
          const float ir = inc[c * 129 + p], ii = inc[c * 129 + 64 + p];
          const float nr = ar * hr - ai * hi + ir, ni = ar * hi + ai * hr + ii; hr = nr; hi = ni; }
    }
    LDS_WAIT(); __builtin_amdgcn_s_barrier(); asm volatile("" ::: "memory");
    }
    asm volatile("s_waitcnt vmcnt(0)" ::: "memory"); __syncthreads();
#undef S5_STAGE
}

__device__ __forceinline__ void ln1_router_unit(Frame& F, const Args& a, int layer, int unit) {
    const int l15 = F.lane & 15, g4 = F.lane >> 4, w = F.wave;
    const bf16* Zb = (const bf16*)(F.ws + WS_Z); unsigned char* X1F8 = F.ws + WS_XF; float* stats = (float*)(F.ws + WS_Z + 64 * MiB);
    const float* gam = a.in[12] + layer * DM; const float* bet = a.in[13] + layer * DM;
    LAS int* lcnt = (LAS int*)(F.lds + TST_OFF + 640); LAS int* lbase = lcnt + 32;
    if (F.tid < 32) lcnt[F.tid] = 0;
    const int r0 = unit * 64;
    LAS unsigned char* x1s = F.lds;
    LAS float* gl = (LAS float*)(F.lds + 131584);
    const f32x4 gst = *(const f32x4*)(gam + 4 * F.tid), bst = *(const f32x4*)(bet + 4 * F.tid);
    LAS float* sts = (LAS float*)(F.lds + 147968);
    f32x4 acc[4][2];
#pragma unroll
    for (int rt = 0; rt < 4; ++rt) { acc[rt][0] = (f32x4){0.f, 0.f, 0.f, 0.f}; acc[rt][1] = (f32x4){0.f, 0.f, 0.f, 0.f}; }
    {
        u32x4 xin[8][4];
#pragma unroll
        for (int rr = 0; rr < 8; ++rr)
#pragma unroll
            for (int j = 0; j < 4; ++j) xin[rr][j] = __builtin_nontemporal_load((const u32x4*)(Zb + (size_t)(r0 + 32 * (rr >> 2) + 4 * w + (rr & 3)) * DM + 8 * F.lane + 512 * j));
        *(LAS f32x4*)(gl + 4 * F.tid) = gst; *(LAS f32x4*)(gl + DM + 4 * F.tid) = bst;
        LDS_WAIT(); __builtin_amdgcn_s_barrier(); asm volatile("" ::: "memory");
        size_t zo_ = 0; asm volatile("" : "+s"(zo_));
        const bf16* rwh = (const bf16*)(F.ws + WS_RWT) + zo_ + (size_t)l15 * DM + w * 256 + g4 * 8; const bf16* rwl = rwh + NE * DM;
#pragma unroll
        for (int p = 0; p < 2; ++p) {
#pragma unroll
            for (int q4 = 0; q4 < 4; ++q4) { const int rr = 4 * p + q4; const int lr = 4 * w + q4; float v[4][8]; float s = 0.f;
                unsigned go_ = (unsigned)(8 * F.lane); asm volatile("" : "+v"(go_));
#pragma unroll
                for (int j = 0; j < 4; ++j) { const u32x4 x = xin[rr][j];
                    v[j][0] = bflo(x.x); v[j][1] = bfhi(x.x); v[j][2] = bflo(x.y); v[j][3] = bfhi(x.y); v[j][4] = bflo(x.z); v[j][5] = bfhi(x.z); v[j][6] = bflo(x.w); v[j][7] = bfhi(x.w);
#pragma unroll
                    for (int q = 0; q < 8; ++q) s += v[j][q]; }
                const float mean = wave_sum(s) * (1.0f / DM); float s2 = 0.f;
#pragma unroll
                for (int j = 0; j < 4; ++j)
#pragma unroll
                    for (int q = 0; q < 8; ++q) { v[j][q] -= mean; s2 += v[j][q] * v[j][q]; }
                const float rstd = 1.0f / sqrtf(wave_sum(s2) * (1.0f / DM) + LN_EPS);
                if (F.lane == 0) { sts[(32 * p + lr) * 2] = mean; sts[(32 * p + lr) * 2 + 1] = rstd; }
#pragma unroll
                for (int j = 0; j < 4; ++j) { const f32x4 g0 = *(const LAS f32x4*)(gl + go_ + 512 * j), g1 = *(const LAS f32x4*)(gl + go_ + 512 * j + 4), b0 = *(const LAS f32x4*)(gl + DM + go_ + 512 * j), b1 = *(const LAS f32x4*)(gl + DM + go_ + 512 * j + 4);
                    u32x4 pk; pk.x = cvt_pk_bf16(v[j][0] * rstd * g0[0] + b0[0], v[j][1] * rstd * g0[1] + b0[1]); pk.y = cvt_pk_bf16(v[j][2] * rstd * g0[2] + b0[2], v[j][3] * rstd * g0[3] + b0[3]);
                    pk.z = cvt_pk_bf16(v[j][4] * rstd * g1[0] + b1[0], v[j][5] * rstd * g1[1] + b1[1]); pk.w = cvt_pk_bf16(v[j][6] * rstd * g1[2] + b1[2], v[j][7] * rstd * g1[3] + b1[3]);
                    *(LAS u32x4*)(x1s + lr * 4112 + (8 * F.lane + 512 * j) * 2) = pk;
                    u32x2 p8; p8.x = cvt4_fp8(bflo(pk.x), bfhi(pk.x), bflo(pk.y), bfhi(pk.y)); p8.y = cvt4_fp8(bflo(pk.z), bfhi(pk.z), bflo(pk.w), bfhi(pk.w));
                    *(u32x2*)(X1F8 + (size_t)(r0 + 32 * p + lr) * DM + 8 * F.lane + 512 * j) = p8; }
            }
            LDS_WAIT(); __builtin_amdgcn_s_barrier(); asm volatile("" ::: "memory");
#pragma nounroll
            for (int s0 = 0; s0 < 8; s0 += 4) {
                bf16x8 ah[4][2], bh[4][2], bl[4][2];
#pragma unroll
                for (int i = 0; i < 4; ++i) {
#pragma unroll
                    for (int t = 0; t < 2; ++t) ah[i][t] = *(const LAS bf16x8*)(x1s + (t * 16 + l15) * 4112 + (w * 256 + (s0 + i) * 32 + g4 * 8) * 2);
#pragma unroll
                    for (int n = 0; n < 2; ++n) { bh[i][n] = *(const bf16x8*)(rwh + (size_t)n * 16 * DM + (s0 + i) * 32); bl[i][n] = *(const bf16x8*)(rwl + (size_t)n * 16 * DM + (s0 + i) * 32); } }
#pragma unroll
                for (int i = 0; i < 4; ++i)
#pragma unroll
                    for (int t = 0; t < 2; ++t)
#pragma unroll
                        for (int n = 0; n < 2; ++n) { acc[2 * p + t][n] = __builtin_amdgcn_mfma_f32_16x16x32_bf16(ah[i][t], bh[i][n], acc[2 * p + t][n], 0, 0, 0);
                            acc[2 * p + t][n] = __builtin_amdgcn_mfma_f32_16x16x32_bf16(ah[i][t], bl[i][n], acc[2 * p + t][n], 0, 0, 0); } }
            LDS_WAIT(); __builtin_amdgcn_s_barrier(); asm volatile("" ::: "memory");
        }
    }
    {
      LAS float* part = (LAS float*)F.lds;
#pragma unroll
      for (int rt = 0; rt < 4; ++rt)
#pragma unroll
          for (int n = 0; n < 2; ++n)
#pragma unroll
              for (int r = 0; r < 4; ++r) part[(w * 64 + rt * 16 + 4 * g4 + r) * 33 + n * 16 + l15] = acc[rt][n][r];
    }
    __syncthreads();
    { LAS float* part = (LAS float*)F.lds; LAS float* lsum = part + 8 * 64 * 33;
      const int row = F.tid >> 3, eb = (F.tid & 7) * 4;
#pragma unroll
      for (int j = 0; j < 4; ++j) { float sacc_ = 0.f;
#pragma unroll
          for (int k = 0; k < 8; ++k) sacc_ += part[(k * 64 + row) * 33 + eb + j];
          lsum[row * 33 + eb + j] = sacc_; } }
    __syncthreads();
    int e0 = 0, e1 = 0, rk0 = 0, rk1 = 0; float w0 = 0.f, w1 = 0.f;
    if (F.tid < 64) { const LAS float* part = (const LAS float*)F.lds; const float* rb = a.in[17];
        float lgt[32]; float mx = -3.0e38f;
#pragma unroll
        for (int e = 0; e < 32; ++e) { lgt[e] = part[(8 * 64 + F.tid) * 33 + e] + rb[e]; mx = fmaxf(mx, lgt[e]); }
        float bs = -1.f; float ba1 = 0.f, ba2 = 0.f; int bi1 = 0, bi2 = 0;
#pragma unroll
        for (int gi = 0; gi < 4; ++gi) { float a1 = -3.0e38f, a2 = -3.0e38f; int i1 = 0, i2 = 0;
#pragma unroll
            for (int j = 0; j < 8; ++j) { const float v = lgt[gi * 8 + j]; if (v > a1) { a2 = a1; i2 = i1; a1 = v; i1 = gi * 8 + j; } else if (v > a2) { a2 = v; i2 = gi * 8 + j; } }
            const float p1 = __expf(a1 - mx), p2 = __expf(a2 - mx), sc = p1 + p2;
            if (sc > bs) { bs = sc; ba1 = p1; ba2 = p2; bi1 = i1; bi2 = i2; } }
        e0 = bi1; e1 = bi2; w0 = ba1 / (ba1 + ba2); w1 = ba2 / (ba1 + ba2);
        rk0 = __hip_atomic_fetch_add(lcnt + e0, 1, __ATOMIC_RELAXED, __HIP_MEMORY_SCOPE_WORKGROUP);
        rk1 = __hip_atomic_fetch_add(lcnt + e1, 1, __ATOMIC_RELAXED, __HIP_MEMORY_SCOPE_WORKGROUP);
    }
    __syncthreads();
    if (F.tid < 32) lbase[F.tid] = (int)__hip_atomic_fetch_add(F.ctl + CW_CNT + (layer * NE + F.tid) * 64, (unsigned)lcnt[F.tid], __ATOMIC_RELAXED, __HIP_MEMORY_SCOPE_AGENT);
    __syncthreads();
    if (F.tid < 64) { const int tok = r0 + F.tid; const int s0 = lbase[e0] + rk0, s1 = lbase[e1] + rk1;
        int* list = (int*)(F.ws + WS_LIST); list[e0 * T + s0] = tok; list[e1 * T + s1] = tok;
        i32x4* ti = (i32x4*)(F.ws + WS_TOK) + (size_t)tok * 2;
        ti[0] = (i32x4){e0, s0, e1, s1}; ti[1] = (i32x4){(int)__float_as_uint(w0), (int)__float_as_uint(w1), 0, 0}; }
    if (F.tid < 64) { f32x2 st; st[0] = sts[F.tid * 2]; st[1] = sts[F.tid * 2 + 1]; *(f32x2*)(stats + (size_t)(r0 + F.tid) * 2) = st; }
    __syncthreads();
}

__device__ __forceinline__ void moe_setup(Frame& F, int layer) {
    LAS int* cnt = (LAS int*)(F.lds + TST_OFF); LAS int* pst = cnt + 32; LAS int* fst = pst + 33; LAS int* hst = fst + 33;
    __syncthreads();
    if (F.tid < 32) cnt[F.tid] = (int)__hip_atomic_load(F.ctl + CW_CNT + (layer * NE + F.tid) * 64, __ATOMIC_RELAXED, __HIP_MEMORY_SCOPE_AGENT);
    __syncthreads();
    if (F.tid < 64) {
        const int e = F.tid; int c = e < NE ? cnt[e & 31] : 0; c = c < 0 ? 0 : (c > T ? T : c); const int t = (c + 127) >> 7, f = t >> 1, hb = t & 1;
        int st = t, sf = f, sh = hb;
#pragma unroll
        for (int o = 1; o < 32; o <<= 1) { const int a = __shfl_up(st, o), b = __shfl_up(sf, o), d = __shfl_up(sh, o); if (e >= o) { st += a; sf += b; sh += d; } }
        if (e < NE) { pst[e] = st - t; fst[e] = sf - f; hst[e] = sh - hb; }
        if (e == NE - 1) { pst[NE] = st; fst[NE] = sf; hst[NE] = sh; } }
    __syncthreads();
}

constexpr int LN2R = 2;
__device__ __forceinline__ void ln2_rows(Frame& F, const LAS float* gl, const int (&toks)[LN2R], float* outf, bf16* outb) {
    const LAS int* pst = (const LAS int*)(F.lds + TST_OFF) + 32;
    i32x4 inf[LN2R][2];
#pragma unroll
    for (int r = 0; r < LN2R; ++r) { const i32x4* ti = (const i32x4*)(F.ws + WS_TOK) + (size_t)toks[r] * 2; inf[r][0] = ti[0]; inf[r][1] = ti[1]; }
    u32x4 xx[LN2R][4]; u32x2 pa[LN2R][4], pb[LN2R][4]; f32x2 stv[LN2R];
#pragma unroll
    for (int r = 0; r < LN2R; ++r) { const int tok = toks[r]; const int e0 = inf[r][0][0] & 31, e1 = inf[r][0][2] & 31;
        const size_t ra = (size_t)pst[e0] * 128 + inf[r][0][1], rb = (size_t)pst[e1] * 128 + inf[r][0][3];
        const bf16* x1 = (const bf16*)(F.ws + WS_Z) + (size_t)tok * DM + 8 * F.lane;
        stv[r] = *(const f32x2*)((const float*)(F.ws + WS_Z + 64 * MiB) + (size_t)tok * 2);
        const unsigned char* ya = F.ws + WS_YB + ra * DM + 8 * F.lane; const unsigned char* yb = F.ws + WS_YB + rb * DM + 8 * F.lane;
#pragma unroll
        for (int j = 0; j < 4; ++j) { xx[r][j] = __builtin_nontemporal_load((const u32x4*)(x1 + 512 * j)); pa[r][j] = __builtin_nontemporal_load((const u32x2*)(ya + 512 * j)); pb[r][j] = __builtin_nontemporal_load((const u32x2*)(yb + 512 * j)); } }
    float wts[LN2R][2];
#pragma unroll
    for (int r = 0; r < LN2R; ++r) { wts[r][0] = __uint_as_float((unsigned)inf[r][1][0]) * 0.0625f; wts[r][1] = __uint_as_float((unsigned)inf[r][1][1]) * 0.0625f; }
#pragma unroll
    for (int r = 0; r < LN2R; ++r) { const int tok = toks[r];
        const float w0 = wts[r][0], w1 = wts[r][1];
        float v[4][8]; float s = 0.f;
        const float m1 = stv[r][0], r1 = stv[r][1];
        unsigned g1o_ = (unsigned)(8 * F.lane); asm volatile("" : "+v"(g1o_));
#pragma unroll
        for (int j = 0; j < 4; ++j) { const u32x4 x = xx[r][j]; const u32x2 p = pa[r][j], q = pb[r][j];
            const f32x4 ga = *(const LAS f32x4*)(gl + 2 * DM + g1o_ + 512 * j), gb = *(const LAS f32x4*)(gl + 2 * DM + g1o_ + 512 * j + 4), ba = *(const LAS f32x4*)(gl + 3 * DM + g1o_ + 512 * j), bb = *(const LAS f32x4*)(gl + 3 * DM + g1o_ + 512 * j + 4);
            float x1v[8];
            x1v[0] = (bflo(x.x) - m1) * r1 * ga[0] + ba[0]; x1v[1] = (bfhi(x.x) - m1) * r1 * ga[1] + ba[1]; x1v[2] = (bflo(x.y) - m1) * r1 * ga[2] + ba[2]; x1v[3] = (bfhi(x.y) - m1) * r1 * ga[3] + ba[3];
            x1v[4] = (bflo(x.z) - m1) * r1 * gb[0] + bb[0]; x1v[5] = (bfhi(x.z) - m1) * r1 * gb[1] + bb[1]; x1v[6] = (bflo(x.w) - m1) * r1 * gb[2] + bb[2]; x1v[7] = (bfhi(x.w) - m1) * r1 * gb[3] + bb[3];
            const f32x2 p0 = __builtin_amdgcn_cvt_pk_f32_fp8((int)p.x, false), p1 = __builtin_amdgcn_cvt_pk_f32_fp8((int)p.x, true), p2 = __builtin_amdgcn_cvt_pk_f32_fp8((int)p.y, false), p3 = __builtin_amdgcn_cvt_pk_f32_fp8((int)p.y, true);
            const f32x2 q0 = __builtin_amdgcn_cvt_pk_f32_fp8((int)q.x, false), q1 = __builtin_amdgcn_cvt_pk_f32_fp8((int)q.x, true), q2 = __builtin_amdgcn_cvt_pk_f32_fp8((int)q.y, false), q3 = __builtin_amdgcn_cvt_pk_f32_fp8((int)q.y, true);
            v[j][0] = ALPHA * x1v[0] + w0 * p0[0] + w1 * q0[0]; v[j][1] = ALPHA * x1v[1] + w0 * p0[1] + w1 * q0[1];
            v[j][2] = ALPHA * x1v[2] + w0 * p1[0] + w1 * q1[0]; v[j][3] = ALPHA * x1v[3] + w0 * p1[1] + w1 * q1[1];
            v[j][4] = ALPHA * x1v[4] + w0 * p2[0] + w1 * q2[0]; v[j][5] = ALPHA * x1v[5] + w0 * p2[1] + w1 * q2[1];
            v[j][6] = ALPHA * x1v[6] + w0 * p3[0] + w1 * q3[0]; v[j][7] = ALPHA * x1v[7] + w0 * p3[1] + w1 * q3[1];
#pragma unroll
            for (int t = 0; t < 8; ++t) s += v[j][t]; }
        const float mean = wave_sum(s) * (1.0f / DM); float s2 = 0.f;
#pragma unroll
        for (int j = 0; j < 4; ++j)
#pragma unroll
            for (int t = 0; t < 8; ++t) { v[j][t] -= mean; s2 += v[j][t] * v[j][t]; }
        const float rstd = 1.0f / sqrtf(wave_sum(s2) * (1.0f / DM) + LN_EPS);
        unsigned go_ = (unsigned)(8 * F.lane); asm volatile("" : "+v"(go_));
#pragma unroll
        for (int j = 0; j < 4; ++j) { const f32x4 g0 = *(const LAS f32x4*)(gl + go_ + 512 * j), g1 = *(const LAS f32x4*)(gl + go_ + 512 * j + 4), b0 = *(const LAS f32x4*)(gl + DM + go_ + 512 * j), b1 = *(const LAS f32x4*)(gl + DM + go_ + 512 * j + 4);
            f32x4 o0, o1;
#pragma unroll
            for (int t = 0; t < 4; ++t) { o0[t] = v[j][t] * rstd * g0[t] + b0[t]; o1[t] = v[j][4 + t] * rstd * g1[t] + b1[t]; }
            if (outf) { float* op = outf + (size_t)tok * DM + 8 * F.lane + 512 * j; __builtin_nontemporal_store(o0, (f32x4*)op); __builtin_nontemporal_store(o1, (f32x4*)(op + 4)); }
            if (outb) { u32x4 pk; pk.x = cvt_pk_bf16(o0[0], o0[1]); pk.y = cvt_pk_bf16(o0[2], o0[3]); pk.z = cvt_pk_bf16(o1[0], o1[1]); pk.w = cvt_pk_bf16(o1[2], o1[3]);
                __builtin_nontemporal_store(pk, (u32x4*)(outb + (size_t)tok * DM + 8 * F.lane + 512 * j));
                u32x2 p8; p8.x = cvt4_fp8(o0[0], o0[1], o0[2], o0[3]); p8.y = cvt4_fp8(o1[0], o1[1], o1[2], o1[3]); *(u32x2*)(F.ws + WS_XB8 + (size_t)tok * DM + 8 * F.lane + 512 * j) = p8; } }
    }
}

__global__ void __launch_bounds__(NWAVES * 64, 2) mk_fwd(Args args) {
    extern __shared__ __attribute__((aligned(16))) unsigned char lds_raw[];
    Frame F;
    F.lds = (LAS unsigned char*)lds_raw;
    F.tid = threadIdx.x; F.lane = F.tid & 63; F.wave = __builtin_amdgcn_readfirstlane(F.tid >> 6);
    F.G = gridDim.x; { const int bx = blockIdx.x; F.vcu = (F.G % 8 == 0) ? (bx % 8) * (F.G / 8) + bx / 8 : bx; }
    F.ws = args.ws; F.ctl = (unsigned*)(args.ws + WS_CTL);
    volatile LAS unsigned* MISC = (volatile LAS unsigned*)(F.lds + MISC_OFF);
    if (F.tid < 4) MISC[F.tid] = 0u;
    __syncthreads();
    XcdBarrier bar; bar.bar = F.ctl + CW_BAR; bar.x = 0; bar.st = MISC;
    if (MK_N_LAUNCHES == 1) bar = xcd_barrier_post(F.ctl + CW_BAR, MISC);
    const int lo = args.ph_lo, hi = args.ph_hi;
#ifndef ONLY_PHASE
#define ONLY_PHASE -1
#endif
#define PON(k) (ONLY_PHASE < 0 || ONLY_PHASE == (k))
#ifndef PROBE_PHASE
#define PROBE_PHASE -1
#endif
#define RPT(k) ((PROBE_PHASE == (k)) ? 2 : 1)
#define IN(k) (lo <= (k) && (k) < hi)
#define PHASE_FRAME Frame P = F; { size_t z_ = 0; asm volatile("" : "+s"(z_)); P.ws = F.ws + z_; P.wave = F.wave + (int)z_; } P.lane = (int)__builtin_amdgcn_mbcnt_hi(~0u, __builtin_amdgcn_mbcnt_lo(~0u, 0u)); asm volatile("" : "+v"(P.lane)); P.tid = P.wave * 64 + P.lane; P.ctl = (unsigned*)(P.ws + WS_CTL)
#define SEAM(k) do { if (IN(k) && IN((k) + 1)) xcd_barrier(bar); } while (0)

    if (PON(0) && IN(0)) { PHASE_FRAME; p0_prologue(P, args); __syncthreads(); }
    if (PROBE_PHASE == 0 && PON(0) && IN(0)) { PHASE_FRAME; p0_prologue(P, args); __syncthreads(); }
    SEAM(0);

    for (int layer = 0; layer < 2; ++layer) {
        const int pb = 1 + 9 * layer;
#define MIXCONV() do { const int c_ = P.vcu & 1, ng_ = (P.G >> 1) * NWAVES, g0_ = (P.vcu >> 1) * NWAVES + P.wave; \
            convert_items(P, args, TI_IN / 2 + c_ * (TI_IN / 4), TI_IN / 4, g0_, ng_); \
            convert_items(P, args, TI_IN + c_ * (TI_OUT / 2), TI_OUT / 2, (g0_ + ng_ - (TI_IN / 8) % ng_) % ng_, ng_); \
            convert_items(P, args, TI_IN + TI_OUT + c_ * (TI_GLU / 2), TI_GLU / 2, (g0_ + 2 * ng_ - (TI_IN / 8 + TI_OUT / 4) % ng_) % ng_, ng_); } while (0)
        if (PON(1) && IN(pb + 0)) for (int rp_ = 0; rp_ < RPT(1); ++rp_) {
            PHASE_FRAME;
            bf16* XB = (bf16*)(P.ws + WS_XB); float* XF = (float*)(P.ws + WS_XF);
            bf16* Qb = (bf16*)(P.ws + WS_Q); bf16* Kb = (bf16*)(P.ws + WS_K); bf16* Gb = (bf16*)(P.ws + WS_G); bf16* VT = (bf16*)(P.ws + WS_VT);
            bf16* U2 = (bf16*)(P.ws + WS_U2); bf16* Yb = (bf16*)(P.ws + WS_Y); bf16* MIX = (bf16*)(P.ws + WS_MIX); float* Z = (float*)(P.ws + WS_Z);
            bf16* X1B = (bf16*)(P.ws + WS_X1B); bf16* Hb = (bf16*)(P.ws + WS_H); bf16* YB = (bf16*)(P.ws + WS_YB);
            const bf16* Win = (const bf16*)(P.ws + WS_WIN) + (size_t)layer * NPROJ * DM;
            (void)XB; (void)XF; (void)Qb; (void)Kb; (void)Gb; (void)VT; (void)U2; (void)Yb; (void)MIX; (void)Z; (void)X1B; (void)Hb; (void)YB; (void)Win;
            { pg8::DenseOrder S; S.init(T, 4096, DM, P.G, (int)blockIdx.x, P.ws + WS_WIN + (size_t)layer * NPROJ * DM, 1);
              pg8::EpiInProj E{Qb, Kb, Gb, U2, (const float*)(P.ws + WS_COS), (const float*)(P.ws + WS_SIN)};
              if (layer == 0 && (P.vcu & 1) != 0) { MIXCONV(); __syncthreads(); }
              S.ulist = (const LAS int*)(P.lds + TST_OFF + 896); __syncthreads(); pg8::moe_units(S, (LAS int*)(P.lds + TST_OFF + 896), P.tid); __syncthreads();
              pg8::gemm_phase<true>(P.lds, P.tid, (const char*)(P.ws + WS_XB8), DM, S, E); }
            { pg8::DenseOrder S; S.init(1024, T, DM, P.G, (int)blockIdx.x, P.ws + WS_XB8, 1);
              pg8::EpiBf16 E{VT, T, W8_INV};
              S.ulist = (const LAS int*)(P.lds + TST_OFF + 896); __syncthreads(); pg8::moe_units(S, (LAS int*)(P.lds + TST_OFF + 896), P.tid); __syncthreads();
              pg8::gemm_phase<true>(P.lds, P.tid, (const char*)(P.ws + WS_WIN + ((size_t)layer * NPROJ + 4096) * DM), DM, S, E); }
            if (layer == 0 && (P.vcu & 1) == 0) { __syncthreads(); MIXCONV(); }
        }
        SEAM(pb + 0);

        if (PON(2) && IN(pb + 1)) for (int rp_ = 0; rp_ < RPT(2); ++rp_) {
            PHASE_FRAME;
            bf16* XB = (bf16*)(P.ws + WS_XB); float* XF = (float*)(P.ws + WS_XF);
            bf16* Qb = (bf16*)(P.ws + WS_Q); bf16* Kb = (bf16*)(P.ws + WS_K); bf16* Gb = (bf16*)(P.ws + WS_G); bf16* VT = (bf16*)(P.ws + WS_VT);
            bf16* U2 = (bf16*)(P.ws + WS_U2); bf16* Yb = (bf16*)(P.ws + WS_Y); bf16* MIX = (bf16*)(P.ws + WS_MIX); float* Z = (float*)(P.ws + WS_Z);
            bf16* X1B = (bf16*)(P.ws + WS_X1B); bf16* Hb = (bf16*)(P.ws + WS_H); bf16* YB = (bf16*)(P.ws + WS_YB);
            const bf16* Win = (const bf16*)(P.ws + WS_WIN) + (size_t)layer * NPROJ * DM;
            (void)XB; (void)XF; (void)Qb; (void)Kb; (void)Gb; (void)VT; (void)U2; (void)Yb; (void)MIX; (void)Z; (void)X1B; (void)Hb; (void)YB; (void)Win;
            const int cpos = P.vcu & 3, ufirst4 = TI_MOE0 + TI_G + layer * (TI_U / 2) + cpos * (TI_U / 8), cgw4 = (P.vcu >> 2) * NWAVES + P.wave, cngw4 = (P.G >> 2) * NWAVES;
            for (int rq_ = 0; rq_ < (PROBE_PHASE == 21 ? 2 : 1); ++rq_)
            for (int u = P.vcu; u < 256; u += P.G) { const int bh = u >> 3, p = u & 7, b = bh >> 2, h = bh & 3;
                if (cpos == 0) { convert_items(P, args, ufirst4, TI_U / 8, cgw4, cngw4); __syncthreads(); }
                retention_qtile(P, Qb, Kb, VT, Gb, P.ws + WS_MIX8, b, h, 15 - p); __syncthreads();
                if (cpos == 1) { convert_items(P, args, ufirst4, TI_U / 8, cgw4, cngw4); __syncthreads(); }
                retention_qtile(P, Qb, Kb, VT, Gb, P.ws + WS_MIX8, b, h, p); __syncthreads();
                if (cpos == 2) { convert_items(P, args, ufirst4, TI_U / 8, cgw4, cngw4); __syncthreads(); } }
            for (int rq_ = 0; rq_ < (PROBE_PHASE == 22 ? 2 : 1); ++rq_)
            for (int u2 = P.vcu * 2; u2 < 512; u2 += 2 * P.G) { const int g = u2 >> 3, b0 = u2 & 7;
                s5in_pair(P, U2, (const bf16*)(P.ws + WS_S5IN) + ((size_t)layer * SGRP + g) * (128 * 256), (const float*)(P.ws + WS_S5A) + ((size_t)layer * SGRP + g) * SST * 2, g, b0); }
            if (cpos == 3) { __syncthreads(); convert_items(P, args, ufirst4, TI_U / 8, cgw4, cngw4); __syncthreads(); }
        }
        if (F.G == 256) { if (IN(pb + 1) && IN(pb + 2)) { VM_WAIT(); __syncthreads(); } } else SEAM(pb + 1);

        if (PON(3) && IN(pb + 2)) for (int rp_ = 0; rp_ < RPT(3); ++rp_) {
            PHASE_FRAME;
            bf16* XB = (bf16*)(P.ws + WS_XB); float* XF = (float*)(P.ws + WS_XF);
            bf16* Qb = (bf16*)(P.ws + WS_Q); bf16* Kb = (bf16*)(P.ws + WS_K); bf16* Gb = (bf16*)(P.ws + WS_G); bf16* VT = (bf16*)(P.ws + WS_VT);
            bf16* U2 = (bf16*)(P.ws + WS_U2); bf16* Yb = (bf16*)(P.ws + WS_Y); bf16* MIX = (bf16*)(P.ws + WS_MIX); float* Z = (float*)(P.ws + WS_Z);
            bf16* X1B = (bf16*)(P.ws + WS_X1B); bf16* Hb = (bf16*)(P.ws + WS_H); bf16* YB = (bf16*)(P.ws + WS_YB);
            const bf16* Win = (const bf16*)(P.ws + WS_WIN) + (size_t)layer * NPROJ * DM;
            (void)XB; (void)XF; (void)Qb; (void)Kb; (void)Gb; (void)VT; (void)U2; (void)Yb; (void)MIX; (void)Z; (void)X1B; (void)Hb; (void)YB; (void)Win;
            pg8::S5Order S; S.G = P.G; S.c = P.vcu; S.Bt = (const char*)((const bf16*)(P.ws + WS_S5OUT) + (size_t)layer * SGRP * 256 * KS5);
            pg8::EpiS5Out E{Yb, P.ws + WS_Y8};
            int k5 = KS5; asm volatile("" : "+s"(k5));
            S.ulist = (const LAS int*)(P.lds + TST_OFF + 896); __syncthreads(); pg8::moe_units(S, (LAS int*)(P.lds + TST_OFF + 896), P.tid); __syncthreads();
            pg8::gemm_phase<false>(P.lds, P.tid, (const char*)U2, k5, S, E);
        }
        SEAM(pb + 2);

        if (PON(4) && IN(pb + 3)) for (int rp_ = 0; rp_ < RPT(4); ++rp_) {
            PHASE_FRAME;
            bf16* XB = (bf16*)(P.ws + WS_XB); float* XF = (float*)(P.ws + WS_XF);
            bf16* Qb = (bf16*)(P.ws + WS_Q); bf16* Kb = (bf16*)(P.ws + WS_K); bf16* Gb = (bf16*)(P.ws + WS_G); bf16* VT = (bf16*)(P.ws + WS_VT);
            bf16* U2 = (bf16*)(P.ws + WS_U2); bf16* Yb = (bf16*)(P.ws + WS_Y); bf16* MIX = (bf16*)(P.ws + WS_MIX); float* Z = (float*)(P.ws + WS_Z);
            bf16* X1B = (bf16*)(P.ws + WS_X1B); bf16* Hb = (bf16*)(P.ws + WS_H); bf16* YB = (bf16*)(P.ws + WS_YB);
            const bf16* Win = (const bf16*)(P.ws + WS_WIN) + (size_t)layer * NPROJ * DM;
            (void)XB; (void)XF; (void)Qb; (void)Kb; (void)Gb; (void)VT; (void)U2; (void)Yb; (void)MIX; (void)Z; (void)X1B; (void)Hb; (void)YB; (void)Win;
            pg8::DenseOrder S; S.init(T, 1024, 1024, P.G, (int)blockIdx.x, P.ws + WS_WGLU + (size_t)layer * 1024 * 1024, 1);
            pg8::EpiGlu E{Yb, P.ws + WS_MIX8};
            S.ulist = (const LAS int*)(P.lds + TST_OFF + 896); __syncthreads(); pg8::moe_units(S, (LAS int*)(P.lds + TST_OFF + 896), P.tid); __syncthreads();
            pg8::gemm_phase<true>(P.lds, P.tid, (const char*)(P.ws + WS_Y8), 1024, S, E);
        }
        SEAM(pb + 3);

        if (PON(5) && IN(pb + 4)) for (int rp_ = 0; rp_ < RPT(5); ++rp_) {
            PHASE_FRAME;
            bf16* XB = (bf16*)(P.ws + WS_XB); float* XF = (float*)(P.ws + WS_XF);
            bf16* Qb = (bf16*)(P.ws + WS_Q); bf16* Kb = (bf16*)(P.ws + WS_K); bf16* Gb = (bf16*)(P.ws + WS_G); bf16* VT = (bf16*)(P.ws + WS_VT);
            bf16* U2 = (bf16*)(P.ws + WS_U2); bf16* Yb = (bf16*)(P.ws + WS_Y); bf16* MIX = (bf16*)(P.ws + WS_MIX); float* Z = (float*)(P.ws + WS_Z);
            bf16* X1B = (bf16*)(P.ws + WS_X1B); bf16* Hb = (bf16*)(P.ws + WS_H); bf16* YB = (bf16*)(P.ws + WS_YB);
            const bf16* Win = (const bf16*)(P.ws + WS_WIN) + (size_t)layer * NPROJ * DM;
            (void)XB; (void)XF; (void)Qb; (void)Kb; (void)Gb; (void)VT; (void)U2; (void)Yb; (void)MIX; (void)Z; (void)X1B; (void)Hb; (void)YB; (void)Win;
            pg8::DenseOrder S; S.init(T, DM, DM, P.G, (int)blockIdx.x, P.ws + WS_WOUT + (size_t)layer * DM * DM, 1);

            constexpr int GC0 = 5462, GC1 = 5462, GC2 = TI_G / 2 - GC0 - GC1;
            const int gcls = P.vcu % 3, gfirst = TI_MOE0 + layer * (TI_G / 2) + (gcls == 0 ? 0 : (gcls == 1 ? GC0 : GC0 + GC1)), gcount = gcls == 0 ? GC0 : (gcls == 1 ? GC1 : GC2);
            const int cgw = (P.vcu / 3) * NWAVES + P.wave, cngw = ((P.G - gcls + 2) / 3) * NWAVES;
            if (gcls == 0) convert_items(P, args, gfirst, gcount, cgw, cngw);
            S.ulist = (const LAS int*)(P.lds + TST_OFF + 896); __syncthreads(); pg8::moe_units(S, (LAS int*)(P.lds + TST_OFF + 896), P.tid); __syncthreads();
            const ConvHook H{&P, &args, gfirst, gcount, cgw, cngw, gcls == 1 ? 0 : -1};
            if (layer == 0) { pg8::EpiResid<true> E{(const void*)args.in[0], (bf16*)Z}; pg8::gemm_phase<true>(P.lds, P.tid, (const char*)(P.ws + WS_MIX8), DM, S, E, H); }
            else { pg8::EpiResid<false> E{(const void*)XB, (bf16*)Z}; pg8::gemm_phase<true>(P.lds, P.tid, (const char*)(P.ws + WS_MIX8), DM, S, E, H); }
            if (gcls == 2) convert_items(P, args, gfirst, gcount, cgw, cngw);
        }
        SEAM(pb + 4);

        if (PON(6) && IN(pb + 5)) for (int rp_ = 0; rp_ < RPT(6); ++rp_) {
            PHASE_FRAME;
            bf16* XB = (bf16*)(P.ws + WS_XB); float* XF = (float*)(P.ws + WS_XF);
            bf16* Qb = (bf16*)(P.ws + WS_Q); bf16* Kb = (bf16*)(P.ws + WS_K); bf16* Gb = (bf16*)(P.ws + WS_G); bf16* VT = (bf16*)(P.ws + WS_VT);
            bf16* U2 = (bf16*)(P.ws + WS_U2); bf16* Yb = (bf16*)(P.ws + WS_Y); bf16* MIX = (bf16*)(P.ws + WS_MIX); float* Z = (float*)(P.ws + WS_Z);
            bf16* X1B = (bf16*)(P.ws + WS_X1B); bf16* Hb = (bf16*)(P.ws + WS_H); bf16* YB = (bf16*)(P.ws + WS_YB);
            const bf16* Win = (const bf16*)(P.ws + WS_WIN) + (size_t)layer * NPROJ * DM;
            (void)XB; (void)XF; (void)Qb; (void)Kb; (void)Gb; (void)VT; (void)U2; (void)Yb; (void)MIX; (void)Z; (void)X1B; (void)Hb; (void)YB; (void)Win;
            for (int u = P.vcu; u < T / 64; u += P.G) ln1_router_unit(P, args, layer, u);

        }
        SEAM(pb + 5);

        if (PON(7) && IN(pb + 6)) for (int rp_ = 0; rp_ < RPT(7); ++rp_) {
            PHASE_FRAME;
            bf16* XB = (bf16*)(P.ws + WS_XB); float* XF = (float*)(P.ws + WS_XF);
            bf16* Qb = (bf16*)(P.ws + WS_Q); bf16* Kb = (bf16*)(P.ws + WS_K); bf16* Gb = (bf16*)(P.ws + WS_G); bf16* VT = (bf16*)(P.ws + WS_VT);
            bf16* U2 = (bf16*)(P.ws + WS_U2); bf16* Yb = (bf16*)(P.ws + WS_Y); bf16* MIX = (bf16*)(P.ws + WS_MIX); float* Z = (float*)(P.ws + WS_Z);
            bf16* X1B = (bf16*)(P.ws + WS_X1B); bf16* Hb = (bf16*)(P.ws + WS_H); bf16* YB = (bf16*)(P.ws + WS_YB);
            const bf16* Win = (const bf16*)(P.ws + WS_WIN) + (size_t)layer * NPROJ * DM;
            (void)XB; (void)XF; (void)Qb; (void)Kb; (void)Gb; (void)VT; (void)U2; (void)Yb; (void)MIX; (void)Z; (void)X1B; (void)Hb; (void)YB; (void)Win;
            moe_setup(P, layer);
            const LAS int* cnt = (const LAS int*)(P.lds + TST_OFF); const LAS int* pst = cnt + 32; const LAS int* fst = pst + 33; const LAS int* hst = fst + 33;
            LAS unsigned* table = (LAS unsigned*)(P.lds + TAB_OFF);
            pg8::MoeOrder<true> S; S.NF = fst[NE] * 8; S.NU = S.NF + hst[NE] * 8; S.G = P.G; S.c = P.vcu; S.pst = pst; S.fst = fst; S.hst = hst; S.table = table; S.rowbytes = 0;
            S.Bt = (const char*)(P.ws + WS_WGU) + (size_t)layer * NE * 2048 * DM; S.estepB = (size_t)2048 * DM; S.tstepB = (size_t)256 * DM;
            S.ulist = (const LAS int*)(P.lds + TST_OFF + 896); pg8::moe_units(S, (LAS int*)(P.lds + TST_OFF + 896), P.tid); __syncthreads();
            { const int* list = (const int*)(P.ws + WS_LIST); int tk[8]; bool okk[8];
#pragma unroll
              for (int i = 0; i < 8; ++i) { pg8::Unit u; okk[i] = S.next(i, u) && (P.tid < 256); int tok = 0;
                  if (okk[i]) { const int e = u.e & 255; const int slot = (u.pm - pst[e] * 128) + P.tid; if (slot < cnt[e]) tok = list[e * T + slot]; }
                  tk[i] = tok; }
#pragma unroll
              for (int i = 0; i < 8; ++i) if (okk[i]) { int tok = tk[i]; tok = tok < 0 ? 0 : (tok >= T ? T - 1 : tok); table[i * 256 + P.tid] = (unsigned)tok * (unsigned)DM; } }
            __syncthreads();
            const int dcls = P.vcu & 3, dk = P.vcu >> 2, nclass = P.G >> 2;
            int dfirst = TI_MOE0 + 2 * TI_G + layer * (TI_D / 2) + dcls * (TI_D / 8), dcount = TI_D / 8, dgw = dk * NWAVES + P.wave, dngw = nclass * NWAVES;
            { const int ntall = S.NU - 4 * P.G; int nt = ntall > dcls ? (ntall - dcls + 3) >> 2 : 0; nt = nt > nclass ? nclass : nt;
              const int wtot = 3 * nt + 5 * (nclass - nt), c0 = 3 * (dk < nt ? dk : nt) + 5 * (dk > nt ? dk - nt : 0), c1 = c0 + (dk < nt ? 3 : 5);
              const int npc = TI_D / 16;
              const int p0 = (int)(((long)npc * c0) / wtot), p1 = (int)(((long)npc * c1) / wtot);
              dfirst += 2 * p0; dcount = 2 * (p1 - p0); dgw = P.wave; dngw = NWAVES; }
            pg8::EpiGateUp E{(unsigned char*)Hb};
            if (dcls == 0) convert_items(P, args, dfirst, dcount, dgw, dngw);
            { const ConvHook H{&P, &args, dfirst, dcount, dgw, dngw, dcls == 1 ? 0 : (dcls == 2 ? 2 : -1)};
              pg8::gemm_phase<true>(P.lds, P.tid, (const char*)(P.ws + WS_XF), DM, S, E, H); }
            if (dcls == 3) convert_items(P, args, dfirst, dcount, dgw, dngw);
        }
        SEAM(pb + 6);

        if (PON(8) && IN(pb + 7)) for (int rp_ = 0; rp_ < RPT(8); ++rp_) {
            PHASE_FRAME;
            bf16* XB = (bf16*)(P.ws + WS_XB); float* XF = (float*)(P.ws + WS_XF);
            bf16* Qb = (bf16*)(P.ws + WS_Q); bf16* Kb = (bf16*)(P.ws + WS_K); bf16* Gb = (bf16*)(P.ws + WS_G); bf16* VT = (bf16*)(P.ws + WS_VT);
            bf16* U2 = (bf16*)(P.ws + WS_U2); bf16* Yb = (bf16*)(P.ws + WS_Y); bf16* MIX = (bf16*)(P.ws + WS_MIX); float* Z = (float*)(P.ws + WS_Z);
            bf16* X1B = (bf16*)(P.ws + WS_X1B); bf16* Hb = (bf16*)(P.ws + WS_H); bf16* YB = (bf16*)(P.ws + WS_YB);
            const bf16* Win = (const bf16*)(P.ws + WS_WIN) + (size_t)layer * NPROJ * DM;
            (void)XB; (void)XF; (void)Qb; (void)Kb; (void)Gb; (void)VT; (void)U2; (void)Yb; (void)MIX; (void)Z; (void)X1B; (void)Hb; (void)YB; (void)Win;
            moe_setup(P, layer);
            const LAS int* pst = (const LAS int*)(P.lds + TST_OFF) + 32; const LAS int* fst = pst + 33; const LAS int* hst = fst + 33;
            pg8::MoeOrder<false> S; S.NF = fst[NE] * 8; S.NU = S.NF + hst[NE] * 8; S.G = P.G; S.c = P.vcu; S.pst = pst; S.fst = fst; S.hst = hst; S.table = (const LAS unsigned*)(P.lds + TAB_OFF); S.rowbytes = DE;
            S.ulist = (const LAS int*)(P.lds + TST_OFF + 896);
            S.Bt = (const char*)(P.ws + WS_WDN) + (size_t)layer * NE * DM * DE; S.estepB = (size_t)DM * DE; S.tstepB = (size_t)256 * DE;
            pg8::moe_units(S, (LAS int*)(P.lds + TST_OFF + 896), P.tid); __syncthreads();
            pg8::EpiF8 E{(unsigned char*)YB, DM, W8_INV * 16.0f};
            pg8::gemm_phase<true>(P.lds, P.tid, (const char*)Hb, DE, S, E);
        }
        SEAM(pb + 7);

        if (PON(9) && IN(pb + 8)) for (int rp_ = 0; rp_ < RPT(9); ++rp_) {
            PHASE_FRAME;
            bf16* XB = (bf16*)(P.ws + WS_XB); float* XF = (float*)(P.ws + WS_XF);
            bf16* Qb = (bf16*)(P.ws + WS_Q); bf16* Kb = (bf16*)(P.ws + WS_K); bf16* Gb = (bf16*)(P.ws + WS_G); bf16* VT = (bf16*)(P.ws + WS_VT);
            bf16* U2 = (bf16*)(P.ws + WS_U2); bf16* Yb = (bf16*)(P.ws + WS_Y); bf16* MIX = (bf16*)(P.ws + WS_MIX); float* Z = (float*)(P.ws + WS_Z);
            bf16* X1B = (bf16*)(P.ws + WS_X1B); bf16* Hb = (bf16*)(P.ws + WS_H); bf16* YB = (bf16*)(P.ws + WS_YB);
            const bf16* Win = (const bf16*)(P.ws + WS_WIN) + (size_t)layer * NPROJ * DM;
            (void)XB; (void)XF; (void)Qb; (void)Kb; (void)Gb; (void)VT; (void)U2; (void)Yb; (void)MIX; (void)Z; (void)X1B; (void)Hb; (void)YB; (void)Win;
            moe_setup(P, layer);
            float* outf = layer == 1 ? args.out : (float*)nullptr; bf16* outb = layer == 1 ? (bf16*)nullptr : XB;
            { LAS float* gl = (LAS float*)P.lds;
              { const f32x4 g = *(const f32x4*)(args.in[14] + layer * DM + 4 * P.tid), b = *(const f32x4*)(args.in[15] + layer * DM + 4 * P.tid); *(LAS f32x4*)(gl + 4 * P.tid) = g; *(LAS f32x4*)(gl + DM + 4 * P.tid) = b;
                const f32x4 g1 = *(const f32x4*)(args.in[12] + layer * DM + 4 * P.tid), b1 = *(const f32x4*)(args.in[13] + layer * DM + 4 * P.tid); *(LAS f32x4*)(gl + 2 * DM + 4 * P.tid) = g1; *(LAS f32x4*)(gl + 3 * DM + 4 * P.tid) = b1; }
              __syncthreads();
              const int step = P.G * NWAVES; const int tok0 = P.vcu * NWAVES + P.wave;
#pragma nounroll
              for (int tok = tok0; tok < T; tok += LN2R * step) { int toks[LN2R];
#pragma unroll
                  for (int r = 0; r < LN2R; ++r) toks[r] = (tok + r * step < T) ? tok + r * step : tok;
                  ln2_rows(P, gl, toks, outf, outb); } }
        }
        if (layer == 0) SEAM(pb + 8);
    }
#undef IN
#undef SEAM
}

extern "C" void kernel_launch(void* const* d_in, const int* in_sizes, int n_in, void* d_out, int out_size, void* d_ws, size_t ws_size, hipStream_t stream) {
    static int grid = 0;
    if (grid == 0) {
        if (n_in != 21 || out_size != T * DM || ws_size < WS_END) { fprintf(stderr, "kernel_launch: unexpected problem (n_in %d, out %d, ws %zu; need ws >= %zu)\n", n_in, out_size, ws_size, (size_t)WS_END); grid = -1; return; }
        int dev = 0, cus = 0, per_cu = 0;
        if (hipGetDevice(&dev) != hipSuccess || hipDeviceGetAttribute(&cus, hipDeviceAttributeMultiprocessorCount, dev) != hipSuccess) { grid = -1; return; }
        if (hipFuncSetAttribute((const void*)mk_fwd, hipFuncAttributeMaxDynamicSharedMemorySize, LDS_BYTES) != hipSuccess) { fprintf(stderr, "kernel_launch: hipFuncSetAttribute failed\n"); grid = -1; return; }
        if (hipOccupancyMaxActiveBlocksPerMultiprocessor(&per_cu, (const void*)mk_fwd, NWAVES * 64, LDS_BYTES) != hipSuccess || per_cu < 1) fprintf(stderr, "kernel_launch: occupancy query reports %d\n", per_cu);
        (void)hipGetLastError();
        grid = cus;
    }
    if (grid < 0) return;
    (void)hipMemsetAsync((char*)d_ws + WS_CTL, 0, CTL_ZERO_BYTES, stream);
    Args a{};
    for (int i = 0; i < 21; ++i) a.in[i] = (const float*)d_in[i];
    a.out = (float*)d_out; a.ws = (unsigned char*)d_ws;
#if MK_N_LAUNCHES == 1
    a.ph_lo = 0; a.ph_hi = NPH;
    hipLaunchKernelGGL(mk_fwd, dim3(grid), dim3(NWAVES * 64), LDS_BYTES, stream, a);
#else
    for (int p = 0; p < NPH; ++p) { a.ph_lo = p; a.ph_hi = p + 1; hipLaunchKernelGGL(mk_fwd, dim3(grid), dim3(NWAVES * 64), LDS_BYTES, stream, a); }
#endif
}
```

```cpp
#include <hip/hip_runtime.h>
#include <cstdio>
#include <cstdint>

#ifndef PG8_ALIGN_EPI
#define PG8_ALIGN_EPI 1
#endif
#ifndef PROBE_EPI
#define PROBE_EPI 0
#endif
#ifndef MK_N_LAUNCHES
#define MK_N_LAUNCHES 1
#endif

#define LAS __attribute__((address_space(3)))
#define GAS __attribute__((address_space(1)))
typedef unsigned short bf16;
typedef short bf16x8 __attribute__((ext_vector_type(8)));
typedef float f32x4 __attribute__((ext_vector_type(4)));
typedef float f32x2 __attribute__((ext_vector_type(2)));
typedef unsigned u32x4 __attribute__((ext_vector_type(4)));
typedef unsigned u32x2 __attribute__((ext_vector_type(2)));
typedef int i32x4 __attribute__((ext_vector_type(4)));
typedef int i32x8 __attribute__((ext_vector_type(8)));

constexpr int BATCH = 8, SEQ = 2048, DM = 2048, T = BATCH * SEQ;
constexpr int RW = 1024, HD = 256, NPROJ = 5120;
constexpr int NE = 32, DE = 1024;
constexpr int SGRP = 64, SCH = 16, SST = 64, CS = 16, NCHUNK = SEQ / CS;
constexpr int KS5 = 384;
constexpr float LN_EPS = 1e-5f;
constexpr float ALPHA = 1.41421356237309515f;
constexpr int NPH = 19;

constexpr size_t MiB = 1u << 20;
constexpr size_t WS_CTL = 0, CTL_ZERO_BYTES = 128 * 1024;
constexpr size_t WS_WIN = 1 * MiB;
constexpr size_t WS_WOUT = WS_WIN + 40 * MiB;
constexpr size_t WS_WGLU = WS_WOUT + 16 * MiB;
constexpr size_t WS_WGU = WS_WGLU + 4 * MiB;
constexpr size_t WS_WDN = WS_WGU + 512 * MiB;
constexpr size_t WS_S5OUT = WS_WDN + 256 * MiB;
constexpr size_t WS_S5IN = WS_S5OUT + 24 * MiB;
constexpr size_t WS_S5A = WS_S5IN + 8 * MiB;
constexpr size_t WS_COS = WS_S5A + 1 * MiB;
constexpr size_t WS_SIN = WS_COS + 1 * MiB;
constexpr size_t WS_RWT = WS_SIN + 1 * MiB;
constexpr size_t WS_XB = WS_RWT + 1 * MiB;
constexpr size_t WS_XF = WS_XB + 64 * MiB;
constexpr size_t WS_Y8 = WS_XF + 32 * MiB;
constexpr size_t WS_MIX8 = WS_XF + 64 * MiB;
constexpr size_t WS_XB8 = WS_XF + 96 * MiB;
constexpr size_t WS_Q = WS_XF + 128 * MiB;
constexpr size_t WS_K = WS_Q + 32 * MiB;
constexpr size_t WS_G = WS_K + 32 * MiB;
constexpr size_t WS_VT = WS_G + 32 * MiB;
constexpr size_t WS_U2 = WS_VT + 32 * MiB;
constexpr size_t WS_Y = WS_U2 + 48 * MiB;
constexpr size_t WS_MIX = WS_Y + 32 * MiB;
constexpr size_t WS_Z = WS_MIX + 64 * MiB;
constexpr size_t WS_X1B = WS_Z + 128 * MiB;
constexpr size_t WS_LIST = WS_X1B + 64 * MiB;
constexpr size_t WS_TOK = WS_LIST + 2 * MiB;
constexpr size_t WS_H = WS_TOK + 1 * MiB;
constexpr size_t WS_YB = WS_H + 80 * MiB;
constexpr size_t WS_END = WS_YB + 160 * MiB;
constexpr int CW_BAR = 4096;
constexpr int CW_CNT = 16384;

constexpr int RING_BYTES = 131072;
constexpr int TAB_OFF = 150528;
constexpr int TST_OFF = TAB_OFF + 8192;
constexpr int MISC_OFF = TST_OFF + 1024;
constexpr int LDS_BYTES = 160768;
static_assert(MISC_OFF + 64 <= LDS_BYTES && LDS_BYTES <= 163840, "LDS map");
constexpr int NWAVES = 8;

__device__ __forceinline__ unsigned cvt_pk_bf16(float lo, float hi) { unsigned r; asm volatile("v_cvt_pk_bf16_f32 %0, %1, %2" : "=v"(r) : "v"(lo), "v"(hi)); return r; }
__device__ __forceinline__ float bflo(unsigned w) { return __uint_as_float(w << 16); }
__device__ __forceinline__ float bfhi(unsigned w) { return __uint_as_float(w & 0xffff0000u); }
__device__ __forceinline__ float sigmoid_f(float x) { return __builtin_amdgcn_rcpf(1.0f + __builtin_amdgcn_exp2f(-1.44269504089f * x)); }
__device__ __forceinline__ float silu_f(float x) { return x * sigmoid_f(x); }
__device__ __forceinline__ float gelu_tanh_f(float x) { return x * sigmoid_f(1.59576912161f * (x + 0.044715f * x * x * x)); }
__device__ __forceinline__ unsigned cvt4_fp8(float a, float b, float c, float d) { int w = __builtin_amdgcn_cvt_pk_fp8_f32(a, b, 0, false); w = __builtin_amdgcn_cvt_pk_fp8_f32(c, d, w, true); return (unsigned)w; }
constexpr float W8_SCALE = 64.0f, W8_INV = 1.0f / 64.0f;
__device__ __forceinline__ float wave_sum(float v) {
#define WS_DPP(x, ctrl) __builtin_bit_cast(float, __builtin_amdgcn_update_dpp(0, __builtin_bit_cast(int, (x)), (ctrl), 0xf, 0xf, true))
    v += WS_DPP(v, 0xB1);
    v += WS_DPP(v, 0x4E);
    v += WS_DPP(v, 0x141);
    v += WS_DPP(v, 0x140);
#undef WS_DPP
    const int b = __builtin_bit_cast(int, v);
    return (__builtin_bit_cast(float, __builtin_amdgcn_readlane(b, 0)) + __builtin_bit_cast(float, __builtin_amdgcn_readlane(b, 16)))
         + (__builtin_bit_cast(float, __builtin_amdgcn_readlane(b, 32)) + __builtin_bit_cast(float, __builtin_amdgcn_readlane(b, 48)));
}
#define VM_WAIT() asm volatile("s_waitcnt vmcnt(0)" ::: "memory")
#define LDS_WAIT() asm volatile("s_waitcnt lgkmcnt(0)" ::: "memory")

namespace pg8 {
constexpr int BM = 256, BK = 64, HALF = 128, HTB = HALF * BK * 2, STAGE_BYTES = 8 * HTB, NXCD = 8, WGM = 8;
__host__ __device__ __forceinline__ int lds_byte(int r, int c) { const int st = (r >> 4) * 2 + (c >> 5), rr = r & 15, cc = c & 31, ob = rr * 64 + cc * 2; return st * 1024 + (ob ^ (((ob >> 9) & 1) << 5)); }
__host__ __device__ __forceinline__ void stage_rc(int b, int& R, int& C) { const int st = b / 1024, sb = b % 1024, swz = sb ^ (((sb >> 9) & 1) << 5); R = (st >> 1) * 16 + swz / 64; C = (st & 1) * 32 + (swz % 64) / 2; }
__host__ __device__ __forceinline__ int perm32(int rho) { const int n = rho >> 4, i = rho & 15; return 8 * (i >> 2) + 4 * n + (i & 3); }

struct Unit { int pm, pn, e, li; };
__device__ __forceinline__ void glds16s(const char* sbase, unsigned voff, unsigned lds_dst) { unsigned keep;
    asm volatile("s_mov_b32 %0, m0\n\ts_mov_b32 m0, %3\n\ts_nop 2\n\tglobal_load_lds_dwordx4 %1, %2\n\ts_mov_b32 m0, %0" : "=&s"(keep) : "v"(voff), "s"(sbase), "s"(lds_dst) : "memory"); }

struct NoHook { static constexpr bool ON = false; __device__ __forceinline__ void operator()(int) const {} };
template <bool FP8, class Epi, class Sched, class Hook = NoHook>
__device__ __forceinline__ void gemm_phase(LAS unsigned char* lds, const int tid, const char* Abase, const int Kc, const Sched& S, const Epi& E, const Hook& H = Hook()) {
    int K = Kc; asm volatile("" : "+s"(K));
    const int wid = __builtin_amdgcn_readfirstlane(tid >> 6), lane = tid & 63, wr = wid >> 2, wc = wid & 3, fr = lane & 15, fq = lane >> 4;
    const int nt = FP8 ? K / 128 : K / BK;
    int R0, C0; stage_rc(tid * 16, R0, C0);
    const int Rb0 = Epi::PERM ? ((R0 & ~31) + perm32(R0 & 31)) : R0;
    const unsigned Cb0 = (unsigned)C0 * 2u;
    const unsigned voffB0 = FP8 ? (unsigned)(Rb0 * K) + Cb0 : (unsigned)(Rb0 * K) * 2u + Cb0;
    const size_t bstep64 = (size_t)64 * K * (FP8 ? 1 : 2);
    const size_t hstepB = 2 * bstep64;
    const unsigned ldsw = (unsigned)wid * 1024u; const unsigned ldsb = (unsigned)(size_t)lds + ldsw;
    const int aoff = lds_byte(wr * 64 + fr, fq * 8), boff = lds_byte(wc * 32 + fr, fq * 8);
    struct AOff { unsigned o0, o1, o2, o3; };
    const unsigned rb64 = Sched::GATHER ? 0u : S.rowstep() * 64u;
#define PG8_LOAD_AO(AO, U, rr) do { if constexpr (Sched::GATHER) { AO.o0 = S.rowoff(U, (rr)) + Cb0; AO.o1 = S.rowoff(U, (rr) + 64) + Cb0; AO.o2 = S.rowoff(U, (rr) + 128) + Cb0; AO.o3 = S.rowoff(U, (rr) + 192) + Cb0; } \
        else { AO.o0 = S.rowoff(U, (rr)) + Cb0 * Sched::KMULV; AO.o1 = 0u; AO.o2 = 0u; AO.o3 = 0u; } } while (0)
#define PG8_SA(b, h) (((b) * 2 + (h)) * HTB)
#define PG8_SB(b, h) ((4 + (b) * 2 + (h)) * HTB)
#define PG8_STAGE_B(bufoff, gbase) do { const char* gb_ = (const char*)(gbase); \
        glds16s(gb_, voffB0, ldsb + (unsigned)(bufoff)); glds16s(gb_ + bstep64, voffB0, ldsb + (unsigned)(bufoff) + 8192u); } while (0)
#define PG8_STAGE_A(bufoff, AO, h, kb) do { \
        if constexpr (Sched::GATHER) { const char* ab_ = Abase + (size_t)(kb); \
            glds16s(ab_, (h) ? AO.o2 : AO.o0, ldsb + (unsigned)(bufoff)); glds16s(ab_, (h) ? AO.o3 : AO.o1, ldsb + (unsigned)(bufoff) + 8192u); \
        } else { const char* ab_ = Abase + (size_t)(kb) * Sched::KMULV + (size_t)((h) * 2) * rb64; \
            glds16s(ab_, AO.o0, ldsb + (unsigned)(bufoff)); glds16s(ab_ + rb64, AO.o0, ldsb + (unsigned)(bufoff) + 8192u); } } while (0)
#define PG8_LDA(dst, b, h) do { _Pragma("unroll") for (int m = 0; m < 4; ++m) _Pragma("unroll") for (int k = 0; k < 2; ++k) dst[m][k] = *(const LAS bf16x8*)(lds + PG8_SA(b, h) + aoff + m * 2048 + k * 1024); } while (0)
#define PG8_LDB(dst, b, h) do { _Pragma("unroll") for (int n = 0; n < 2; ++n) _Pragma("unroll") for (int k = 0; k < 2; ++k) dst[n][k] = *(const LAS bf16x8*)(lds + PG8_SB(b, h) + boff + n * 2048 + k * 1024); } while (0)
#define PG8_MMA(ai, bj, At, Bt) do { __builtin_amdgcn_s_setprio(1); _Pragma("unroll") for (int m = 0; m < 4; ++m) _Pragma("unroll") for (int n = 0; n < 2; ++n) { \
        if constexpr (FP8) { \
            const i32x8 bq_ = __builtin_shufflevector(__builtin_bit_cast(i32x4, Bt[n][0]), __builtin_bit_cast(i32x4, Bt[n][1]), 0, 1, 2, 3, 4, 5, 6, 7); \
            const i32x8 aq_ = __builtin_shufflevector(__builtin_bit_cast(i32x4, At[m][0]), __builtin_bit_cast(i32x4, At[m][1]), 0, 1, 2, 3, 4, 5, 6, 7); \
            asm volatile("s_nop 1\n\tv_mfma_f32_16x16x128_f8f6f4 %0, %1, %2, %0" : "+v"(acc[ai][bj][m][n]) : "v"(bq_), "v"(aq_));   \
        } else { _Pragma("unroll") for (int k = 0; k < 2; ++k) { const i32x4 bq_ = __builtin_bit_cast(i32x4, Bt[n][k]), aq_ = __builtin_bit_cast(i32x4, At[m][k]); \
            asm volatile("s_nop 1\n\tv_mfma_f32_16x16x32_bf16 %0, %1, %2, %0" : "+v"(acc[ai][bj][m][n]) : "v"(bq_), "v"(aq_)); } } }   \
        __builtin_amdgcn_s_setprio(0); } while (0)
#define PG8_WAIT_V(n) asm volatile("s_waitcnt vmcnt(" #n ")" ::: "memory")
#define PG8_WAIT_VN(n) asm volatile("s_waitcnt vmcnt(%0)" :: "n"(n) : "memory")
#define PG8_WAIT_V8F() do { if (fa) PG8_WAIT_VN(8 + Epi::NST); else PG8_WAIT_V(8); } while (0)
#define PG8_WAIT_V6F() do { if (fa) PG8_WAIT_VN(6 + Epi::NST); else PG8_WAIT_V(6); } while (0)
#define PG8_WAIT_L(n) asm volatile("s_waitcnt lgkmcnt(" #n ")" ::: "memory")
#define PG8_BAR __builtin_amdgcn_s_barrier()
#define PG8_SCHED __builtin_amdgcn_sched_barrier(0)
    Unit cur, nxt; int ui = 0;
    if (!S.next(0, cur)) return;
    f32x4 acc[2][2][4][2];
#pragma unroll
    for (int a = 0; a < 2; ++a)
#pragma unroll
        for (int b = 0; b < 2; ++b)
#pragma unroll
            for (int m = 0; m < 4; ++m)
#pragma unroll
                for (int n = 0; n < 2; ++n) acc[a][b][m][n] = (f32x4){0.f, 0.f, 0.f, 0.f};
    bf16x8 At[4][2], B0[2][2], B1[2][2];
    AOff oc; PG8_LOAD_AO(oc, cur, R0);
    const char* cB = S.bbase(cur);
    PG8_STAGE_B(PG8_SB(0, 0), cB); PG8_STAGE_B(PG8_SB(0, 1), cB + hstepB); PG8_STAGE_A(PG8_SA(0, 0), oc, 0, 0u); PG8_STAGE_A(PG8_SA(0, 1), oc, 1, 0u);
    if (wr == 1) PG8_BAR;
    PG8_WAIT_V(2); PG8_BAR;
    PG8_STAGE_B(PG8_SB(1, 0), cB + 128); PG8_STAGE_A(PG8_SA(1, 0), oc, 0, 128u); PG8_STAGE_B(PG8_SB(1, 1), cB + hstepB + 128);
    PG8_WAIT_V(6); PG8_BAR;
    for (;;) {
        const bool has_next = S.next(ui + 1, nxt);
        const char* nB = has_next ? S.bbase(nxt) : cB;
        const bool hcur = Sched::HALFABLE ? S.half(cur) : false;
        for (int t = 0; t < nt; t += 2) {
            const bool last = (t == nt - 2);
            const unsigned kb1 = (unsigned)(t + 1) * 128u, kb2 = last ? 0u : (unsigned)(t + 2) * 128u, kb3 = kb2 + 128u;
            AOff pn = oc;
            if (last && has_next) { int t_ = (int)__builtin_amdgcn_mbcnt_hi(~0u, __builtin_amdgcn_mbcnt_lo(~0u, 0u)); asm volatile("" : "+v"(t_));
                int r0_, c0_; stage_rc((wid * 64 + t_) * 16, r0_, c0_); const unsigned Cb0 = (unsigned)c0_ * 2u; PG8_LOAD_AO(pn, nxt, r0_); }
            const char* b2 = last ? nB : cB + (size_t)(t + 2) * 128; const char* b3 = b2 + 128;
            const bool fa = FP8 && Sched::MULTI && (t == 0) && (ui > 0);
            PG8_LDB(B0, 0, 0); PG8_LDB(B1, 0, 1); PG8_SCHED; PG8_LDA(At, 0, 0); if (!fa) PG8_STAGE_A(PG8_SA(1, 1), oc, 1, kb1);
            PG8_WAIT_V8F(); PG8_WAIT_L(0); PG8_BAR; PG8_MMA(0, 0, At, B0); PG8_MMA(0, 1, At, B1); PG8_BAR; PG8_SCHED;
            if (!hcur) PG8_LDA(At, 0, 1); PG8_STAGE_B(PG8_SB(0, 0), b2); PG8_STAGE_B(PG8_SB(0, 1), b2 + hstepB);
            PG8_WAIT_V6F(); PG8_WAIT_L(0); PG8_BAR; if (!hcur) PG8_MMA(1, 0, At, B0); PG8_STAGE_A(PG8_SA(0, 0), pn, 0, kb2); if (!hcur) PG8_MMA(1, 1, At, B1); PG8_BAR; PG8_SCHED;
            PG8_LDB(B0, 1, 0); PG8_LDB(B1, 1, 1); PG8_SCHED; PG8_LDA(At, 1, 0); PG8_STAGE_A(PG8_SA(0, 1), pn, 1, kb2);
            PG8_WAIT_V8F(); PG8_WAIT_L(0); PG8_BAR; PG8_MMA(0, 0, At, B0); PG8_MMA(0, 1, At, B1); PG8_BAR; PG8_SCHED;
            if (!hcur) PG8_LDA(At, 1, 1); PG8_STAGE_B(PG8_SB(1, 0), b3); PG8_STAGE_B(PG8_SB(1, 1), b3 + hstepB);
            PG8_WAIT_V(6); PG8_WAIT_L(0); PG8_BAR; if (!hcur) PG8_MMA(1, 0, At, B0); PG8_STAGE_A(PG8_SA(1, 0), pn, 0, kb3); if (!hcur) PG8_MMA(1, 1, At, B1); PG8_BAR; PG8_SCHED;
            if (FP8 && Sched::MULTI && last && has_next) PG8_STAGE_A(PG8_SA(1, 1), pn, 1, 128u);
        }
        asm volatile("s_nop 15\n\ts_nop 15" ::: "memory");
        if (PG8_ALIGN_EPI) { if (wr == 0) PG8_BAR; }
        { int l_ = (int)__builtin_amdgcn_mbcnt_hi(~0u, __builtin_amdgcn_mbcnt_lo(~0u, 0u)); asm volatile("" : "+v"(l_));
          E(acc, cur, wr, wc, l_ & 15, l_ >> 4);
          if (PROBE_EPI) { asm volatile("" ::: "memory"); E(acc, cur, wr, wc, l_ & 15, l_ >> 4); } }
        if (!has_next) break;
        if constexpr (Hook::ON) { if (H.wants(ui)) { H(ui); asm volatile("s_waitcnt vmcnt(0)" ::: "memory"); } }
#pragma unroll
        for (int a = 0; a < 2; ++a)
#pragma unroll
            for (int b = 0; b < 2; ++b)
#pragma unroll
                for (int m = 0; m < 4; ++m)
#pragma unroll
                    for (int n = 0; n < 2; ++n) acc[a][b][m][n] = (f32x4){0.f, 0.f, 0.f, 0.f};
        cur = nxt; cB = nB; ++ui;
        { int t_ = (int)__builtin_amdgcn_mbcnt_hi(~0u, __builtin_amdgcn_mbcnt_lo(~0u, 0u)); asm volatile("" : "+v"(t_));
          int r0_, c0_; stage_rc((wid * 64 + t_) * 16, r0_, c0_); const unsigned Cb0 = (unsigned)c0_ * 2u; PG8_LOAD_AO(oc, cur, r0_); }
        if (PG8_ALIGN_EPI) { if (wr == 1) PG8_BAR; }
    }
    PG8_WAIT_V(0);
    if (!PG8_ALIGN_EPI) { if (wr == 0) PG8_BAR; }
    PG8_BAR;
#undef PG8_SA
#undef PG8_SB
#undef PG8_STAGE_A
#undef PG8_LOAD_AO
#undef PG8_STAGE_B
#undef PG8_LDA
#undef PG8_LDB
#undef PG8_MMA
#undef PG8_WAIT_V
#undef PG8_WAIT_VN
#undef PG8_WAIT_V8F
#undef PG8_WAIT_V6F
#undef PG8_WAIT_V6F
#undef PG8_WAIT_L
#undef PG8_BAR
#undef PG8_SCHED
}

struct DenseOrder {
    static constexpr bool GATHER = false, HALFABLE = false, MULTI = true; static constexpr unsigned KMULV = 1u;
    __device__ __forceinline__ bool half(const Unit&) const { return false; }
    int nM, nN, nwg, G, c; unsigned rowbytes; const char* Bt; size_t tstepB;
    __device__ __forceinline__ unsigned rowstep() const { return rowbytes; }
    __device__ __forceinline__ void init(int M, int N, int K, int G_, int c_, const void* Bt_, int eb = 2) { nM = M / BM; nN = N / BM; nwg = nM * nN; G = G_; c = c_; rowbytes = (unsigned)(K * eb); Bt = (const char*)Bt_; tstepB = (size_t)BM * K * eb; }
    const LAS int* ulist;
    __device__ __forceinline__ bool next(int i, Unit& u) const { if (i >= 8) return false; const i32x4 v = *(const LAS i32x4*)(ulist + 4 * i); u.pm = v[0]; u.pn = v[1]; u.e = v[2]; u.li = i; return v[3] != 0; }
    __device__ __forceinline__ bool find(int i, Unit& u) const {
        const long L = (long)i * G + c; if (L >= nwg) return false;
        int wgid = (int)L; { const int q = nwg / NXCD, r = nwg % NXCD, xcd = wgid % NXCD, off = wgid / NXCD; wgid = (xcd < r ? xcd * (q + 1) : r * (q + 1) + (xcd - r) * q) + off; }
        const int nig = WGM * nN, gid = wgid / nig, fm = gid * WGM, gsz = (nM - fm) < WGM ? (nM - fm) : WGM;
        u.pm = fm + ((wgid % nig) % gsz); u.pn = (wgid % nig) / gsz; u.e = 0; u.li = i; return true;
    }
    __device__ __forceinline__ unsigned rowoff(const Unit& u, int r) const { return (unsigned)(u.pm * BM + r) * rowbytes; }
    __device__ __forceinline__ const char* bbase(const Unit& u) const { return Bt + (size_t)u.pn * tstepB; }
};
struct GluOrder : DenseOrder { static constexpr unsigned KMULV = (unsigned)T; static constexpr bool MULTI = false; };
struct S5Order {
    static constexpr bool GATHER = false, HALFABLE = false, MULTI = true; static constexpr unsigned KMULV = 1u;
    __device__ __forceinline__ bool half(const Unit&) const { return false; }
    int G, c; const char* Bt;
    __device__ __forceinline__ unsigned rowstep() const { return (unsigned)(KS5 * 2); }
    const LAS int* ulist;
    __device__ __forceinline__ bool next(int i, Unit& u) const { if (i >= 8) return false; const i32x4 v = *(const LAS i32x4*)(ulist + 4 * i); u.pm = v[0]; u.pn = v[1]; u.e = v[2]; u.li = i; return v[3] != 0; }
    __device__ __forceinline__ bool find(int i, Unit& u) const { const int L = i * G + c; if (L >= 256) return false; u.pm = L; u.pn = L >> 2; u.e = 0; u.li = i; return true; }
    __device__ __forceinline__ unsigned rowoff(const Unit& u, int r) const { return (unsigned)(u.pm * BM + r) * (unsigned)(KS5 * 2); }
    __device__ __forceinline__ const char* bbase(const Unit& u) const { return Bt + (size_t)u.pn * (size_t)(BM * KS5 * 2); }
};
template <bool GATHER_> struct MoeOrder {
    static constexpr bool GATHER = GATHER_, HALFABLE = true, MULTI = true; static constexpr unsigned KMULV = 1u;
    int NF, NU, G, c; const LAS int* pst; const LAS int* fst; const LAS int* hst; const LAS unsigned* table; const char* Bt; size_t estepB, tstepB; unsigned rowbytes;
    __device__ __forceinline__ unsigned rowstep() const { return rowbytes; }
    const LAS int* ulist;
    __device__ __forceinline__ bool find(int i, Unit& u) const {
        const int L = i * G + c; if (L >= NU) return false;
        int e = 0;
        if (L < NF) { const int rt = L >> 3; while (e < NE - 1 && fst[e + 1] <= rt) ++e; u.pm = (pst[e] + 2 * (rt - fst[e])) * 128; u.e = e; }
        else { const int hh = (L - NF) >> 3; while (e < NE - 1 && hst[e + 1] <= hh) ++e; u.pm = (pst[e + 1] - 1) * 128; u.e = e | 256; }
        u.pn = L & 7; u.li = i; return true;
    }
    int ibeg = 0, iend = 8;
    __device__ __forceinline__ bool next(int i, Unit& u) const {
        const int j = ibeg + i; if (j >= iend) return false;
        const i32x4 v = *(const LAS i32x4*)(ulist + 4 * j);
        u.pm = v[0]; u.pn = v[1]; u.e = v[2]; u.li = j; return v[3] != 0;
    }
    __device__ __forceinline__ bool half(const Unit& u) const { return (u.e & 256) != 0; }
    __device__ __forceinline__ unsigned rowoff(const Unit& u, int r) const { if constexpr (GATHER_) return table[u.li * 256 + r]; else return (unsigned)(u.pm + r) * rowbytes; }
    __device__ __forceinline__ const char* bbase(const Unit& u) const { return Bt + (size_t)(u.e & 255) * estepB + (size_t)u.pn * tstepB; }
};

template <class MO> __device__ __forceinline__ void moe_units(const MO& S, LAS int* ulist, int tid) {
    if (tid < 8) { Unit u; u.pm = 0; u.pn = 0; u.e = 0; u.li = tid; const bool ok = S.find(tid, u); *(LAS i32x4*)(ulist + 4 * tid) = (i32x4){u.pm, u.pn, u.e, ok ? 1 : 0}; }
}

struct EpiInProj {
    static constexpr int NST = 16;
    static constexpr bool PERM = true;
    bf16 *Q, *Kk, *Gs, *U2; const float *cosT, *sinT;
    __device__ __forceinline__ void operator()(const f32x4 (&acc)[2][2][4][2], const Unit& u, int wr, int wc, int fr, int fq) const {
        const int seg = u.pn >> 2;
        const int colseg = (u.pn & 3) * 256 + wc * 32 + 8 * fq;
        const int hd_ = u.pn & 3;
        const float lgam = hd_ == 0 ? -0.045803689613f : hd_ == 1 ? -0.022720076500f : hd_ == 2 ? -0.011315313227f : -0.005646563141f;
        if (seg <= 1) {
            bf16* const O = (seg == 0) ? Q : Kk;
            float frq[2][4];
#pragma unroll
            for (int bj = 0; bj < 2; ++bj) { const int i0 = ((colseg + bj * HALF) & (HD - 1)) >> 1;
#pragma unroll
                for (int j = 0; j < 4; ++j) frq[bj][j] = __builtin_amdgcn_exp2f(-0.10381025296523f * (float)(i0 + j)) * 0.15915494309189535f; }
#pragma unroll
            for (int ai = 0; ai < 2; ++ai) {
#pragma unroll
                for (int m = 0; m < 4; ++m) { const int row = u.pm * BM + ai * HALF + wr * 64 + m * 16 + fr; const int tpos = row & (SEQ - 1); const float tf = (float)tpos;
                    const float fdec = (seg == 0) ? W8_INV * __builtin_amdgcn_exp2f(lgam * tf) : (W8_INV * 0.0625f) * __builtin_amdgcn_exp2f(-lgam * tf);
#pragma unroll
                    for (int bj = 0; bj < 2; ++bj) { const int col = colseg + bj * HALF; const f32x4 v0 = acc[ai][bj][m][0] * fdec, v1 = acc[ai][bj][m][1] * fdec; f32x4 c, sn;
#pragma unroll
                        for (int j = 0; j < 4; ++j) { const float x = __builtin_amdgcn_fractf(tf * frq[bj][j]); c[j] = __builtin_amdgcn_cosf(x); sn[j] = __builtin_amdgcn_sinf(x); }
                        u32x4 w; w.x = cvt_pk_bf16(v0[0] * c[0] - v0[1] * sn[0], v0[0] * sn[0] + v0[1] * c[0]); w.y = cvt_pk_bf16(v0[2] * c[1] - v0[3] * sn[1], v0[2] * sn[1] + v0[3] * c[1]);
                        w.z = cvt_pk_bf16(v1[0] * c[2] - v1[1] * sn[2], v1[0] * sn[2] + v1[1] * c[2]); w.w = cvt_pk_bf16(v1[2] * c[3] - v1[3] * sn[3], v1[2] * sn[3] + v1[3] * c[3]);
                        *(u32x4*)(O + (size_t)row * RW + col) = w; } }
            }
        } else {
#pragma unroll
            for (int ai = 0; ai < 2; ++ai)
#pragma unroll
                for (int m = 0; m < 4; ++m) {
                    const int row = u.pm * BM + ai * HALF + wr * 64 + m * 16 + fr; const int tpos = row & (SEQ - 1);
#pragma unroll
                    for (int bj = 0; bj < 2; ++bj) {
                        const int col = colseg + bj * HALF; const f32x4 v0 = acc[ai][bj][m][0] * W8_INV, v1 = acc[ai][bj][m][1] * W8_INV;
                        if (seg == 2) {
                            u32x4 w; w.x = cvt_pk_bf16(silu_f(v0[0]), silu_f(v0[1])); w.y = cvt_pk_bf16(silu_f(v0[2]), silu_f(v0[3])); w.z = cvt_pk_bf16(silu_f(v1[0]), silu_f(v1[1])); w.w = cvt_pk_bf16(silu_f(v1[2]), silu_f(v1[3]));
                            *(u32x4*)(Gs + (size_t)row * RW + col) = w;
                        } else {
                            const int gidx = col >> 4, ch0 = col & 15, b = row >> 11, c = tpos >> 4, tt = tpos & 15;
                            u32x4 w; w.x = cvt_pk_bf16(v0[0], v0[1]); w.y = cvt_pk_bf16(v0[2], v0[3]); w.z = cvt_pk_bf16(v1[0], v1[1]); w.w = cvt_pk_bf16(v1[2], v1[3]);
                            *(u32x4*)(U2 + (size_t)(gidx * 1024 + b * 128 + c) * KS5 + tt * 16 + ch0) = w;
                        }
                    }
                }
        }
    }
};
struct EpiBf16 {
    static constexpr int NST = 16;
    static constexpr bool PERM = true;
    bf16* O; int ldc; float sc;
    __device__ __forceinline__ void operator()(const f32x4 (&acc)[2][2][4][2], const Unit& u, int wr, int wc, int fr, int fq) const {
        const int row0 = u.pm * BM + wr * 64 + fr, col0 = u.pn * BM + wc * 32 + 8 * fq;
#pragma unroll
        for (int ai = 0; ai < 2; ++ai)
#pragma unroll
            for (int m = 0; m < 4; ++m) { bf16* rowp = O + (size_t)(row0 + ai * HALF + m * 16) * ldc + col0;
#pragma unroll
                for (int bj = 0; bj < 2; ++bj) { const f32x4 v0 = acc[ai][bj][m][0] * sc, v1 = acc[ai][bj][m][1] * sc;
                    u32x4 w; w.x = cvt_pk_bf16(v0[0], v0[1]); w.y = cvt_pk_bf16(v0[2], v0[3]); w.z = cvt_pk_bf16(v1[0], v1[1]); w.w = cvt_pk_bf16(v1[2], v1[3]);
                    *(u32x4*)(rowp + bj * HALF) = w; } }
    }
};
struct EpiF8 {
    static constexpr int NST = 8;
    static constexpr bool PERM = true;
    unsigned char* O; int ldc; float sc;
    __device__ __forceinline__ void operator()(const f32x4 (&acc)[2][2][4][2], const Unit& u, int wr, int wc, int fr, int fq) const {
        const int row0 = u.pm + wr * 64 + fr, col0 = u.pn * BM + wc * 32 + 8 * fq; const int nai = (u.e & 256) ? 1 : 2;
#pragma unroll
        for (int ai = 0; ai < 2; ++ai) if (ai < nai)
#pragma unroll
            for (int m = 0; m < 4; ++m) { unsigned char* rowp = O + (size_t)(row0 + ai * HALF + m * 16) * ldc + col0;
#pragma unroll
                for (int bj = 0; bj < 2; ++bj) { const f32x4 v0 = acc[ai][bj][m][0] * sc, v1 = acc[ai][bj][m][1] * sc;
                    u32x2 w; w.x = cvt4_fp8(v0[0], v0[1], v0[2], v0[3]); w.y = cvt4_fp8(v1[0], v1[1], v1[2], v1[3]);
                    *(u32x2*)(rowp + bj * HALF) = w; } }
    }
};
struct EpiS5Out {
    static constexpr int NST = 32;
    static constexpr bool PERM = true;
    bf16* Y; unsigned char* Y8;
    __device__ __forceinline__ void operator()(const f32x4 (&acc)[2][2][4][2], const Unit& u, int wr, int wc, int fr, int fq) const {
        const unsigned lane0 = (unsigned)(fr * 256 + (fq >> 1) * 16 + (fq & 1) * 8) + (unsigned)(wr * 16384 + wc * 32);
#pragma unroll
        for (int ai = 0; ai < 2; ++ai) { const unsigned gb = ((unsigned)(u.pm >> 2) * (unsigned)T + (unsigned)(((u.pm * 2 + ai) & 7) * SEQ)) * 16u + lane0;
#pragma unroll
            for (int m = 0; m < 4; ++m)
#pragma unroll
                for (int bj = 0; bj < 2; ++bj) {
                    const f32x4 v0 = acc[ai][bj][m][0], v1 = acc[ai][bj][m][1];
                    u32x4 w; w.x = cvt_pk_bf16(gelu_tanh_f(v0[0]), gelu_tanh_f(v0[1])); w.y = cvt_pk_bf16(gelu_tanh_f(v0[2]), gelu_tanh_f(v0[3]));
                    w.z = cvt_pk_bf16(gelu_tanh_f(v1[0]), gelu_tanh_f(v1[1])); w.w = cvt_pk_bf16(gelu_tanh_f(v1[2]), gelu_tanh_f(v1[3]));
                    const unsigned yo = gb + (unsigned)(m * 4096 + bj * 128);
                    *(u32x4*)(Y + yo) = w;
                    u32x2 w8; w8.x = cvt4_fp8(bflo(w.x), bfhi(w.x), bflo(w.y), bfhi(w.y)); w8.y = cvt4_fp8(bflo(w.z), bfhi(w.z), bflo(w.w), bfhi(w.w));
                    *(u32x2*)(Y8 + yo) = w8;
                }
        }
    }
};
struct EpiGlu {
    static constexpr int NST = 16;
    static constexpr bool PERM = true;
    const bf16* Y; unsigned char* MIX8;
    __device__ __forceinline__ void operator()(const f32x4 (&acc)[2][2][4][2], const Unit& u, int wr, int wc, int fr, int fq) const {
        const int row0 = u.pm * BM + wr * 64 + fr, col0 = u.pn * BM + wc * 32 + 8 * fq;
        const unsigned ylb = ((unsigned)(u.pn * 16 + wc * 2 + (fq >> 1)) * (unsigned)T + (unsigned)(u.pm * BM + wr * 64 + fr)) * 16u + 8u * (unsigned)(fq & 1);
        u32x4 yv[2][4][2];
#pragma unroll
        for (int ai = 0; ai < 2; ++ai)
#pragma unroll
            for (int m = 0; m < 4; ++m)
#pragma unroll
                for (int bj = 0; bj < 2; ++bj) yv[ai][m][bj] = *(const u32x4*)(Y + ylb + (unsigned)(bj * 8 * T * 16 + (ai * HALF + m * 16) * 16));
#pragma unroll
        for (int ai = 0; ai < 2; ++ai)
#pragma unroll
            for (int m = 0; m < 4; ++m) { const int row = row0 + ai * HALF + m * 16;
#pragma unroll
                for (int bj = 0; bj < 2; ++bj) { const int col = col0 + bj * HALF; const f32x4 v0 = acc[ai][bj][m][0] * W8_INV, v1 = acc[ai][bj][m][1] * W8_INV;
                    const u32x4 y = yv[ai][m][bj];
                    u32x2 w; w.x = cvt4_fp8(bflo(y.x) * sigmoid_f(v0[0]), bfhi(y.x) * sigmoid_f(v0[1]), bflo(y.y) * sigmoid_f(v0[2]), bfhi(y.y) * sigmoid_f(v0[3]));
                    w.y = cvt4_fp8(bflo(y.z) * sigmoid_f(v1[0]), bfhi(y.z) * sigmoid_f(v1[1]), bflo(y.w) * sigmoid_f(v1[2]), bfhi(y.w) * sigmoid_f(v1[3]));
                    *(u32x2*)(MIX8 + (size_t)row * DM + 1024 + col) = w; } }
    }
};
template <bool XF32> struct EpiResid {
    static constexpr int NST = 16;
    static constexpr bool PERM = true;
    const void* xin_; bf16* Z;
    __device__ __forceinline__ void operator()(const f32x4 (&acc)[2][2][4][2], const Unit& u, int wr, int wc, int fr, int fq) const {
        const int row0 = u.pm * BM + wr * 64 + fr, col0 = u.pn * BM + wc * 32 + 8 * fq;
#pragma unroll
        for (int ai = 0; ai < 2; ++ai) {
            f32x4 xf0[XF32 ? 4 : 1][2], xf1[XF32 ? 4 : 1][2]; u32x4 xb[XF32 ? 1 : 4][2];
#pragma unroll
            for (int m = 0; m < 4; ++m)
#pragma unroll
                for (int bj = 0; bj < 2; ++bj) { const size_t off = (size_t)(row0 + ai * HALF + m * 16) * DM + col0 + bj * HALF;
                    if constexpr (XF32) { const float* xf = (const float*)xin_ + off; xf0[m][bj] = __builtin_nontemporal_load((const f32x4*)xf); xf1[m][bj] = __builtin_nontemporal_load((const f32x4*)(xf + 4)); }
                    else xb[m][bj] = __builtin_nontemporal_load((const u32x4*)((const bf16*)xin_ + off)); }
#pragma unroll
            for (int m = 0; m < 4; ++m) { const size_t off = (size_t)(row0 + ai * HALF + m * 16) * DM + col0;
#pragma unroll
                for (int bj = 0; bj < 2; ++bj) { const f32x4 v0 = acc[ai][bj][m][0] * W8_INV, v1 = acc[ai][bj][m][1] * W8_INV;
                    u32x4 w;
                    if constexpr (XF32) { const f32x4 x0 = xf0[m][bj], x1 = xf1[m][bj];
                        w.x = cvt_pk_bf16(ALPHA * x0[0] + v0[0], ALPHA * x0[1] + v0[1]); w.y = cvt_pk_bf16(ALPHA * x0[2] + v0[2], ALPHA * x0[3] + v0[3]);
                        w.z = cvt_pk_bf16(ALPHA * x1[0] + v1[0], ALPHA * x1[1] + v1[1]); w.w = cvt_pk_bf16(ALPHA * x1[2] + v1[2], ALPHA * x1[3] + v1[3]);
                    } else { const u32x4 x = xb[m][bj];
                        w.x = cvt_pk_bf16(ALPHA * bflo(x.x) + v0[0], ALPHA * bfhi(x.x) + v0[1]); w.y = cvt_pk_bf16(ALPHA * bflo(x.y) + v0[2], ALPHA * bfhi(x.y) + v0[3]);
                        w.z = cvt_pk_bf16(ALPHA * bflo(x.z) + v1[0], ALPHA * bfhi(x.z) + v1[1]); w.w = cvt_pk_bf16(ALPHA * bflo(x.w) + v1[2], ALPHA * bfhi(x.w) + v1[3]); }
                    *(u32x4*)(Z + off + bj * HALF) = w; } }
        }
    }
};
struct EpiGateUp {
    static constexpr int NST = 4;
    static constexpr bool PERM = true;
    unsigned char* H;
    __device__ __forceinline__ void operator()(const f32x4 (&acc)[2][2][4][2], const Unit& u, int wr, int wc, int fr, int fq) const {
        const int row0 = u.pm + wr * 64 + fr, col0 = u.pn * HALF + wc * 32 + 8 * fq; const int nai = (u.e & 256) ? 1 : 2;
#pragma unroll
        for (int ai = 0; ai < 2; ++ai) if (ai < nai)
#pragma unroll
            for (int m = 0; m < 4; ++m) { const f32x4 g0 = acc[ai][0][m][0] * W8_INV, g1 = acc[ai][0][m][1] * W8_INV, u0 = acc[ai][1][m][0] * W8_INV, u1 = acc[ai][1][m][1] * W8_INV;
                u32x2 w; w.x = cvt4_fp8(silu_f(g0[0]) * u0[0], silu_f(g0[1]) * u0[1], silu_f(g0[2]) * u0[2], silu_f(g0[3]) * u0[3]);
                w.y = cvt4_fp8(silu_f(g1[0]) * u1[0], silu_f(g1[1]) * u1[1], silu_f(g1[2]) * u1[2], silu_f(g1[3]) * u1[3]);
                *(u32x2*)(H + (size_t)(row0 + ai * HALF + m * 16) * DE + col0) = w; }
    }
};
}

#define XB_TMO      128
#define XB_XCNT(j)  (256  + 64 * (j))
#define XB_XSUB(j)  (1280 + 64 * (j))
#define XB_XGEN(j)  (2304 + 64 * (j))
#define XB_TOP      3328
#define XB_TOPGEN   3392
#define XCD_BAR_WORDS 3456
#define XB_SPIN_CAP (1u << 18)

__device__ __forceinline__ unsigned xb_ld(unsigned* p)              { return __hip_atomic_load(p, __ATOMIC_RELAXED, __HIP_MEMORY_SCOPE_AGENT); }
__device__ __forceinline__ unsigned xb_add(unsigned* p, unsigned v) { return __hip_atomic_fetch_add(p, v, __ATOMIC_RELAXED, __HIP_MEMORY_SCOPE_AGENT); }
__device__ __forceinline__ unsigned xb_xcc_id() { return (unsigned)__builtin_amdgcn_s_getreg((3 << 11) | 20) & 0xFu; }
#define XB_SPIN(cond, bar) do { unsigned _sp = 0; while (cond) { __builtin_amdgcn_s_sleep(1); \
    if ((++_sp & 255u) == 0u) { if (xb_ld(&(bar)[XB_TMO])) break; if (_sp > XB_SPIN_CAP) { atomicAdd(&(bar)[XB_TMO], 1u); break; } } } } while (0)

struct XcdBarrier { unsigned* bar; unsigned x; volatile LAS unsigned* st; };

__device__ __forceinline__ XcdBarrier xcd_barrier_post(unsigned* bar, volatile LAS unsigned* st) {
    XcdBarrier b; b.bar = bar; b.x = xb_xcc_id(); b.st = st;
    if (threadIdx.x == 0) (void)xb_add(&bar[XB_XCNT(b.x)], 1u);
    return b;
}
__device__ __forceinline__ void xcd_barrier_complete(unsigned* bar, unsigned x, unsigned& nloc, unsigned& nx) {
    const unsigned G = gridDim.x * gridDim.y * gridDim.z;
    unsigned sum, cnt, mine, sp = 0u;
    for (;;) {
        sum = 0u; cnt = 0u; mine = 0u;
#pragma unroll
        for (unsigned j = 0; j < 16; ++j) { const unsigned c = xb_ld(&bar[XB_XCNT(j)]); sum += c; cnt += (c > 0u) ? 1u : 0u; mine = (j == x) ? c : mine; }
        if (sum == G) break;
        __builtin_amdgcn_s_sleep(1);
        if ((++sp & 255u) == 0u) { if (xb_ld(&bar[XB_TMO])) break; if (sp > XB_SPIN_CAP) { atomicAdd(&bar[XB_TMO], 1u); break; } }
    }
    nloc = mine > 0u ? mine : 1u; nx = cnt > 0u ? cnt : 1u;
}
__device__ __forceinline__ void xcd_barrier(const XcdBarrier& b) {
    asm volatile("s_waitcnt vmcnt(0)" ::: "memory");
    __syncthreads();
    if (threadIdx.x == 0) {
        unsigned* bar = b.bar;
        __builtin_amdgcn_s_waitcnt(0);
        unsigned nloc = b.st[0], nx = b.st[1];
        if (nloc == 0u) { xcd_barrier_complete(bar, b.x, nloc, nx); b.st[0] = nloc; b.st[1] = nx; }
        const unsigned old = xb_add(&bar[XB_XSUB(b.x)], 1u);
        const unsigned gen = old / nloc;
        if (old + 1u == (gen + 1u) * nloc) {
            __builtin_amdgcn_fence(__ATOMIC_RELEASE, "agent");
            asm volatile("s_waitcnt vmcnt(0)" ::: "memory");
            const unsigned og = xb_add(&bar[XB_TOP], 1u);
            const unsigned tg = og / nx;
            if (og + 1u == (tg + 1u) * nx) xb_add(&bar[XB_TOPGEN], 1u);
            else XB_SPIN(xb_ld(&bar[XB_TOPGEN]) == tg, bar);
            __builtin_amdgcn_fence(__ATOMIC_ACQUIRE, "agent");
            xb_add(&bar[XB_XGEN(b.x)], 1u);
            asm volatile("s_waitcnt vmcnt(0)" ::: "memory");
        } else {
            XB_SPIN(xb_ld(&bar[XB_XGEN(b.x)]) == gen, bar);
            __builtin_amdgcn_fence(__ATOMIC_ACQUIRE, "agent");
            asm volatile("s_waitcnt vmcnt(0)" ::: "memory");
        }
    }
    __syncthreads();
}

struct Args { const float* in[21]; float* out; unsigned char* ws; int ph_lo, ph_hi; };

struct Frame {
    LAS unsigned char* lds;
    int tid, lane, wave, vcu, G;
    unsigned char* ws; unsigned* ctl;
};

struct TItem { const float* src; unsigned char* dst; int srcN, dld, f8; };
__device__ __forceinline__ void titem_load(const TItem& t, f32x4 (&v)[16], int lane) {
    const float* p = t.src + (size_t)(16 * (lane >> 4)) * t.srcN + 4 * (lane & 15);
#pragma unroll
    for (int i = 0; i < 16; ++i) v[i] = __builtin_nontemporal_load((const f32x4*)(p + (size_t)i * t.srcN));
}
__device__ __forceinline__ void titem_convert_write(const TItem& t, const f32x4 (&v)[16], int lane) {
    unsigned char* d = t.dst + (size_t)(4 * (lane & 15)) * t.dld + 16 * (lane >> 4);
#pragma unroll
    for (int c = 0; c < 4; ++c) { u32x4 w;
        w.x = cvt4_fp8(v[0][c] * W8_SCALE, v[1][c] * W8_SCALE, v[2][c] * W8_SCALE, v[3][c] * W8_SCALE); w.y = cvt4_fp8(v[4][c] * W8_SCALE, v[5][c] * W8_SCALE, v[6][c] * W8_SCALE, v[7][c] * W8_SCALE);
        w.z = cvt4_fp8(v[8][c] * W8_SCALE, v[9][c] * W8_SCALE, v[10][c] * W8_SCALE, v[11][c] * W8_SCALE); w.w = cvt4_fp8(v[12][c] * W8_SCALE, v[13][c] * W8_SCALE, v[14][c] * W8_SCALE, v[15][c] * W8_SCALE);
        *(u32x4*)(d + (size_t)c * t.dld) = w; }
}
constexpr int TI_IN = 2 * 32 * 80, TI_OUT = 2 * 32 * 32, TI_GLU = 2 * 16 * 16, TI_G = 64 * 32 * 16, TI_U = TI_G, TI_D = 64 * 16 * 32;
constexpr int TI_N = TI_IN + TI_OUT + TI_GLU + TI_G + TI_U + TI_D;
__device__ __forceinline__ TItem titem_decode(const Args& a, unsigned char* ws, int it) {
    TItem t; int r = it;
    if (r < TI_IN) { const int l = r / (32 * 80), q = r % (32 * 80), kb = q / 80, nb = q % 80, n0 = nb * 64, seg = n0 >> 10;
        const int drow = (seg == 0 ? 0 : seg == 1 ? 1024 : seg == 2 ? 4096 : seg == 3 ? 2048 : 3072) + (n0 & 1023);
        t.src = a.in[1] + (size_t)l * DM * NPROJ + (size_t)kb * 64 * NPROJ + n0; t.srcN = NPROJ; t.dst = ws + WS_WIN + (((size_t)l * NPROJ + drow) * DM + kb * 64); t.dld = DM; t.f8 = 1; return t; }
    r -= TI_IN;
    if (r < TI_OUT) { const int l = r / 1024, q = r % 1024, kb = q / 32, nb = q % 32;
        t.src = a.in[2] + (size_t)l * DM * DM + (size_t)kb * 64 * DM + nb * 64; t.srcN = DM; t.dst = ws + WS_WOUT + (((size_t)l * DM + nb * 64) * DM + kb * 64); t.dld = DM; t.f8 = 1; return t; }
    r -= TI_OUT;
    if (r < TI_GLU) { const int l = r / 256, q = r % 256, kb = q / 16, nb = q % 16;
        t.src = a.in[11] + (size_t)l * 1024 * 1024 + (size_t)kb * 64 * 1024 + nb * 64; t.srcN = 1024; t.dst = ws + WS_WGLU + (((size_t)l * 1024 + nb * 64) * 1024 + kb * 64); t.dld = 1024; t.f8 = 1; return t; }
    r -= TI_GLU;
    if (r < TI_G + TI_U) { const int up = r >= TI_G ? 1 : 0; if (up) r -= TI_G; const int le = r / 512, q = r % 512, kb = ((q >> 1) / 16) * 2 + (q & 1), nb = (q >> 1) % 16, n0 = nb * 64;
        const int drow = (n0 >> 7) * 256 + up * 128 + (n0 & 127);
        t.src = (up ? a.in[19] : a.in[18]) + (size_t)le * DM * DE + (size_t)kb * 64 * DE + n0; t.srcN = DE; t.dst = ws + WS_WGU + ((size_t)le * 2048 + drow) * DM + kb * 64; t.dld = DM; t.f8 = 1; return t; }
    r -= TI_G + TI_U;
    { const int le = r / 512, q = r % 512, kb = ((q >> 1) / 32) * 2 + (q & 1), nb = (q >> 1) % 32;
        t.src = a.in[20] + (size_t)le * DE * DM + (size_t)kb * 64 * DM + nb * 64; t.srcN = DM; t.dst = ws + WS_WDN + ((size_t)le * DM + nb * 64) * DE + kb * 64; t.dld = DE; t.f8 = 1; return t; }
}

__device__ __forceinline__ void convert_items(Frame& F, const Args& a, int first, int count, int gw = -1, int NGW = 0) {
    int lane_ = F.lane; asm volatile("" : "+v"(lane_));
    if (gw < 0) { gw = F.vcu * NWAVES + F.wave; NGW = F.G * NWAVES; }
    f32x4 va[16], vb[16];
    for (int q = gw; q < count / 2; q += NGW) {
        const TItem ta = titem_decode(a, F.ws, first + 2 * q), tb = titem_decode(a, F.ws, first + 2 * q + 1);
        titem_load(ta, va, lane_); titem_load(tb, vb, lane_);
        titem_convert_write(ta, va, lane_); titem_convert_write(tb, vb, lane_);
    }
}
struct ConvHook { static constexpr bool ON = true; Frame* F; const Args* a; int first, count, gw, ngw, at;
    __device__ __forceinline__ bool wants(int ui) const { return ui == at; }
    __device__ __forceinline__ void operator()(int) const { convert_items(*F, *a, first, count, gw, ngw); } };
constexpr int TI_MOE0 = TI_IN + TI_OUT + TI_GLU;

__device__ __forceinline__ void p0_prologue(Frame& F, const Args& a) {
    LAS float* scr = (LAS float*)(F.lds + F.wave * 16640);
    const int gw = F.vcu * NWAVES + F.wave, NGW = F.G * NWAVES;
    {
        LAS float* APr = (LAS float*)(F.lds);
        LAS float* APi = APr + 17 * 64;
        LAS float* BBr = APi + 17 * 64;
        LAS float* BBi = BBr + 1024;
        LAS float* CCr = BBi + 1024;
        LAS float* CCi = CCr + 1024;
        LAS float* DD = CCi + 1024;
        LAS float* KM = DD + 16;
        for (int it = F.vcu; it < 2 * SGRP; it += F.G) {
            const int l = it / SGRP, g = it % SGRP; const size_t lg = (size_t)l * SGRP + g;
            const float dt = expf(a.in[10][lg]);
            for (int idx = F.tid; idx < 17 * 64; idx += 512) { const int tau = idx >> 6, p = idx & 63;
                const float zr = a.in[3][lg * SST + p] * dt, zi = a.in[4][lg * SST + p] * dt; const float mg = expf(zr * (float)tau); float sn, cs; sincosf(zi * (float)tau, &sn, &cs);
                APr[idx] = mg * cs; APi[idx] = mg * sn;
                if (tau == 16) { float* A16 = (float*)(F.ws + WS_S5A) + (lg * SST + p) * 2; A16[0] = mg * cs; A16[1] = mg * sn; } }
            for (int idx = F.tid; idx < 1024; idx += 512) { const int p = idx >> 4;
                const float lre = a.in[3][lg * SST + p], lim = a.in[4][lg * SST + p], zr = lre * dt, zi = lim * dt;
                float sn, cs, sh, ch_; sincosf(zi, &sn, &cs); sincosf(0.5f * zi, &sh, &ch_); (void)ch_;
                const float em = expm1f(zr), ez = em + 1.0f; const float nr = em * cs - 2.0f * sh * sh, ni = ez * sn, den = lre * lre + lim * lim;
                const float sr = (nr * lre + ni * lim) / den, si = (ni * lre - nr * lim) / den;
                const float br = a.in[5][lg * 1024 + idx], bi = a.in[6][lg * 1024 + idx];
                BBr[idx] = sr * br - si * bi; BBi[idx] = sr * bi + si * br;
                CCr[idx] = a.in[7][lg * 1024 + idx]; CCi[idx] = a.in[8][lg * 1024 + idx]; }
            if (F.tid < 16) DD[F.tid] = a.in[9][lg * SCH + F.tid];
            __syncthreads();
            { const int tau = F.tid >> 5, ch0 = ((F.tid >> 2) & 7) * 2, cp0 = (F.tid & 3) * 4; float acc[2][4];
#pragma unroll
              for (int i = 0; i < 2; ++i)
#pragma unroll
                  for (int j = 0; j < 4; ++j) acc[i][j] = 0.f;
              for (int p = 0; p < 64; ++p) { const float ar = APr[tau * 64 + p], ai = APi[tau * 64 + p];
                  const f32x4 br = *(const LAS f32x4*)(BBr + p * 16 + cp0), bi = *(const LAS f32x4*)(BBi + p * 16 + cp0);
#pragma unroll
                  for (int i = 0; i < 2; ++i) { const float cr = CCr[(ch0 + i) * 64 + p], ci = CCi[(ch0 + i) * 64 + p]; const float car = cr * ar - ci * ai, cai = cr * ai + ci * ar;
#pragma unroll
                      for (int j = 0; j < 4; ++j) acc[i][j] += car * br[j] - cai * bi[j]; } }
#pragma unroll
              for (int i = 0; i < 2; ++i)
#pragma unroll
                  for (int j = 0; j < 4; ++j) KM[(tau << 8) + ((ch0 + i) << 4) + cp0 + j] = acc[i][j]; }
            __syncthreads();
            bf16* Bout = (bf16*)(F.ws + WS_S5OUT) + lg * (size_t)(256 * KS5);
            for (int v = F.tid; v < 256 * 48; v += 512) { const int n = v / 48, k8 = (v % 48) * 8, tt = n >> 4, ch = n & 15; float o[8];
                if (k8 < 256) { const int s5 = k8 >> 4, cpb = k8 & 15;
#pragma unroll
                    for (int j = 0; j < 8; ++j) { float x = (s5 <= tt) ? KM[((tt - s5) << 8) + (ch << 4) + cpb + j] : 0.f; if (s5 == tt && cpb + j == ch) x += DD[ch]; o[j] = x; } }
                else { const int p0 = (k8 - 256) & 63; const bool im = k8 >= 320;
#pragma unroll
                    for (int j = 0; j < 8; ++j) { const int p = p0 + j; const float cr = CCr[ch * 64 + p], ci = CCi[ch * 64 + p], ar = APr[(tt + 1) * 64 + p], ai = APi[(tt + 1) * 64 + p];
                        o[j] = im ? -(cr * ai + ci * ar) : (cr * ar - ci * ai); } }
                u32x4 w; w.x = cvt_pk_bf16(o[0], o[1]); w.y = cvt_pk_bf16(o[2], o[3]); w.z = cvt_pk_bf16(o[4], o[5]); w.w = cvt_pk_bf16(o[6], o[7]);
                *(u32x4*)(Bout + (size_t)n * KS5 + k8) = w; }
            bf16* Min = (bf16*)(F.ws + WS_S5IN) + lg * (size_t)(128 * 256);
            for (int v = F.tid; v < 128 * 32; v += 512) { const int n = v >> 5, k8 = (v & 31) * 8, p = n & 63, s5 = k8 >> 4, cpb = k8 & 15; float o[8];
                const float ar = APr[(15 - s5) * 64 + p], ai = APi[(15 - s5) * 64 + p];
#pragma unroll
                for (int j = 0; j < 8; ++j) { const float br = BBr[p * 16 + cpb + j], bi = BBi[p * 16 + cpb + j]; o[j] = (n < 64) ? (ar * br - ai * bi) : (ar * bi + ai * br); }
                u32x4 w; w.x = cvt_pk_bf16(o[0], o[1]); w.y = cvt_pk_bf16(o[2], o[3]); w.z = cvt_pk_bf16(o[4], o[5]); w.w = cvt_pk_bf16(o[6], o[7]);
                *(u32x4*)(Min + (size_t)n * 256 + k8) = w; }
            __syncthreads();
        }
    }
    __syncthreads();
    convert_items(F, a, 0, TI_IN / 2);
    for (int part = 0; part < 2; ++part) { const float* x = a.in[0];
      const bool split = (F.G == 256); const size_t half = (size_t)T * DM / 16;
      if (split && part == 0 && F.vcu < 128) continue;
      const size_t i0 = split ? (size_t)part * half : 0, i1 = split ? i0 + half : (part == 0 ? 2 * half : 0);
      const size_t gwx = (split && part == 0) ? (size_t)(gw - 128 * NWAVES) : (size_t)gw, ngwx = (split && part == 0) ? (size_t)(128 * NWAVES) : (size_t)NGW;
      for (size_t i = i0 + gwx * 64 + F.lane; i < i1; i += 4 * ngwx * 64) {
          f32x4 p[4], q[4];
#pragma unroll
          for (int k = 0; k < 4; ++k) { const size_t ik = i + (size_t)k * ngwx * 64; if (ik < i1) { p[k] = __builtin_nontemporal_load((const f32x4*)(x + ik * 8)); q[k] = __builtin_nontemporal_load((const f32x4*)(x + ik * 8 + 4)); } }
#pragma unroll
          for (int k = 0; k < 4; ++k) { const size_t ik = i + (size_t)k * ngwx * 64; if (ik < i1) {
              u32x2 w8; w8.x = cvt4_fp8(p[k][0], p[k][1], p[k][2], p[k][3]); w8.y = cvt4_fp8(q[k][0], q[k][1], q[k][2], q[k][3]); *(u32x2*)(F.ws + WS_XB8 + ik * 8) = w8; } } } }
    { const float* rw = a.in[16]; bf16* hi = (bf16*)(F.ws + WS_RWT); bf16* lo = hi + NE * DM;
      for (int i = gw * 64 + F.lane; i < NE * DM; i += NGW * 64) { const int e = i >> 11, k = i & 2047; const float v = rw[k * NE + e];
          const unsigned h = cvt_pk_bf16(v, 0.f) & 0xffffu; const float r = v - __uint_as_float(h << 16);
          hi[i] = (bf16)h; lo[i] = (bf16)(cvt_pk_bf16(r, 0.f) & 0xffffu); } }
}

typedef float f32x16 __attribute__((ext_vector_type(16)));
constexpr int RK_OFF = 0, RV_OFF = 65536, RP_OFF = 131072, RX_OFF = 147456;
#define RET_BAR() do { asm volatile("s_waitcnt vmcnt(0) lgkmcnt(0)" ::: "memory"); __builtin_amdgcn_s_barrier(); asm volatile("" ::: "memory"); } while (0)
#define RET_BAR_L() do { asm volatile("s_waitcnt lgkmcnt(0)" ::: "memory"); __builtin_amdgcn_s_barrier(); asm volatile("" ::: "memory"); } while (0)
__device__ __forceinline__ void retention_qtile(Frame& F, const bf16* Q, const bf16* Kk, const bf16* VT, const bf16* Gs, unsigned char* MIX8, int b, int h, int I) {
    int lane_ = F.lane; asm volatile("" : "+v"(lane_));
    const int w = F.wave, rg = w & 3, hf = w >> 2, l31 = lane_ & 31, hh = lane_ >> 5;
    LAS unsigned char* Ks = F.lds + RK_OFF; LAS unsigned char* Vs = F.lds + RV_OFF; LAS unsigned char* Ps = F.lds + RP_OFF; LAS float* Xs = (LAS float*)(F.lds + RX_OFF);
    const int ipos = I * 128 + rg * 32 + l31; const size_t tok = (size_t)b * SEQ + ipos;
    bf16x8 qf[16];
#pragma unroll
    for (int ks = 0; ks < 16; ++ks) qf[ks] = *(const bf16x8*)(Q + tok * RW + h * HD + ks * 16 + hh * 8);
    f32x16 oacc[4];
#pragma unroll
    for (int e = 0; e < 4; ++e)
#pragma unroll
        for (int r = 0; r < 16; ++r) oacc[e][r] = 0.f;
    const int nJ = 2 * I + 2;
    const char* kbase = (const char*)(Kk + ((size_t)b * SEQ) * RW + h * HD); const char* vbase = (const char*)(VT + ((size_t)h * HD) * T + (size_t)b * SEQ);
    const int krow = w * 2 + (lane_ >> 5), vrow = w * 8 + (lane_ >> 3);
    const unsigned ko0 = (unsigned)(krow * RW * 2 + ((l31 ^ (krow & 15)) * 16)), vo0 = (unsigned)(vrow * T * 2 + (((lane_ & 7) ^ ((vrow >> 1) & 7)) * 16));
#define RET_DMA_KV(J) do { const char* kb_ = kbase + (size_t)(J) * (64 * RW * 2); const char* vb_ = vbase + (size_t)(J) * 128; const int bo_ = ((J) & 1) * 32768; \
        unsigned ko_ = ko0, vo_ = vo0; asm volatile("" : "+v"(ko_), "+v"(vo_)); \
        _Pragma("unroll") for (int k = 0; k < 4; ++k) __builtin_amdgcn_global_load_lds((const unsigned*)(kb_ + (ko_ + (unsigned)k * (unsigned)(16 * RW * 2))), (LAS unsigned*)(Ks + bo_ + (k * 512 + w * 64) * 16), 16, 0, 0); \
        _Pragma("unroll") for (int k = 0; k < 4; ++k) __builtin_amdgcn_global_load_lds((const unsigned*)(vb_ + (vo_ + (unsigned)k * (unsigned)(64 * T * 2))), (LAS unsigned*)(Vs + bo_ + (k * 512 + w * 64) * 16), 16, 0, 0); } while (0)
    const int kr = 32 * hf + l31, kx = kr & 15; const int pr = 32 * rg + l31, px = (pr >> 1) & 7; const int vx = (l31 >> 1) & 7;
    LAS unsigned char* pp = Ps + pr * 128;
    unsigned ka[8], pa[4], va[4];
#pragma unroll
    for (int m = 0; m < 8; ++m) ka[m] = (unsigned)(size_t)(Ks + kr * 512 + (((2 * m + hh) ^ kx) * 16));
#pragma unroll
    for (int m = 0; m < 4; ++m) { pa[m] = (unsigned)(size_t)(Ps + pr * 128 + (((2 * m + hh) ^ px) * 16)); va[m] = (unsigned)(size_t)(Vs + (128 * hf + l31) * 128 + (((2 * m + hh) ^ vx) * 16)); }
#define DSR128(dst, addr, off) asm volatile("ds_read_b128 %0, %1 offset:" #off : "=v"(dst) : "v"(addr) : "memory")
#define WAITL(n) do { asm volatile("s_waitcnt lgkmcnt(" #n ")" ::: "memory"); __builtin_amdgcn_sched_barrier(0); } while (0)
#define SBAR() __builtin_amdgcn_sched_barrier(0)
#define RET_DMA_K(J_) do { const char* kb_ = kbase + (size_t)(J_) * (64 * RW * 2); const int bo_ = ((J_) & 1) * 32768; unsigned ko_ = ko0; asm volatile("" : "+v"(ko_)); \
        _Pragma("unroll") for (int k = 0; k < 4; ++k) __builtin_amdgcn_global_load_lds((const unsigned*)(kb_ + (ko_ + (unsigned)k * (unsigned)(16 * RW * 2))), (LAS unsigned*)(Ks + bo_ + (k * 512 + w * 64) * 16), 16, 0, 0); } while (0)
#define RET_DMA_V(J_) do { const char* vb_ = vbase + (size_t)(J_) * 128; const int bo_ = ((J_) & 1) * 32768; unsigned vo_ = vo0; asm volatile("" : "+v"(vo_)); \
        _Pragma("unroll") for (int k = 0; k < 4; ++k) __builtin_amdgcn_global_load_lds((const unsigned*)(vb_ + (vo_ + (unsigned)k * (unsigned)(64 * T * 2))), (LAS unsigned*)(Vs + bo_ + (k * 512 + w * 64) * 16), 16, 0, 0); } while (0)
#define RET_BARV(n) do { asm volatile("s_waitcnt vmcnt(" #n ")" ::: "memory"); __builtin_amdgcn_s_barrier(); asm volatile("" ::: "memory"); } while (0)
    bf16x8 f0, f1, f2, f3;
    RET_DMA_K(0); RET_DMA_V(0); RET_DMA_K(1);
    RET_BARV(8);
    SBAR(); DSR128(f0, ka[0], 0); DSR128(f1, ka[1], 0); DSR128(f2, ka[2], 0); DSR128(f3, ka[3], 0); SBAR();
    for (int J = 0; J < nJ; ++J) {
        const bool hasn = (J + 1 < nJ);
        if (hasn) RET_BARV(4); else RET_BARV(0);
        if (hasn) RET_DMA_V(J + 1);
        const unsigned bofs = (unsigned)((J & 1) * 32768);
        unsigned kaj[8], vaj[4];
#pragma unroll
        for (int m = 0; m < 8; ++m) kaj[m] = ka[m] + bofs;
#pragma unroll
        for (int m = 0; m < 4; ++m) vaj[m] = va[m] + bofs;
        f32x16 sacc;
#pragma unroll
        for (int r = 0; r < 16; ++r) sacc[r] = 0.f;
        {
#define RET_S1(fr, ks, cnt, nxt) WAITL(cnt); sacc = __builtin_amdgcn_mfma_f32_32x32x16_bf16(fr, qf[ks], sacc, 0, 0, 0); SBAR(); nxt; SBAR();
            RET_S1(f0, 0, 3, DSR128(f0, kaj[4], 0)) RET_S1(f1, 1, 3, DSR128(f1, kaj[5], 0)) RET_S1(f2, 2, 3, DSR128(f2, kaj[6], 0)) RET_S1(f3, 3, 3, DSR128(f3, kaj[7], 0))
            RET_S1(f0, 4, 3, DSR128(f0, kaj[0], 256)) RET_S1(f1, 5, 3, DSR128(f1, kaj[1], 256)) RET_S1(f2, 6, 3, DSR128(f2, kaj[2], 256)) RET_S1(f3, 7, 3, DSR128(f3, kaj[3], 256))
            RET_S1(f0, 8, 3, DSR128(f0, kaj[4], 256)) RET_S1(f1, 9, 3, DSR128(f1, kaj[5], 256)) RET_S1(f2, 10, 3, DSR128(f2, kaj[6], 256)) RET_S1(f3, 11, 3, DSR128(f3, kaj[7], 256))
            RET_S1(f0, 12, 3, (void)0) RET_S1(f1, 13, 2, (void)0) RET_S1(f2, 14, 1, (void)0) RET_S1(f3, 15, 0, (void)0)
#undef RET_S1
        }
        if (J * 64 + 63 > I * 128 + rg * 32) { const int d0 = ipos - J * 64 - 32 * hf - 4 * hh;
#pragma unroll
            for (int r = 0; r < 16; ++r) sacc[r] = (d0 >= (r & 3) + 8 * (r >> 2)) ? sacc[r] : 0.f; }
#pragma unroll
        for (int q = 0; q < 4; ++q) { u32x2 pw; pw.x = cvt_pk_bf16(sacc[4 * q], sacc[4 * q + 1]); pw.y = cvt_pk_bf16(sacc[4 * q + 2], sacc[4 * q + 3]);
            *(LAS u32x2*)(pp + (((4 * hf + q) ^ px) * 16) + 8 * hh) = pw; }
        bf16x8 pA, pB, v0, v1, v2, v3;
        SBAR(); DSR128(v0, vaj[0], 0); DSR128(v1, vaj[0], 4096); DSR128(v2, vaj[0], 8192); DSR128(v3, vaj[0], 12288); SBAR();
        asm volatile("s_waitcnt lgkmcnt(4)" ::: "memory");
        RET_BARV(4);
        if (J + 2 < nJ) RET_DMA_K(J + 2);
        {
            SBAR(); DSR128(pA, pa[0], 0); DSR128(pB, pa[1], 0);
#define RET_S2(vr, pr_, et, cnt, nxt) WAITL(cnt); oacc[et] = __builtin_amdgcn_mfma_f32_32x32x16_bf16(vr, pr_, oacc[et], 0, 0, 0); SBAR(); nxt; SBAR();
            RET_S2(v0, pA, 0, 1, DSR128(v0, vaj[1], 0)) RET_S2(v1, pA, 1, 2, DSR128(v1, vaj[1], 4096)) RET_S2(v2, pA, 2, 3, DSR128(v2, vaj[1], 8192)) RET_S2(v3, pA, 3, 4, DSR128(v3, vaj[1], 12288))
            SBAR(); DSR128(pA, pa[2], 0);
            RET_S2(v0, pB, 0, 4, DSR128(v0, vaj[2], 0)) RET_S2(v1, pB, 1, 4, DSR128(v1, vaj[2], 4096)) RET_S2(v2, pB, 2, 4, DSR128(v2, vaj[2], 8192)) RET_S2(v3, pB, 3, 4, DSR128(v3, vaj[2], 12288))
            SBAR(); DSR128(pB, pa[3], 0);
            RET_S2(v0, pA, 0, 4, DSR128(v0, vaj[3], 0)) RET_S2(v1, pA, 1, 4, DSR128(v1, vaj[3], 4096)) RET_S2(v2, pA, 2, 4, DSR128(v2, vaj[3], 8192)) RET_S2(v3, pA, 3, 4, DSR128(v3, vaj[3], 12288))
            RET_S2(v0, pB, 0, 3, (void)0) RET_S2(v1, pB, 1, 2, (void)0) RET_S2(v2, pB, 2, 1, (void)0) RET_S2(v3, pB, 3, 0, (void)0)
#undef RET_S2
        }
        if (hasn) { const unsigned bn = (unsigned)(((J + 1) & 1) * 32768);
            SBAR(); DSR128(f0, ka[0] + bn, 0); DSR128(f1, ka[1] + bn, 0); DSR128(f2, ka[2] + bn, 0); DSR128(f3, ka[3] + bn, 0); SBAR(); }
    }
#undef RET_DMA_K
#undef RET_DMA_V
#undef RET_BARV
#undef RET_DMA_KV
#undef DSR128
#undef WAITL
#undef SBAR
    float s1 = 0.f, s2 = 0.f;
#pragma unroll
    for (int et = 0; et < 4; ++et)
#pragma unroll
        for (int r = 0; r < 16; ++r) { s1 += oacc[et][r]; s2 += oacc[et][r] * oacc[et][r]; }
    s1 += __shfl_xor(s1, 32); s2 += __shfl_xor(s2, 32);
    if (hh == 0) { Xs[(hf * 128 + pr) * 2] = s1; Xs[(hf * 128 + pr) * 2 + 1] = s2; }
    RET_BAR();
    s1 += Xs[((hf ^ 1) * 128 + pr) * 2]; s2 += Xs[((hf ^ 1) * 128 + pr) * 2 + 1];
    const float mean = s1 * (1.0f / 256.0f); const float var = fmaxf(s2 * (1.0f / 256.0f) - mean * mean, 0.f);
    const float rstd = 1.0f / sqrtf(var + LN_EPS);
    u32x2 gvv[4][4];
#pragma unroll
    for (int et = 0; et < 4; ++et)
#pragma unroll
        for (int q = 0; q < 4; ++q) gvv[et][q] = *(const u32x2*)(Gs + tok * RW + h * HD + 128 * hf + 32 * et + 8 * q + 4 * hh);
#pragma unroll
    for (int et = 0; et < 4; ++et)
#pragma unroll
        for (int q = 0; q < 4; ++q) { const int e = h * HD + 128 * hf + 32 * et + 8 * q + 4 * hh;
            const u32x2 gv = gvv[et][q];
            *(unsigned*)(MIX8 + tok * DM + e) = cvt4_fp8((oacc[et][4 * q] - mean) * rstd * bflo(gv.x), (oacc[et][4 * q + 1] - mean) * rstd * bfhi(gv.x),
                                                         (oacc[et][4 * q + 2] - mean) * rstd * bflo(gv.y), (oacc[et][4 * q + 3] - mean) * rstd * bfhi(gv.y)); }
    RET_BAR();
}

constexpr int S5A_OFF = 0, S5I_OFF = 65536, S5E_OFF = S5I_OFF + 128 * 129 * 4;
__device__ __forceinline__ void s5in_pair(Frame& F, bf16* U2, const bf16* Min, const float* A16, int g, int b0) {
    const int l15 = F.lane & 15, g4 = F.lane >> 4, w = F.wave;
    LAS unsigned char* As = F.lds + S5A_OFF; LAS float* inc = (LAS float*)(F.lds + S5I_OFF); LAS float* Es = (LAS float*)(F.lds + S5E_OFF);
#define S5_STAGE(bb) do { const char* ub = (const char*)(U2 + (size_t)(g * 1024 + (bb) * 128) * KS5); const int row0 = w * 2 + (F.lane >> 5); \
      const unsigned so = (unsigned)(row0 * KS5 * 2 + (((F.lane & 31) ^ (row0 & 15)) * 16)); \
      _Pragma("unroll") for (int k = 0; k < 8; ++k) pg8::glds16s(ub + (size_t)k * (16 * KS5 * 2), so, (unsigned)(size_t)As + (unsigned)((k * 512 + w * 64) * 16)); } while (0)
    S5_STAGE(b0);
    bf16x8 bfr[8];
#pragma unroll
    for (int ks = 0; ks < 8; ++ks) bfr[ks] = *(const bf16x8*)(Min + (size_t)(w * 16 + l15) * 256 + ks * 32 + g4 * 8);
    const float a16r = A16[F.lane * 2], a16i = A16[F.lane * 2 + 1];
#pragma nounroll
    for (int ub_ = 0; ub_ < 2; ++ub_) { const int b = b0 + ub_;
    asm volatile("s_waitcnt vmcnt(0)" ::: "memory"); __syncthreads();
#pragma unroll 2
    for (int ct = 0; ct < 8; ++ct) { f32x4 acc = (f32x4){0.f, 0.f, 0.f, 0.f}; const int row = ct * 16 + l15;
#pragma unroll
        for (int ks = 0; ks < 8; ++ks) { const bf16x8 af = *(const LAS bf16x8*)(As + row * 512 + (((4 * ks + g4) ^ (row & 15)) * 16));
            acc = __builtin_amdgcn_mfma_f32_16x16x32_bf16(af, bfr[ks], acc, 0, 0, 0); }
#pragma unroll
        for (int r = 0; r < 4; ++r) inc[(ct * 16 + 4 * g4 + r) * 129 + w * 16 + l15] = acc[r]; }
    __syncthreads();
    if (ub_ == 0) S5_STAGE(b0 + 1);
    { const int p = F.lane, seg = w; const float ar = a16r, ai = a16i;
      float hr = 0.f, hi = 0.f;
#pragma unroll 4
      for (int j = 0; j < 16; ++j) { const int c = seg * 16 + j; const float ir = inc[c * 129 + p], ii = inc[c * 129 + 64 + p];
          const float nr = ar * hr - ai * hi + ir, ni = ar * hi + ai * hr + ii; hr = nr; hi = ni; }
      Es[(seg * 64 + p) * 2] = hr; Es[(seg * 64 + p) * 2 + 1] = hi;
      float pr = ar, pi = ai;
#pragma unroll
      for (int q = 0; q < 4; ++q) { const float t = pr * pr - pi * pi; pi = 2.f * pr * pi; pr = t; }
      LDS_WAIT(); __builtin_amdgcn_s_barrier(); asm volatile("" ::: "memory");
      float sr = 0.f, si = 0.f;
      for (int j = 0; j < seg; ++j) { const float er = Es[(j * 64 + p) * 2], ei = Es[(j * 64 + p) * 2 + 1]; const float nr = pr * sr - pi * si + er, ni = pr * si + pi * sr + ei; sr = nr; si = ni; }
      hr = sr; hi = si;
      bf16* row = U2 + (size_t)(g * 1024 + b * 128 + seg * 16) * KS5 + 256 + p;
#pragma unroll 4
      for (int j = 0; j < 16; ++j) { const int c = seg * 16 + j;
          row[(size_t)j * KS5] = (bf16)(cvt_pk_bf16(hr, 0.f) & 0xffffu); row[(size_t)j * KS5 + 64] = (bf16)(cvt_pk_bf16(hi, 0.f) & 0xffffu);
          const float ir = inc[c * 129 + p], ii = inc[c * 129 + 64 + p];
          const float nr = ar * hr - ai * hi + ir, ni = ar * hi + ai * hr + ii; hr = nr; hi = ni; }
    }
    LDS_WAIT(); __builtin_amdgcn_s_barrier(); asm volatile("" ::: "memory");
    }
    asm volatile("s_waitcnt vmcnt(0)" ::: "memory"); __syncthreads();
#undef S5_STAGE
}

__device__ __forceinline__ void ln1_router_unit(Frame& F, const Args& a, int layer, int unit) {
    const int l15 = F.lane & 15, g4 = F.lane >> 4, w = F.wave;
    const bf16* Zb = (const bf16*)(F.ws + WS_Z); unsigned char* X1F8 = F.ws + WS_XF; float* stats = (float*)(F.ws + WS_Z + 64 * MiB);
    const float* gam = a.in[12] + layer * DM; const float* bet = a.in[13] + layer * DM;
    LAS int* lcnt = (LAS int*)(F.lds + TST_OFF + 640); LAS int* lbase = lcnt + 32;
    if (F.tid < 32) lcnt[F.tid] = 0;
    const int r0 = unit * 64;
    LAS unsigned char* x1s = F.lds;
    LAS float* gl = (LAS float*)(F.lds + 131584);
    const f32x4 gst = *(const f32x4*)(gam + 4 * F.tid), bst = *(const f32x4*)(bet + 4 * F.tid);
    LAS float* sts = (LAS float*)(F.lds + 147968);
    f32x4 acc[4][2];
#pragma unroll
    for (int rt = 0; rt < 4; ++rt) { acc[rt][0] = (f32x4){0.f, 0.f, 0.f, 0.f}; acc[rt][1] = (f32x4){0.f, 0.f, 0.f, 0.f}; }
    {
        u32x4 xin[8][4];
#pragma unroll
        for (int rr = 0; rr < 8; ++rr)
#pragma unroll
            for (int j = 0; j < 4; ++j) xin[rr][j] = __builtin_nontemporal_load((const u32x4*)(Zb + (size_t)(r0 + 32 * (rr >> 2) + 4 * w + (rr & 3)) * DM + 8 * F.lane + 512 * j));
        *(LAS f32x4*)(gl + 4 * F.tid) = gst; *(LAS f32x4*)(gl + DM + 4 * F.tid) = bst;
        LDS_WAIT(); __builtin_amdgcn_s_barrier(); asm volatile("" ::: "memory");
        size_t zo_ = 0; asm volatile("" : "+s"(zo_));
        const bf16* rwh = (const bf16*)(F.ws + WS_RWT) + zo_ + (size_t)l15 * DM + w * 256 + g4 * 8; const bf16* rwl = rwh + NE * DM;
#pragma unroll
        for (int p = 0; p < 2; ++p) {
#pragma unroll
            for (int q4 = 0; q4 < 4; ++q4) { const int rr = 4 * p + q4; const int lr = 4 * w + q4; float v[4][8]; float s = 0.f;
                unsigned go_ = (unsigned)(8 * F.lane); asm volatile("" : "+v"(go_));
#pragma unroll
                for (int j = 0; j < 4; ++j) { const u32x4 x = xin[rr][j];
                    v[j][0] = bflo(x.x); v[j][1] = bfhi(x.x); v[j][2] = bflo(x.y); v[j][3] = bfhi(x.y); v[j][4] = bflo(x.z); v[j][5] = bfhi(x.z); v[j][6] = bflo(x.w); v[j][7] = bfhi(x.w);
#pragma unroll
                    for (int q = 0; q < 8; ++q) s += v[j][q]; }
                const float mean = wave_sum(s) * (1.0f / DM); float s2 = 0.f;
#pragma unroll
                for (int j = 0; j < 4; ++j)
#pragma unroll
                    for (int q = 0; q < 8; ++q) { v[j][q] -= mean; s2 += v[j][q] * v[j][q]; }
                const float rstd = 1.0f / sqrtf(wave_sum(s2) * (1.0f / DM) + LN_EPS);
                if (F.lane == 0) { sts[(32 * p + lr) * 2] = mean; sts[(32 * p + lr) * 2 + 1] = rstd; }
#pragma unroll
                for (int j = 0; j < 4; ++j) { const f32x4 g0 = *(const LAS f32x4*)(gl + go_ + 512 * j), g1 = *(const LAS f32x4*)(gl + go_ + 512 * j + 4), b0 = *(const LAS f32x4*)(gl + DM + go_ + 512 * j), b1 = *(const LAS f32x4*)(gl + DM + go_ + 512 * j + 4);
                    u32x4 pk; pk.x = cvt_pk_bf16(v[j][0] * rstd * g0[0] + b0[0], v[j][1] * rstd * g0[1] + b0[1]); pk.y = cvt_pk_bf16(v[j][2] * rstd * g0[2] + b0[2], v[j][3] * rstd * g0[3] + b0[3]);
                    pk.z = cvt_pk_bf16(v[j][4] * rstd * g1[0] + b1[0], v[j][5] * rstd * g1[1] + b1[1]); pk.w = cvt_pk_bf16(v[j][6] * rstd * g1[2] + b1[2], v[j][7] * rstd * g1[3] + b1[3]);
                    *(LAS u32x4*)(x1s + lr * 4112 + (8 * F.lane + 512 * j) * 2) = pk;
                    u32x2 p8; p8.x = cvt4_fp8(bflo(pk.x), bfhi(pk.x), bflo(pk.y), bfhi(pk.y)); p8.y = cvt4_fp8(bflo(pk.z), bfhi(pk.z), bflo(pk.w), bfhi(pk.w));
                    *(u32x2*)(X1F8 + (size_t)(r0 + 32 * p + lr) * DM + 8 * F.lane + 512 * j) = p8; }
            }
            LDS_WAIT(); __builtin_amdgcn_s_barrier(); asm volatile("" ::: "memory");
#pragma nounroll
            for (int s0 = 0; s0 < 8; s0 += 4) {
                bf16x8 ah[4][2], bh[4][2], bl[4][2];
#pragma unroll
                for (int i = 0; i < 4; ++i) {
#pragma unroll
                    for (int t = 0; t < 2; ++t) ah[i][t] = *(const LAS bf16x8*)(x1s + (t * 16 + l15) * 4112 + (w * 256 + (s0 + i) * 32 + g4 * 8) * 2);
#pragma unroll
                    for (int n = 0; n < 2; ++n) { bh[i][n] = *(const bf16x8*)(rwh + (size_t)n * 16 * DM + (s0 + i) * 32); bl[i][n] = *(const bf16x8*)(rwl + (size_t)n * 16 * DM + (s0 + i) * 32); } }
#pragma unroll
                for (int i = 0; i < 4; ++i)
#pragma unroll
                    for (int t = 0; t < 2; ++t)
#pragma unroll
                        for (int n = 0; n < 2; ++n) { acc[2 * p + t][n] = __builtin_amdgcn_mfma_f32_16x16x32_bf16(ah[i][t], bh[i][n], acc[2 * p + t][n], 0, 0, 0);
                            acc[2 * p + t][n] = __builtin_amdgcn_mfma_f32_16x16x32_bf16(ah[i][t], bl[i][n], acc[2 * p + t][n], 0, 0, 0); } }
            LDS_WAIT(); __builtin_amdgcn_s_barrier(); asm volatile("" ::: "memory");
        }
    }
    {
      LAS float* part = (LAS float*)F.lds;
#pragma unroll
      for (int rt = 0; rt < 4; ++rt)
#pragma unroll
          for (int n = 0; n < 2; ++n)
#pragma unroll
              for (int r = 0; r < 4; ++r) part[(w * 64 + rt * 16 + 4 * g4 + r) * 33 + n * 16 + l15] = acc[rt][n][r];
    }
    __syncthreads();
    { LAS float* part = (LAS float*)F.lds; LAS float* lsum = part + 8 * 64 * 33;
      const int row = F.tid >> 3, eb = (F.tid & 7) * 4;
#pragma unroll
      for (int j = 0; j < 4; ++j) { float sacc_ = 0.f;
#pragma unroll
          for (int k = 0; k < 8; ++k) sacc_ += part[(k * 64 + row) * 33 + eb + j];
          lsum[row * 33 + eb + j] = sacc_; } }
    __syncthreads();
    int e0 = 0, e1 = 0, rk0 = 0, rk1 = 0; float w0 = 0.f, w1 = 0.f;
    if (F.tid < 64) { const LAS float* part = (const LAS float*)F.lds; const float* rb = a.in[17];
        float lgt[32]; float mx = -3.0e38f;
#pragma unroll
        for (int e = 0; e < 32; ++e) { lgt[e] = part[(8 * 64 + F.tid) * 33 + e] + rb[e]; mx = fmaxf(mx, lgt[e]); }
        float bs = -1.f; float ba1 = 0.f, ba2 = 0.f; int bi1 = 0, bi2 = 0;
#pragma unroll
        for (int gi = 0; gi < 4; ++gi) { float a1 = -3.0e38f, a2 = -3.0e38f; int i1 = 0, i2 = 0;
#pragma unroll
            for (int j = 0; j < 8; ++j) { const float v = lgt[gi * 8 + j]; if (v > a1) { a2 = a1; i2 = i1; a1 = v; i1 = gi * 8 + j; } else if (v > a2) { a2 = v; i2 = gi * 8 + j; } }
            const float p1 = __expf(a1 - mx), p2 = __expf(a2 - mx), sc = p1 + p2;
            if (sc > bs) { bs = sc; ba1 = p1; ba2 = p2; bi1 = i1; bi2 = i2; } }
        e0 = bi1; e1 = bi2; w0 = ba1 / (ba1 + ba2); w1 = ba2 / (ba1 + ba2);
        rk0 = __hip_atomic_fetch_add(lcnt + e0, 1, __ATOMIC_RELAXED, __HIP_MEMORY_SCOPE_WORKGROUP);
        rk1 = __hip_atomic_fetch_add(lcnt + e1, 1, __ATOMIC_RELAXED, __HIP_MEMORY_SCOPE_WORKGROUP);
    }
    __syncthreads();
    if (F.tid < 32) lbase[F.tid] = (int)__hip_atomic_fetch_add(F.ctl + CW_CNT + (layer * NE + F.tid) * 64, (unsigned)lcnt[F.tid], __ATOMIC_RELAXED, __HIP_MEMORY_SCOPE_AGENT);
    __syncthreads();
    if (F.tid < 64) { const int tok = r0 + F.tid; const int s0 = lbase[e0] + rk0, s1 = lbase[e1] + rk1;
        int* list = (int*)(F.ws + WS_LIST); list[e0 * T + s0] = tok; list[e1 * T + s1] = tok;
        i32x4* ti = (i32x4*)(F.ws + WS_TOK) + (size_t)tok * 2;
        ti[0] = (i32x4){e0, s0, e1, s1}; ti[1] = (i32x4){(int)__float_as_uint(w0), (int)__float_as_uint(w1), 0, 0}; }
    if (F.tid < 64) { f32x2 st; st[0] = sts[F.tid * 2]; st[1] = sts[F.tid * 2 + 1]; *(f32x2*)(stats + (size_t)(r0 + F.tid) * 2) = st; }
    __syncthreads();
}

__device__ __forceinline__ void moe_setup(Frame& F, int layer) {
    LAS int* cnt = (LAS int*)(F.lds + TST_OFF); LAS int* pst = cnt + 32; LAS int* fst = pst + 33; LAS int* hst = fst + 33;
    __syncthreads();
    if (F.tid < 32) cnt[F.tid] = (int)__hip_atomic_load(F.ctl + CW_CNT + (layer * NE + F.tid) * 64, __ATOMIC_RELAXED, __HIP_MEMORY_SCOPE_AGENT);
    __syncthreads();
    if (F.tid < 64) {
        const int e = F.tid; int c = e < NE ? cnt[e & 31] : 0; c = c < 0 ? 0 : (c > T ? T : c); const int t = (c + 127) >> 7, f = t >> 1, hb = t & 1;
        int st = t, sf = f, sh = hb;
#pragma unroll
        for (int o = 1; o < 32; o <<= 1) { const int a = __shfl_up(st, o), b = __shfl_up(sf, o), d = __shfl_up(sh, o); if (e >= o) { st += a; sf += b; sh += d; } }
        if (e < NE) { pst[e] = st - t; fst[e] = sf - f; hst[e] = sh - hb; }
        if (e == NE - 1) { pst[NE] = st; fst[NE] = sf; hst[NE] = sh; } }
    __syncthreads();
}

constexpr int LN2R = 2;
__device__ __forceinline__ void ln2_rows(Frame& F, const LAS float* gl, const int (&toks)[LN2R], float* outf, bf16* outb) {
    const LAS int* pst = (const LAS int*)(F.lds + TST_OFF) + 32;
    i32x4 inf[LN2R][2];
#pragma unroll
    for (int r = 0; r < LN2R; ++r) { const i32x4* ti = (const i32x4*)(F.ws + WS_TOK) + (size_t)toks[r] * 2; inf[r][0] = ti[0]; inf[r][1] = ti[1]; }
    u32x4 xx[LN2R][4]; u32x2 pa[LN2R][4], pb[LN2R][4]; f32x2 stv[LN2R];
#pragma unroll
    for (int r = 0; r < LN2R; ++r) { const int tok = toks[r]; const int e0 = inf[r][0][0] & 31, e1 = inf[r][0][2] & 31;
        const size_t ra = (size_t)pst[e0] * 128 + inf[r][0][1], rb = (size_t)pst[e1] * 128 + inf[r][0][3];
        const bf16* x1 = (const bf16*)(F.ws + WS_Z) + (size_t)tok * DM + 8 * F.lane;
        stv[r] = *(const f32x2*)((const float*)(F.ws + WS_Z + 64 * MiB) + (size_t)tok * 2);
        const unsigned char* ya = F.ws + WS_YB + ra * DM + 8 * F.lane; const unsigned char* yb = F.ws + WS_YB + rb * DM + 8 * F.lane;
#pragma unroll
        for (int j = 0; j < 4; ++j) { xx[r][j] = __builtin_nontemporal_load((const u32x4*)(x1 + 512 * j)); pa[r][j] = __builtin_nontemporal_load((const u32x2*)(ya + 512 * j)); pb[r][j] = __builtin_nontemporal_load((const u32x2*)(yb + 512 * j)); } }
    float wts[LN2R][2];
#pragma unroll
    for (int r = 0; r < LN2R; ++r) { wts[r][0] = __uint_as_float((unsigned)inf[r][1][0]) * 0.0625f; wts[r][1] = __uint_as_float((unsigned)inf[r][1][1]) * 0.0625f; }
#pragma unroll
    for (int r = 0; r < LN2R; ++r) { const int tok = toks[r];
        const float w0 = wts[r][0], w1 = wts[r][1];
        float v[4][8]; float s = 0.f;
        const float m1 = stv[r][0], r1 = stv[r][1];
        unsigned g1o_ = (unsigned)(8 * F.lane); asm volatile("" : "+v"(g1o_));
#pragma unroll
        for (int j = 0; j < 4; ++j) { const u32x4 x = xx[r][j]; const u32x2 p = pa[r][j], q = pb[r][j];
            const f32x4 ga = *(const LAS f32x4*)(gl + 2 * DM + g1o_ + 512 * j), gb = *(const LAS f32x4*)(gl + 2 * DM + g1o_ + 512 * j + 4), ba = *(const LAS f32x4*)(gl + 3 * DM + g1o_ + 512 * j), bb = *(const LAS f32x4*)(gl + 3 * DM + g1o_ + 512 * j + 4);
            float x1v[8];
            x1v[0] = (bflo(x.x) - m1) * r1 * ga[0] + ba[0]; x1v[1] = (bfhi(x.x) - m1) * r1 * ga[1] + ba[1]; x1v[2] = (bflo(x.y) - m1) * r1 * ga[2] + ba[2]; x1v[3] = (bfhi(x.y) - m1) * r1 * ga[3] + ba[3];
            x1v[4] = (bflo(x.z) - m1) * r1 * gb[0] + bb[0]; x1v[5] = (bfhi(x.z) - m1) * r1 * gb[1] + bb[1]; x1v[6] = (bflo(x.w) - m1) * r1 * gb[2] + bb[2]; x1v[7] = (bfhi(x.w) - m1) * r1 * gb[3] + bb[3];
            const f32x2 p0 = __builtin_amdgcn_cvt_pk_f32_fp8((int)p.x, false), p1 = __builtin_amdgcn_cvt_pk_f32_fp8((int)p.x, true), p2 = __builtin_amdgcn_cvt_pk_f32_fp8((int)p.y, false), p3 = __builtin_amdgcn_cvt_pk_f32_fp8((int)p.y, true);
            const f32x2 q0 = __builtin_amdgcn_cvt_pk_f32_fp8((int)q.x, false), q1 = __builtin_amdgcn_cvt_pk_f32_fp8((int)q.x, true), q2 = __builtin_amdgcn_cvt_pk_f32_fp8((int)q.y, false), q3 = __builtin_amdgcn_cvt_pk_f32_fp8((int)q.y, true);
            v[j][0] = ALPHA * x1v[0] + w0 * p0[0] + w1 * q0[0]; v[j][1] = ALPHA * x1v[1] + w0 * p0[1] + w1 * q0[1];
            v[j][2] = ALPHA * x1v[2] + w0 * p1[0] + w1 * q1[0]; v[j][3] = ALPHA * x1v[3] + w0 * p1[1] + w1 * q1[1];
            v[j][4] = ALPHA * x1v[4] + w0 * p2[0] + w1 * q2[0]; v[j][5] = ALPHA * x1v[5] + w0 * p2[1] + w1 * q2[1];
            v[j][6] = ALPHA * x1v[6] + w0 * p3[0] + w1 * q3[0]; v[j][7] = ALPHA * x1v[7] + w0 * p3[1] + w1 * q3[1];
#pragma unroll
            for (int t = 0; t < 8; ++t) s += v[j][t]; }
        const float mean = wave_sum(s) * (1.0f / DM); float s2 = 0.f;
#pragma unroll
        for (int j = 0; j < 4; ++j)
#pragma unroll
            for (int t = 0; t < 8; ++t) { v[j][t] -= mean; s2 += v[j][t] * v[j][t]; }
        const float rstd = 1.0f / sqrtf(wave_sum(s2) * (1.0f / DM) + LN_EPS);
        unsigned go_ = (unsigned)(8 * F.lane); asm volatile("" : "+v"(go_));
#pragma unroll
        for (int j = 0; j < 4; ++j) { const f32x4 g0 = *(const LAS f32x4*)(gl + go_ + 512 * j), g1 = *(const LAS f32x4*)(gl + go_ + 512 * j + 4), b0 = *(const LAS f32x4*)(gl + DM + go_ + 512 * j), b1 = *(const LAS f32x4*)(gl + DM + go_ + 512 * j + 4);
            f32x4 o0, o1;
#pragma unroll
            for (int t = 0; t < 4; ++t) { o0[t] = v[j][t] * rstd * g0[t] + b0[t]; o1[t] = v[j][4 + t] * rstd * g1[t] + b1[t]; }
            if (outf) { float* op = outf + (size_t)tok * DM + 8 * F.lane + 512 * j; __builtin_nontemporal_store(o0, (f32x4*)op); __builtin_nontemporal_store(o1, (f32x4*)(op + 4)); }
            if (outb) { u32x4 pk; pk.x = cvt_pk_bf16(o0[0], o0[1]); pk.y = cvt_pk_bf16(o0[2], o0[3]); pk.z = cvt_pk_bf16(o1[0], o1[1]); pk.w = cvt_pk_bf16(o1[2], o1[3]);
                __builtin_nontemporal_store(pk, (u32x4*)(outb + (size_t)tok * DM + 8 * F.lane + 512 * j));
                u32x2 p8; p8.x = cvt4_fp8(o0[0], o0[1], o0[2], o0[3]); p8.y = cvt4_fp8(o1[0], o1[1], o1[2], o1[3]); *(u32x2*)(F.ws + WS_XB8 + (size_t)tok * DM + 8 * F.lane + 512 * j) = p8; } }
    }
}

__global__ void __launch_bounds__(NWAVES * 64, 2) mk_fwd(Args args) {
    extern __shared__ __attribute__((aligned(16))) unsigned char lds_raw[];
    Frame F;
    F.lds = (LAS unsigned char*)lds_raw;
    F.tid = threadIdx.x; F.lane = F.tid & 63; F.wave = __builtin_amdgcn_readfirstlane(F.tid >> 6);
    F.G = gridDim.x; { const int bx = blockIdx.x; F.vcu = (F.G % 8 == 0) ? (bx % 8) * (F.G / 8) + bx / 8 : bx; }
    F.ws = args.ws; F.ctl = (unsigned*)(args.ws + WS_CTL);
    volatile LAS unsigned* MISC = (volatile LAS unsigned*)(F.lds + MISC_OFF);
    if (F.tid < 4) MISC[F.tid] = 0u;
    __syncthreads();
    XcdBarrier bar; bar.bar = F.ctl + CW_BAR; bar.x = 0; bar.st = MISC;
    if (MK_N_LAUNCHES == 1) bar = xcd_barrier_post(F.ctl + CW_BAR, MISC);
    const int lo = args.ph_lo, hi = args.ph_hi;
#ifndef ONLY_PHASE
#define ONLY_PHASE -1
#endif
#define PON(k) (ONLY_PHASE < 0 || ONLY_PHASE == (k))
#ifndef PROBE_PHASE
#define PROBE_PHASE -1
#endif
#define RPT(k) ((PROBE_PHASE == (k)) ? 2 : 1)
#define IN(k) (lo <= (k) && (k) < hi)
#define PHASE_FRAME Frame P = F; { size_t z_ = 0; asm volatile("" : "+s"(z_)); P.ws = F.ws + z_; P.wave = F.wave + (int)z_; } P.lane = (int)__builtin_amdgcn_mbcnt_hi(~0u, __builtin_amdgcn_mbcnt_lo(~0u, 0u)); asm volatile("" : "+v"(P.lane)); P.tid = P.wave * 64 + P.lane; P.ctl = (unsigned*)(P.ws + WS_CTL)
#define SEAM(k) do { if (IN(k) && IN((k) + 1)) xcd_barrier(bar); } while (0)

    if (PON(0) && IN(0)) { PHASE_FRAME; p0_prologue(P, args); __syncthreads(); }
    if (PROBE_PHASE == 0 && PON(0) && IN(0)) { PHASE_FRAME; p0_prologue(P, args); __syncthreads(); }
    SEAM(0);

    for (int layer = 0; layer < 2; ++layer) {
        const int pb = 1 + 9 * layer;
#define MIXCONV() do { const int c_ = P.vcu & 1, ng_ = (P.G >> 1) * NWAVES, g0_ = (P.vcu >> 1) * NWAVES + P.wave; \
            convert_items(P, args, TI_IN / 2 + c_ * (TI_IN / 4), TI_IN / 4, g0_, ng_); \
            convert_items(P, args, TI_IN + c_ * (TI_OUT / 2), TI_OUT / 2, (g0_ + ng_ - (TI_IN / 8) % ng_) % ng_, ng_); \
            convert_items(P, args, TI_IN + TI_OUT + c_ * (TI_GLU / 2), TI_GLU / 2, (g0_ + 2 * ng_ - (TI_IN / 8 + TI_OUT / 4) % ng_) % ng_, ng_); } while (0)
        if (PON(1) && IN(pb + 0)) for (int rp_ = 0; rp_ < RPT(1); ++rp_) {
            PHASE_FRAME;
            bf16* XB = (bf16*)(P.ws + WS_XB); float* XF = (float*)(P.ws + WS_XF);
            bf16* Qb = (bf16*)(P.ws + WS_Q); bf16* Kb = (bf16*)(P.ws + WS_K); bf16* Gb = (bf16*)(P.ws + WS_G); bf16* VT = (bf16*)(P.ws + WS_VT);
            bf16* U2 = (bf16*)(P.ws + WS_U2); bf16* Yb = (bf16*)(P.ws + WS_Y); bf16* MIX = (bf16*)(P.ws + WS_MIX); float* Z = (float*)(P.ws + WS_Z);
            bf16* X1B = (bf16*)(P.ws + WS_X1B); bf16* Hb = (bf16*)(P.ws + WS_H); bf16* YB = (bf16*)(P.ws + WS_YB);
            const bf16* Win = (const bf16*)(P.ws + WS_WIN) + (size_t)layer * NPROJ * DM;
            (void)XB; (void)XF; (void)Qb; (void)Kb; (void)Gb; (void)VT; (void)U2; (void)Yb; (void)MIX; (void)Z; (void)X1B; (void)Hb; (void)YB; (void)Win;
            { pg8::DenseOrder S; S.init(T, 4096, DM, P.G, (int)blockIdx.x, P.ws + WS_WIN + (size_t)layer * NPROJ * DM, 1);
              pg8::EpiInProj E{Qb, Kb, Gb, U2, (const float*)(P.ws + WS_COS), (const float*)(P.ws + WS_SIN)};
              if (layer == 0 && (P.vcu & 1) != 0) { MIXCONV(); __syncthreads(); }
              S.ulist = (const LAS int*)(P.lds + TST_OFF + 896); __syncthreads(); pg8::moe_units(S, (LAS int*)(P.lds + TST_OFF + 896), P.tid); __syncthreads();
              pg8::gemm_phase<true>(P.lds, P.tid, (const char*)(P.ws + WS_XB8), DM, S, E); }
            { pg8::DenseOrder S; S.init(1024, T, DM, P.G, (int)blockIdx.x, P.ws + WS_XB8, 1);
              pg8::EpiBf16 E{VT, T, W8_INV};
              S.ulist = (const LAS int*)(P.lds + TST_OFF + 896); __syncthreads(); pg8::moe_units(S, (LAS int*)(P.lds + TST_OFF + 896), P.tid); __syncthreads();
              pg8::gemm_phase<true>(P.lds, P.tid, (const char*)(P.ws + WS_WIN + ((size_t)layer * NPROJ + 4096) * DM), DM, S, E); }
            if (layer == 0 && (P.vcu & 1) == 0) { __syncthreads(); MIXCONV(); }
        }
        SEAM(pb + 0);

        if (PON(2) && IN(pb + 1)) for (int rp_ = 0; rp_ < RPT(2); ++rp_) {
            PHASE_FRAME;
            bf16* XB = (bf16*)(P.ws + WS_XB); float* XF = (float*)(P.ws + WS_XF);
            bf16* Qb = (bf16*)(P.ws + WS_Q); bf16* Kb = (bf16*)(P.ws + WS_K); bf16* Gb = (bf16*)(P.ws + WS_G); bf16* VT = (bf16*)(P.ws + WS_VT);
            bf16* U2 = (bf16*)(P.ws + WS_U2); bf16* Yb = (bf16*)(P.ws + WS_Y); bf16* MIX = (bf16*)(P.ws + WS_MIX); float* Z = (float*)(P.ws + WS_Z);
            bf16* X1B = (bf16*)(P.ws + WS_X1B); bf16* Hb = (bf16*)(P.ws + WS_H); bf16* YB = (bf16*)(P.ws + WS_YB);
            const bf16* Win = (const bf16*)(P.ws + WS_WIN) + (size_t)layer * NPROJ * DM;
            (void)XB; (void)XF; (void)Qb; (void)Kb; (void)Gb; (void)VT; (void)U2; (void)Yb; (void)MIX; (void)Z; (void)X1B; (void)Hb; (void)YB; (void)Win;
            const int cpos = P.vcu & 3, ufirst4 = TI_MOE0 + TI_G + layer * (TI_U / 2) + cpos * (TI_U / 8), cgw4 = (P.vcu >> 2) * NWAVES + P.wave, cngw4 = (P.G >> 2) * NWAVES;
            for (int rq_ = 0; rq_ < (PROBE_PHASE == 21 ? 2 : 1); ++rq_)
            for (int u = P.vcu; u < 256; u += P.G) { const int bh = u >> 3, p = u & 7, b = bh >> 2, h = bh & 3;
                if (cpos == 0) { convert_items(P, args, ufirst4, TI_U / 8, cgw4, cngw4); __syncthreads(); }
                retention_qtile(P, Qb, Kb, VT, Gb, P.ws + WS_MIX8, b, h, 15 - p); __syncthreads();
                if (cpos == 1) { convert_items(P, args, ufirst4, TI_U / 8, cgw4, cngw4); __syncthreads(); }
                retention_qtile(P, Qb, Kb, VT, Gb, P.ws + WS_MIX8, b, h, p); __syncthreads();
                if (cpos == 2) { convert_items(P, args, ufirst4, TI_U / 8, cgw4, cngw4); __syncthreads(); } }
            for (int rq_ = 0; rq_ < (PROBE_PHASE == 22 ? 2 : 1); ++rq_)
            for (int u2 = P.vcu * 2; u2 < 512; u2 += 2 * P.G) { const int g = u2 >> 3, b0 = u2 & 7;
                s5in_pair(P, U2, (const bf16*)(P.ws + WS_S5IN) + ((size_t)layer * SGRP + g) * (128 * 256), (const float*)(P.ws + WS_S5A) + ((size_t)layer * SGRP + g) * SST * 2, g, b0); }
            if (cpos == 3) { __syncthreads(); convert_items(P, args, ufirst4, TI_U / 8, cgw4, cngw4); __syncthreads(); }
        }
        if (F.G == 256) { if (IN(pb + 1) && IN(pb + 2)) { VM_WAIT(); __syncthreads(); } } else SEAM(pb + 1);

        if (PON(3) && IN(pb + 2)) for (int rp_ = 0; rp_ < RPT(3); ++rp_) {
            PHASE_FRAME;
            bf16* XB = (bf16*)(P.ws + WS_XB); float* XF = (float*)(P.ws + WS_XF);
            bf16* Qb = (bf16*)(P.ws + WS_Q); bf16* Kb = (bf16*)(P.ws + WS_K); bf16* Gb = (bf16*)(P.ws + WS_G); bf16* VT = (bf16*)(P.ws + WS_VT);
            bf16* U2 = (bf16*)(P.ws + WS_U2); bf16* Yb = (bf16*)(P.ws + WS_Y); bf16* MIX = (bf16*)(P.ws + WS_MIX); float* Z = (float*)(P.ws + WS_Z);
            bf16* X1B = (bf16*)(P.ws + WS_X1B); bf16* Hb = (bf16*)(P.ws + WS_H); bf16* YB = (bf16*)(P.ws + WS_YB);
            const bf16* Win = (const bf16*)(P.ws + WS_WIN) + (size_t)layer * NPROJ * DM;
            (void)XB; (void)XF; (void)Qb; (void)Kb; (void)Gb; (void)VT; (void)U2; (void)Yb; (void)MIX; (void)Z; (void)X1B; (void)Hb; (void)YB; (void)Win;
            pg8::S5Order S; S.G = P.G; S.c = P.vcu; S.Bt = (const char*)((const bf16*)(P.ws + WS_S5OUT) + (size_t)layer * SGRP * 256 * KS5);
            pg8::EpiS5Out E{Yb, P.ws + WS_Y8};
            int k5 = KS5; asm volatile("" : "+s"(k5));
            S.ulist = (const LAS int*)(P.lds + TST_OFF + 896); __syncthreads(); pg8::moe_units(S, (LAS int*)(P.lds + TST_OFF + 896), P.tid); __syncthreads();
            pg8::gemm_phase<false>(P.lds, P.tid, (const char*)U2, k5, S, E);
        }
        SEAM(pb + 2);

        if (PON(4) && IN(pb + 3)) for (int rp_ = 0; rp_ < RPT(4); ++rp_) {
            PHASE_FRAME;
            bf16* XB = (bf16*)(P.ws + WS_XB); float* XF = (float*)(P.ws + WS_XF);
            bf16* Qb = (bf16*)(P.ws + WS_Q); bf16* Kb = (bf16*)(P.ws + WS_K); bf16* Gb = (bf16*)(P.ws + WS_G); bf16* VT = (bf16*)(P.ws + WS_VT);
            bf16* U2 = (bf16*)(P.ws + WS_U2); bf16* Yb = (bf16*)(P.ws + WS_Y); bf16* MIX = (bf16*)(P.ws + WS_MIX); float* Z = (float*)(P.ws + WS_Z);
            bf16* X1B = (bf16*)(P.ws + WS_X1B); bf16* Hb = (bf16*)(P.ws + WS_H); bf16* YB = (bf16*)(P.ws + WS_YB);
            const bf16* Win = (const bf16*)(P.ws + WS_WIN) + (size_t)layer * NPROJ * DM;
            (void)XB; (void)XF; (void)Qb; (void)Kb; (void)Gb; (void)VT; (void)U2; (void)Yb; (void)MIX; (void)Z; (void)X1B; (void)Hb; (void)YB; (void)Win;
            pg8::GluOrder S; S.init(T, 1024, 1024, P.G, (int)blockIdx.x, P.ws + WS_WGLU + (size_t)layer * 1024 * 1024, 1); S.rowbytes = 16;
            pg8::EpiGlu E{Yb, P.ws + WS_MIX8};
            S.ulist = (const LAS int*)(P.lds + TST_OFF + 896); __syncthreads(); pg8::moe_units(S, (LAS int*)(P.lds + TST_OFF + 896), P.tid); __syncthreads();
            pg8::gemm_phase<true>(P.lds, P.tid, (const char*)(P.ws + WS_Y8), 1024, S, E);
        }
        SEAM(pb + 3);

        if (PON(5) && IN(pb + 4)) for (int rp_ = 0; rp_ < RPT(5); ++rp_) {
            PHASE_FRAME;
            bf16* XB = (bf16*)(P.ws + WS_XB); float* XF = (float*)(P.ws + WS_XF);
            bf16* Qb = (bf16*)(P.ws + WS_Q); bf16* Kb = (bf16*)(P.ws + WS_K); bf16* Gb = (bf16*)(P.ws + WS_G); bf16* VT = (bf16*)(P.ws + WS_VT);
            bf16* U2 = (bf16*)(P.ws + WS_U2); bf16* Yb = (bf16*)(P.ws + WS_Y); bf16* MIX = (bf16*)(P.ws + WS_MIX); float* Z = (float*)(P.ws + WS_Z);
            bf16* X1B = (bf16*)(P.ws + WS_X1B); bf16* Hb = (bf16*)(P.ws + WS_H); bf16* YB = (bf16*)(P.ws + WS_YB);
            const bf16* Win = (const bf16*)(P.ws + WS_WIN) + (size_t)layer * NPROJ * DM;
            (void)XB; (void)XF; (void)Qb; (void)Kb; (void)Gb; (void)VT; (void)U2; (void)Yb; (void)MIX; (void)Z; (void)X1B; (void)Hb; (void)YB; (void)Win;
            pg8::DenseOrder S; S.init(T, DM, DM, P.G, (int)blockIdx.x, P.ws + WS_WOUT + (size_t)layer * DM * DM, 1);

            constexpr int GC0 = 5462, GC1 = 5462, GC2 = TI_G / 2 - GC0 - GC1;
            const int gcls = P.vcu % 3, gfirst = TI_MOE0 + layer * (TI_G / 2) + (gcls == 0 ? 0 : (gcls == 1 ? GC0 : GC0 + GC1)), gcount = gcls == 0 ? GC0 : (gcls == 1 ? GC1 : GC2);
            const int cgw = (P.vcu / 3) * NWAVES + P.wave, cngw = ((P.G - gcls + 2) / 3) * NWAVES;
            if (gcls == 0) convert_items(P, args, gfirst, gcount, cgw, cngw);
            S.ulist = (const LAS int*)(P.lds + TST_OFF + 896); __syncthreads(); pg8::moe_units(S, (LAS int*)(P.lds + TST_OFF + 896), P.tid); __syncthreads();
            const ConvHook H{&P, &args, gfirst, gcount, cgw, cngw, gcls == 1 ? 0 : -1};
            if (layer == 0) { pg8::EpiResid<true> E{(const void*)args.in[0], (bf16*)Z}; pg8::gemm_phase<true>(P.lds, P.tid, (const char*)(P.ws + WS_MIX8), DM, S, E, H); }
            else { pg8::EpiResid<false> E{(const void*)XB, (bf16*)Z}; pg8::gemm_phase<true>(P.lds, P.tid, (const char*)(P.ws + WS_MIX8), DM, S, E, H); }
            if (gcls == 2) convert_items(P, args, gfirst, gcount, cgw, cngw);
        }
        SEAM(pb + 4);

        if (PON(6) && IN(pb + 5)) for (int rp_ = 0; rp_ < RPT(6); ++rp_) {
            PHASE_FRAME;
            bf16* XB = (bf16*)(P.ws + WS_XB); float* XF = (float*)(P.ws + WS_XF);
            bf16* Qb = (bf16*)(P.ws + WS_Q); bf16* Kb = (bf16*)(P.ws + WS_K); bf16* Gb = (bf16*)(P.ws + WS_G); bf16* VT = (bf16*)(P.ws + WS_VT);
            bf16* U2 = (bf16*)(P.ws + WS_U2); bf16* Yb = (bf16*)(P.ws + WS_Y); bf16* MIX = (bf16*)(P.ws + WS_MIX); float* Z = (float*)(P.ws + WS_Z);
            bf16* X1B = (bf16*)(P.ws + WS_X1B); bf16* Hb = (bf16*)(P.ws + WS_H); bf16* YB = (bf16*)(P.ws + WS_YB);
            const bf16* Win = (const bf16*)(P.ws + WS_WIN) + (size_t)layer * NPROJ * DM;
            (void)XB; (void)XF; (void)Qb; (void)Kb; (void)Gb; (void)VT; (void)U2; (void)Yb; (void)MIX; (void)Z; (void)X1B; (void)Hb; (void)YB; (void)Win;
            for (int u = P.vcu; u < T / 64; u += P.G) ln1_router_unit(P, args, layer, u);

        }
        SEAM(pb + 5);

        if (PON(7) && IN(pb + 6)) for (int rp_ = 0; rp_ < RPT(7); ++rp_) {
            PHASE_FRAME;
            bf16* XB = (bf16*)(P.ws + WS_XB); float* XF = (float*)(P.ws + WS_XF);
            bf16* Qb = (bf16*)(P.ws + WS_Q); bf16* Kb = (bf16*)(P.ws + WS_K); bf16* Gb = (bf16*)(P.ws + WS_G); bf16* VT = (bf16*)(P.ws + WS_VT);
            bf16* U2 = (bf16*)(P.ws + WS_U2); bf16* Yb = (bf16*)(P.ws + WS_Y); bf16* MIX = (bf16*)(P.ws + WS_MIX); float* Z = (float*)(P.ws + WS_Z);
            bf16* X1B = (bf16*)(P.ws + WS_X1B); bf16* Hb = (bf16*)(P.ws + WS_H); bf16* YB = (bf16*)(P.ws + WS_YB);
            const bf16* Win = (const bf16*)(P.ws + WS_WIN) + (size_t)layer * NPROJ * DM;
            (void)XB; (void)XF; (void)Qb; (void)Kb; (void)Gb; (void)VT; (void)U2; (void)Yb; (void)MIX; (void)Z; (void)X1B; (void)Hb; (void)YB; (void)Win;
            moe_setup(P, layer);
            const LAS int* cnt = (const LAS int*)(P.lds + TST_OFF); const LAS int* pst = cnt + 32; const LAS int* fst = pst + 33; const LAS int* hst = fst + 33;
            LAS unsigned* table = (LAS unsigned*)(P.lds + TAB_OFF);
            pg8::MoeOrder<true> S; S.NF = fst[NE] * 8; S.NU = S.NF + hst[NE] * 8; S.G = P.G; S.c = P.vcu; S.pst = pst; S.fst = fst; S.hst = hst; S.table = table; S.rowbytes = 0;
            S.Bt = (const char*)(P.ws + WS_WGU) + (size_t)layer * NE * 2048 * DM; S.estepB = (size_t)2048 * DM; S.tstepB = (size_t)256 * DM;
            S.ulist = (const LAS int*)(P.lds + TST_OFF + 896); pg8::moe_units(S, (LAS int*)(P.lds + TST_OFF + 896), P.tid); __syncthreads();
            { const int* list = (const int*)(P.ws + WS_LIST); int tk[8]; bool okk[8];
#pragma unroll
              for (int i = 0; i < 8; ++i) { pg8::Unit u; okk[i] = S.next(i, u) && (P.tid < 256); int tok = 0;
                  if (okk[i]) { const int e = u.e & 255; const int slot = (u.pm - pst[e] * 128) + P.tid; if (slot < cnt[e]) tok = list[e * T + slot]; }
                  tk[i] = tok; }
#pragma unroll
              for (int i = 0; i < 8; ++i) if (okk[i]) { int tok = tk[i]; tok = tok < 0 ? 0 : (tok >= T ? T - 1 : tok); table[i * 256 + P.tid] = (unsigned)tok * (unsigned)DM; } }
            __syncthreads();
            const int dcls = P.vcu & 3, dk = P.vcu >> 2, nclass = P.G >> 2;
            int dfirst = TI_MOE0 + 2 * TI_G + layer * (TI_D / 2) + dcls * (TI_D / 8), dcount = TI_D / 8, dgw = dk * NWAVES + P.wave, dngw = nclass * NWAVES;
            { const int ntall = S.NU - 4 * P.G; int nt = ntall > dcls ? (ntall - dcls + 3) >> 2 : 0; nt = nt > nclass ? nclass : nt;
              const int wtot = 3 * nt + 5 * (nclass - nt), c0 = 3 * (dk < nt ? dk : nt) + 5 * (dk > nt ? dk - nt : 0), c1 = c0 + (dk < nt ? 3 : 5);
              const int npc = TI_D / 16;
              const int p0 = (int)(((long)npc * c0) / wtot), p1 = (int)(((long)npc * c1) / wtot);
              dfirst += 2 * p0; dcount = 2 * (p1 - p0); dgw = P.wave; dngw = NWAVES; }
            pg8::EpiGateUp E{(unsigned char*)Hb};
            if (dcls == 0) convert_items(P, args, dfirst, dcount, dgw, dngw);
            { const ConvHook H{&P, &args, dfirst, dcount, dgw, dngw, dcls == 1 ? 0 : (dcls == 2 ? 2 : -1)};
              pg8::gemm_phase<true>(P.lds, P.tid, (const char*)(P.ws + WS_XF), DM, S, E, H); }
            if (dcls == 3) convert_items(P, args, dfirst, dcount, dgw, dngw);
        }
        SEAM(pb + 6);

        if (PON(8) && IN(pb + 7)) for (int rp_ = 0; rp_ < RPT(8); ++rp_) {
            PHASE_FRAME;
            bf16* XB = (bf16*)(P.ws + WS_XB); float* XF = (float*)(P.ws + WS_XF);
            bf16* Qb = (bf16*)(P.ws + WS_Q); bf16* Kb = (bf16*)(P.ws + WS_K); bf16* Gb = (bf16*)(P.ws + WS_G); bf16* VT = (bf16*)(P.ws + WS_VT);
            bf16* U2 = (bf16*)(P.ws + WS_U2); bf16* Yb = (bf16*)(P.ws + WS_Y); bf16* MIX = (bf16*)(P.ws + WS_MIX); float* Z = (float*)(P.ws + WS_Z);
            bf16* X1B = (bf16*)(P.ws + WS_X1B); bf16* Hb = (bf16*)(P.ws + WS_H); bf16* YB = (bf16*)(P.ws + WS_YB);
            const bf16* Win = (const bf16*)(P.ws + WS_WIN) + (size_t)layer * NPROJ * DM;
            (void)XB; (void)XF; (void)Qb; (void)Kb; (void)Gb; (void)VT; (void)U2; (void)Yb; (void)MIX; (void)Z; (void)X1B; (void)Hb; (void)YB; (void)Win;
            moe_setup(P, layer);
            const LAS int* pst = (const LAS int*)(P.lds + TST_OFF) + 32; const LAS int* fst = pst + 33; const LAS int* hst = fst + 33;
            pg8::MoeOrder<false> S; S.NF = fst[NE] * 8; S.NU = S.NF + hst[NE] * 8; S.G = P.G; S.c = P.vcu; S.pst = pst; S.fst = fst; S.hst = hst; S.table = (const LAS unsigned*)(P.lds + TAB_OFF); S.rowbytes = DE;
            S.ulist = (const LAS int*)(P.lds + TST_OFF + 896);
            S.Bt = (const char*)(P.ws + WS_WDN) + (size_t)layer * NE * DM * DE; S.estepB = (size_t)DM * DE; S.tstepB = (size_t)256 * DE;
            pg8::moe_units(S, (LAS int*)(P.lds + TST_OFF + 896), P.tid); __syncthreads();
            pg8::EpiF8 E{(unsigned char*)YB, DM, W8_INV * 16.0f};
            pg8::gemm_phase<true>(P.lds, P.tid, (const char*)Hb, DE, S, E);
        }
        SEAM(pb + 7);

        if (PON(9) && IN(pb + 8)) for (int rp_ = 0; rp_ < RPT(9); ++rp_) {
            PHASE_FRAME;
            bf16* XB = (bf16*)(P.ws + WS_XB); float* XF = (float*)(P.ws + WS_XF);
            bf16* Qb = (bf16*)(P.ws + WS_Q); bf16* Kb = (bf16*)(P.ws + WS_K); bf16* Gb = (bf16*)(P.ws + WS_G); bf16* VT = (bf16*)(P.ws + WS_VT);
            bf16* U2 = (bf16*)(P.ws + WS_U2); bf16* Yb = (bf16*)(P.ws + WS_Y); bf16* MIX = (bf16*)(P.ws + WS_MIX); float* Z = (float*)(P.ws + WS_Z);
            bf16* X1B = (bf16*)(P.ws + WS_X1B); bf16* Hb = (bf16*)(P.ws + WS_H); bf16* YB = (bf16*)(P.ws + WS_YB);
            const bf16* Win = (const bf16*)(P.ws + WS_WIN) + (size_t)layer * NPROJ * DM;
            (void)XB; (void)XF; (void)Qb; (void)Kb; (void)Gb; (void)VT; (void)U2; (void)Yb; (void)MIX; (void)Z; (void)X1B; (void)Hb; (void)YB; (void)Win;
            moe_setup(P, layer);
            float* outf = layer == 1 ? args.out : (float*)nullptr; bf16* outb = layer == 1 ? (bf16*)nullptr : XB;
            { LAS float* gl = (LAS float*)P.lds;
              { const f32x4 g = *(const f32x4*)(args.in[14] + layer * DM + 4 * P.tid), b = *(const f32x4*)(args.in[15] + layer * DM + 4 * P.tid); *(LAS f32x4*)(gl + 4 * P.tid) = g; *(LAS f32x4*)(gl + DM + 4 * P.tid) = b;
                const f32x4 g1 = *(const f32x4*)(args.in[12] + layer * DM + 4 * P.tid), b1 = *(const f32x4*)(args.in[13] + layer * DM + 4 * P.tid); *(LAS f32x4*)(gl + 2 * DM + 4 * P.tid) = g1; *(LAS f32x4*)(gl + 3 * DM + 4 * P.tid) = b1; }
              __syncthreads();
              const int step = P.G * NWAVES; const int tok0 = P.vcu * NWAVES + P.wave;
#pragma nounroll
              for (int tok = tok0; tok < T; tok += LN2R * step) { int toks[LN2R];
#pragma unroll
                  for (int r = 0; r < LN2R; ++r) toks[r] = (tok + r * step < T) ? tok + r * step : tok;
                  ln2_rows(P, gl, toks, outf, outb); } }
        }
        if (layer == 0) SEAM(pb + 8);
    }
#undef IN
#undef SEAM
}

extern "C" void kernel_launch(void* const* d_in, const int* in_sizes, int n_in, void* d_out, int out_size, void* d_ws, size_t ws_size, hipStream_t stream) {
    static int grid = 0;
    if (grid == 0) {
        if (n_in != 21 || out_size != T * DM || ws_size < WS_END) { fprintf(stderr, "kernel_launch: unexpected problem (n_in %d, out %d, ws %zu; need ws >= %zu)\n", n_in, out_size, ws_size, (size_t)WS_END); grid = -1; return; }
        int dev = 0, cus = 0, per_cu = 0;
        if (hipGetDevice(&dev) != hipSuccess || hipDeviceGetAttribute(&cus, hipDeviceAttributeMultiprocessorCount, dev) != hipSuccess) { grid = -1; return; }
        if (hipFuncSetAttribute((const void*)mk_fwd, hipFuncAttributeMaxDynamicSharedMemorySize, LDS_BYTES) != hipSuccess) { fprintf(stderr, "kernel_launch: hipFuncSetAttribute failed\n"); grid = -1; return; }
        if (hipOccupancyMaxActiveBlocksPerMultiprocessor(&per_cu, (const void*)mk_fwd, NWAVES * 64, LDS_BYTES) != hipSuccess || per_cu < 1) fprintf(stderr, "kernel_launch: occupancy query reports %d\n", per_cu);
        (void)hipGetLastError();
        grid = cus;
    }
    if (grid < 0) return;
    (void)hipMemsetAsync((char*)d_ws + WS_CTL, 0, CTL_ZERO_BYTES, stream);
    Args a{};
    for (int i = 0; i < 21; ++i) a.in[i] = (const float*)d_in[i];
    a.out = (float*)d_out; a.ws = (unsigned char*)d_ws;
#if MK_N_LAUNCHES == 1
    a.ph_lo = 0; a.ph_hi = NPH;
    hipLaunchKernelGGL(mk_fwd, dim3(grid), dim3(NWAVES * 64), LDS_BYTES, stream, a);
#else
    for (int p = 0; p < NPH; ++p) { a.ph_lo = p; a.ph_hi = p + 1; hipLaunchKernelGGL(mk_fwd, dim3(grid), dim3(NWAVES * 64), LDS_BYTES, stream, a); }
#endif
}
```

```cpp
#include <hip/hip_runtime.h>
#include <cstdio>
#include <cstdint>

#ifndef PG8_ALIGN_EPI
#define PG8_ALIGN_EPI 1
#endif
#ifndef PROBE_EPI
#define PROBE_EPI 0
#endif
#ifndef MK_N_LAUNCHES
#define MK_N_LAUNCHES 1
#endif

#define LAS __attribute__((address_space(3)))
#define GAS __attribute__((address_space(1)))
typedef unsigned short bf16;
typedef short bf16x8 __attribute__((ext_vector_type(8)));
typedef float f32x4 __attribute__((ext_vector_type(4)));
typedef float f32x2 __attribute__((ext_vector_type(2)));
typedef unsigned u32x4 __attribute__((ext_vector_type(4)));
typedef unsigned u32x2 __attribute__((ext_vector_type(2)));
typedef int i32x4 __attribute__((ext_vector_type(4)));
typedef int i32x8 __attribute__((ext_vector_type(8)));

constexpr int BATCH = 8, SEQ = 2048, DM = 2048, T = BATCH * SEQ;
constexpr int RW = 1024, HD = 256, NPROJ = 5120;
constexpr int NE = 32, DE = 1024;
constexpr int SGRP = 64, SCH = 16, SST = 64, CS = 16, NCHUNK = SEQ / CS;
constexpr int KS5 = 384;
constexpr float LN_EPS = 1e-5f;
constexpr float ALPHA = 1.41421356237309515f;
constexpr int NPH = 19;

constexpr size_t MiB = 1u << 20;
constexpr size_t WS_CTL = 0, CTL_ZERO_BYTES = 128 * 1024;
constexpr size_t WS_WIN = 1 * MiB;
constexpr size_t WS_WOUT = WS_WIN + 40 * MiB;
constexpr size_t WS_WGLU = WS_WOUT + 16 * MiB;
constexpr size_t WS_WGU = WS_WGLU + 4 * MiB;
constexpr size_t WS_WDN = WS_WGU + 512 * MiB;
constexpr size_t WS_S5OUT = WS_WDN + 256 * MiB;
constexpr size_t WS_S5IN = WS_S5OUT + 24 * MiB;
constexpr size_t WS_S5A = WS_S5IN + 8 * MiB;
constexpr size_t WS_COS = WS_S5A + 1 * MiB;
constexpr size_t WS_SIN = WS_COS + 1 * MiB;
constexpr size_t WS_RWT = WS_SIN + 1 * MiB;
constexpr size_t WS_XB = WS_RWT + 1 * MiB;
constexpr size_t WS_XF = WS_XB + 64 * MiB;
constexpr size_t WS_Y8 = WS_XF + 32 * MiB;
constexpr size_t WS_MIX8 = WS_XF + 64 * MiB;
constexpr size_t WS_XB8 = WS_XF + 96 * MiB;
constexpr size_t WS_Q = WS_XF + 128 * MiB;
constexpr size_t WS_K = WS_Q + 32 * MiB;
constexpr size_t WS_G = WS_K + 32 * MiB;
constexpr size_t WS_VT = WS_G + 32 * MiB;
constexpr size_t WS_U2 = WS_VT + 32 * MiB;
constexpr size_t WS_Y = WS_U2 + 48 * MiB;
constexpr size_t WS_MIX = WS_Y + 32 * MiB;
constexpr size_t WS_Z = WS_MIX + 64 * MiB;
constexpr size_t WS_X1B = WS_Z + 128 * MiB;
constexpr size_t WS_LIST = WS_X1B + 64 * MiB;
constexpr size_t WS_TOK = WS_LIST + 2 * MiB;
constexpr size_t WS_H = WS_TOK + 1 * MiB;
constexpr size_t WS_YB = WS_H + 80 * MiB;
constexpr size_t WS_END = WS_YB + 160 * MiB;
constexpr int CW_BAR = 4096;
constexpr int CW_CNT = 16384;

constexpr int RING_BYTES = 131072;
constexpr int TAB_OFF = 150528;
constexpr int TST_OFF = TAB_OFF + 8192;
constexpr int MISC_OFF = TST_OFF + 1024;
constexpr int LDS_BYTES = 160768;
static_assert(MISC_OFF + 64 <= LDS_BYTES && LDS_BYTES <= 163840, "LDS map");
constexpr int NWAVES = 8;

__device__ __forceinline__ unsigned cvt_pk_bf16(float lo, float hi) { unsigned r; asm volatile("v_cvt_pk_bf16_f32 %0, %1, %2" : "=v"(r) : "v"(lo), "v"(hi)); return r; }
__device__ __forceinline__ float bflo(unsigned w) { return __uint_as_float(w << 16); }
__device__ __forceinline__ float bfhi(unsigned w) { return __uint_as_float(w & 0xffff0000u); }
__device__ __forceinline__ float sigmoid_f(float x) { return __builtin_amdgcn_rcpf(1.0f + __builtin_amdgcn_exp2f(-1.44269504089f * x)); }
__device__ __forceinline__ float silu_f(float x) { return x * sigmoid_f(x); }
__device__ __forceinline__ float gelu_tanh_f(float x) { return x * sigmoid_f(1.59576912161f * (x + 0.044715f * x * x * x)); }
__device__ __forceinline__ unsigned cvt4_fp8(float a, float b, float c, float d) { int w = __builtin_amdgcn_cvt_pk_fp8_f32(a, b, 0, false); w = __builtin_amdgcn_cvt_pk_fp8_f32(c, d, w, true); return (unsigned)w; }
constexpr float W8_SCALE = 64.0f, W8_INV = 1.0f / 64.0f;
__device__ __forceinline__ float wave_sum(float v) {
#define WS_DPP(x, ctrl) __builtin_bit_cast(float, __builtin_amdgcn_update_dpp(0, __builtin_bit_cast(int, (x)), (ctrl), 0xf, 0xf, true))
    v += WS_DPP(v, 0xB1);
    v += WS_DPP(v, 0x4E);
    v += WS_DPP(v, 0x141);
    v += WS_DPP(v, 0x140);
#undef WS_DPP
    const int b = __builtin_bit_cast(int, v);
    return (__builtin_bit_cast(float, __builtin_amdgcn_readlane(b, 0)) + __builtin_bit_cast(float, __builtin_amdgcn_readlane(b, 16)))
         + (__builtin_bit_cast(float, __builtin_amdgcn_readlane(b, 32)) + __builtin_bit_cast(float, __builtin_amdgcn_readlane(b, 48)));
}
#define VM_WAIT() asm volatile("s_waitcnt vmcnt(0)" ::: "memory")
#define LDS_WAIT() asm volatile("s_waitcnt lgkmcnt(0)" ::: "memory")

namespace pg8 {
constexpr int BM = 256, BK = 64, HALF = 128, HTB = HALF * BK * 2, STAGE_BYTES = 8 * HTB, NXCD = 8, WGM = 8;
__host__ __device__ __forceinline__ int lds_byte(int r, int c) { const int st = (r >> 4) * 2 + (c >> 5), rr = r & 15, cc = c & 31, ob = rr * 64 + cc * 2; return st * 1024 + (ob ^ (((ob >> 9) & 1) << 5)); }
__host__ __device__ __forceinline__ void stage_rc(int b, int& R, int& C) { const int st = b / 1024, sb = b % 1024, swz = sb ^ (((sb >> 9) & 1) << 5); R = (st >> 1) * 16 + swz / 64; C = (st & 1) * 32 + (swz % 64) / 2; }
__host__ __device__ __forceinline__ int perm32(int rho) { const int n = rho >> 4, i = rho & 15; return 8 * (i >> 2) + 4 * n + (i & 3); }

struct Unit { int pm, pn, e, li; };
__device__ __forceinline__ void glds16s(const char* sbase, unsigned voff, unsigned lds_dst) { unsigned keep;
    asm volatile("s_mov_b32 %0, m0\n\ts_mov_b32 m0, %3\n\ts_nop 2\n\tglobal_load_lds_dwordx4 %1, %2\n\ts_mov_b32 m0, %0" : "=&s"(keep) : "v"(voff), "s"(sbase), "s"(lds_dst) : "memory"); }

struct NoHook { static constexpr bool ON = false; __device__ __forceinline__ void operator()(int) const {} };
template <bool FP8, class Epi, class Sched, class Hook = NoHook>
__device__ __forceinline__ void gemm_phase(LAS unsigned char* lds, const int tid, const char* Abase, const int Kc, const Sched& S, const Epi& E, const Hook& H = Hook()) {
    int K = Kc; asm volatile("" : "+s"(K));
    const int wid = __builtin_amdgcn_readfirstlane(tid >> 6), lane = tid & 63, wr = wid >> 2, wc = wid & 3, fr = lane & 15, fq = lane >> 4;
    const int nt = FP8 ? K / 128 : K / BK;
    int R0, C0; stage_rc(tid * 16, R0, C0);
    const int Rb0 = Epi::PERM ? ((R0 & ~31) + perm32(R0 & 31)) : R0;
    const unsigned Cb0 = (unsigned)C0 * 2u;
    const unsigned voffB0 = FP8 ? (unsigned)(Rb0 * K) + Cb0 : (unsigned)(Rb0 * K) * 2u + Cb0;
    const size_t bstep64 = (size_t)64 * K * (FP8 ? 1 : 2);
    const size_t hstepB = 2 * bstep64;
    const unsigned ldsw = (unsigned)wid * 1024u; const unsigned ldsb = (unsigned)(size_t)lds + ldsw;
    const int aoff = lds_byte(wr * 64 + fr, fq * 8), boff = lds_byte(wc * 32 + fr, fq * 8);
    struct AOff { unsigned o0, o1, o2, o3; };
    const unsigned rb64 = Sched::GATHER ? 0u : S.rowstep() * 64u;
#define PG8_LOAD_AO(AO, U, rr) do { if constexpr (Sched::GATHER) { AO.o0 = S.rowoff(U, (rr)) + Cb0; AO.o1 = S.rowoff(U, (rr) + 64) + Cb0; AO.o2 = S.rowoff(U, (rr) + 128) + Cb0; AO.o3 = S.rowoff(U, (rr) + 192) + Cb0; } \
        else { AO.o0 = S.rowoff(U, (rr)) + Cb0 * Sched::KMULV; AO.o1 = 0u; AO.o2 = 0u; AO.o3 = 0u; } } while (0)
#define PG8_SA(b, h) (((b) * 2 + (h)) * HTB)
#define PG8_SB(b, h) ((4 + (b) * 2 + (h)) * HTB)
#define PG8_STAGE_B(bufoff, gbase) do { const char* gb_ = (const char*)(gbase); \
        glds16s(gb_, voffB0, ldsb + (unsigned)(bufoff)); glds16s(gb_ + bstep64, voffB0, ldsb + (unsigned)(bufoff) + 8192u); } while (0)
#define PG8_STAGE_A(bufoff, AO, h, kb) do { \
        if constexpr (Sched::GATHER) { const char* ab_ = Abase + (size_t)(kb); \
            glds16s(ab_, (h) ? AO.o2 : AO.o0, ldsb + (unsigned)(bufoff)); glds16s(ab_, (h) ? AO.o3 : AO.o1, ldsb + (unsigned)(bufoff) + 8192u); \
        } else { const char* ab_ = Abase + (size_t)(kb) * Sched::KMULV + (size_t)((h) * 2) * rb64; \
            glds16s(ab_, AO.o0, ldsb + (unsigned)(bufoff)); glds16s(ab_ + rb64, AO.o0, ldsb + (unsigned)(bufoff) + 8192u); } } while (0)
#define PG8_LDA(dst, b, h) do { _Pragma("unroll") for (int m = 0; m < 4; ++m) _Pragma("unroll") for (int k = 0; k < 2; ++k) dst[m][k] = *(const LAS bf16x8*)(lds + PG8_SA(b, h) + aoff + m * 2048 + k * 1024); } while (0)
#define PG8_LDB(dst, b, h) do { _Pragma("unroll") for (int n = 0; n < 2; ++n) _Pragma("unroll") for (int k = 0; k < 2; ++k) dst[n][k] = *(const LAS bf16x8*)(lds + PG8_SB(b, h) + boff + n * 2048 + k * 1024); } while (0)
#define PG8_MMA(ai, bj, At, Bt) do { __builtin_amdgcn_s_setprio(1); _Pragma("unroll") for (int m = 0; m < 4; ++m) _Pragma("unroll") for (int n = 0; n < 2; ++n) { \
        if constexpr (FP8) { \
            const i32x8 bq_ = __builtin_shufflevector(__builtin_bit_cast(i32x4, Bt[n][0]), __builtin_bit_cast(i32x4, Bt[n][1]), 0, 1, 2, 3, 4, 5, 6, 7); \
            const i32x8 aq_ = __builtin_shufflevector(__builtin_bit_cast(i32x4, At[m][0]), __builtin_bit_cast(i32x4, At[m][1]), 0, 1, 2, 3, 4, 5, 6, 7); \
            asm volatile("s_nop 1\n\tv_mfma_f32_16x16x128_f8f6f4 %0, %1, %2, %0" : "+v"(acc[ai][bj][m][n]) : "v"(bq_), "v"(aq_));   \
        } else { _Pragma("unroll") for (int k = 0; k < 2; ++k) { const i32x4 bq_ = __builtin_bit_cast(i32x4, Bt[n][k]), aq_ = __builtin_bit_cast(i32x4, At[m][k]); \
            asm volatile("s_nop 1\n\tv_mfma_f32_16x16x32_bf16 %0, %1, %2, %0" : "+v"(acc[ai][bj][m][n]) : "v"(bq_), "v"(aq_)); } } }   \
        __builtin_amdgcn_s_setprio(0); } while (0)
#define PG8_WAIT_V(n) asm volatile("s_waitcnt vmcnt(" #n ")" ::: "memory")
#define PG8_WAIT_VN(n) asm volatile("s_waitcnt vmcnt(%0)" :: "n"(n) : "memory")
#define PG8_WAIT_V8F() do { if (fa) PG8_WAIT_VN(8 + Epi::NST); else PG8_WAIT_V(8); } while (0)
#define PG8_WAIT_V6F() do { if (fa) PG8_WAIT_VN(6 + Epi::NST); else PG8_WAIT_V(6); } while (0)
#define PG8_WAIT_L(n) asm volatile("s_waitcnt lgkmcnt(" #n ")" ::: "memory")
#define PG8_BAR __builtin_amdgcn_s_barrier()
#define PG8_SCHED __builtin_amdgcn_sched_barrier(0)
    Unit cur, nxt; int ui = 0;
    if (!S.next(0, cur)) return;
    f32x4 acc[2][2][4][2];
#pragma unroll
    for (int a = 0; a < 2; ++a)
#pragma unroll
        for (int b = 0; b < 2; ++b)
#pragma unroll
            for (int m = 0; m < 4; ++m)
#pragma unroll
                for (int n = 0; n < 2; ++n) acc[a][b][m][n] = (f32x4){0.f, 0.f, 0.f, 0.f};
    bf16x8 At[4][2], B0[2][2], B1[2][2];
    AOff oc; PG8_LOAD_AO(oc, cur, R0);
    const char* cB = S.bbase(cur);
    PG8_STAGE_B(PG8_SB(0, 0), cB); PG8_STAGE_B(PG8_SB(0, 1), cB + hstepB); PG8_STAGE_A(PG8_SA(0, 0), oc, 0, 0u); PG8_STAGE_A(PG8_SA(0, 1), oc, 1, 0u);
    if (wr == 1) PG8_BAR;
    PG8_WAIT_V(2); PG8_BAR;
    PG8_STAGE_B(PG8_SB(1, 0), cB + 128); PG8_STAGE_A(PG8_SA(1, 0), oc, 0, 128u); PG8_STAGE_B(PG8_SB(1, 1), cB + hstepB + 128);
    PG8_WAIT_V(6); PG8_BAR;
    for (;;) {
        const bool has_next = S.next(ui + 1, nxt);
        const char* nB = has_next ? S.bbase(nxt) : cB;
        const bool hcur = Sched::HALFABLE ? S.half(cur) : false;
        for (int t = 0; t < nt; t += 2) {
            const bool last = (t == nt - 2);
            const unsigned kb1 = (unsigned)(t + 1) * 128u, kb2 = last ? 0u : (unsigned)(t + 2) * 128u, kb3 = kb2 + 128u;
            AOff pn = oc;
            if (last && has_next) { int t_ = (int)__builtin_amdgcn_mbcnt_hi(~0u, __builtin_amdgcn_mbcnt_lo(~0u, 0u)); asm volatile("" : "+v"(t_));
                int r0_, c0_; stage_rc((wid * 64 + t_) * 16, r0_, c0_); const unsigned Cb0 = (unsigned)c0_ * 2u; PG8_LOAD_AO(pn, nxt, r0_); }
            const char* b2 = last ? nB : cB + (size_t)(t + 2) * 128; const char* b3 = b2 + 128;
            const bool fa = FP8 && Sched::MULTI && (t == 0) && (ui > 0);
            PG8_LDB(B0, 0, 0); PG8_LDB(B1, 0, 1); PG8_SCHED; PG8_LDA(At, 0, 0); if (!fa) PG8_STAGE_A(PG8_SA(1, 1), oc, 1, kb1);
            PG8_WAIT_V8F(); PG8_WAIT_L(0); PG8_BAR; PG8_MMA(0, 0, At, B0); PG8_MMA(0, 1, At, B1); PG8_BAR; PG8_SCHED;
            if (!hcur) PG8_LDA(At, 0, 1); PG8_STAGE_B(PG8_SB(0, 0), b2); PG8_STAGE_B(PG8_SB(0, 1), b2 + hstepB);
            PG8_WAIT_V6F(); PG8_WAIT_L(0); PG8_BAR; if (!hcur) PG8_MMA(1, 0, At, B0); PG8_STAGE_A(PG8_SA(0, 0), pn, 0, kb2); if (!hcur) PG8_MMA(1, 1, At, B1); PG8_BAR; PG8_SCHED;
            PG8_LDB(B0, 1, 0); PG8_LDB(B1, 1, 1); PG8_SCHED; PG8_LDA(At, 1, 0); PG8_STAGE_A(PG8_SA(0, 1), pn, 1, kb2);
            PG8_WAIT_V8F(); PG8_WAIT_L(0); PG8_BAR; PG8_MMA(0, 0, At, B0); PG8_MMA(0, 1, At, B1); PG8_BAR; PG8_SCHED;
            if (!hcur) PG8_LDA(At, 1, 1); PG8_STAGE_B(PG8_SB(1, 0), b3); PG8_STAGE_B(PG8_SB(1, 1), b3 + hstepB);
            PG8_WAIT_V(6); PG8_WAIT_L(0); PG8_BAR; if (!hcur) PG8_MMA(1, 0, At, B0); PG8_STAGE_A(PG8_SA(1, 0), pn, 0, kb3); if (!hcur) PG8_MMA(1, 1, At, B1); PG8_BAR; PG8_SCHED;
            if (FP8 && Sched::MULTI && last && has_next) PG8_STAGE_A(PG8_SA(1, 1), pn, 1, 128u);
        }
        asm volatile("s_nop 15\n\ts_nop 15" ::: "memory");
        if (PG8_ALIGN_EPI) { if (wr == 0) PG8_BAR; }
        { int l_ = (int)__builtin_amdgcn_mbcnt_hi(~0u, __builtin_amdgcn_mbcnt_lo(~0u, 0u)); asm volatile("" : "+v"(l_));
          E(acc, cur, wr, wc, l_ & 15, l_ >> 4);
          if (PROBE_EPI) { asm volatile("" ::: "memory"); E(acc, cur, wr, wc, l_ & 15, l_ >> 4); } }
        if (!has_next) break;
        if constexpr (Hook::ON) { if (H.wants(ui)) { H(ui); asm volatile("s_waitcnt vmcnt(0)" ::: "memory"); } }
#pragma unroll
        for (int a = 0; a < 2; ++a)
#pragma unroll
            for (int b = 0; b < 2; ++b)
#pragma unroll
                for (int m = 0; m < 4; ++m)
#pragma unroll
                    for (int n = 0; n < 2; ++n) acc[a][b][m][n] = (f32x4){0.f, 0.f, 0.f, 0.f};
        cur = nxt; cB = nB; ++ui;
        { int t_ = (int)__builtin_amdgcn_mbcnt_hi(~0u, __builtin_amdgcn_mbcnt_lo(~0u, 0u)); asm volatile("" : "+v"(t_));
          int r0_, c0_; stage_rc((wid * 64 + t_) * 16, r0_, c0_); const unsigned Cb0 = (unsigned)c0_ * 2u; PG8_LOAD_AO(oc, cur, r0_); }
        if (PG8_ALIGN_EPI) { if (wr == 1) PG8_BAR; }
    }
    PG8_WAIT_V(0);
    if (!PG8_ALIGN_EPI) { if (wr == 0) PG8_BAR; }
    PG8_BAR;
#undef PG8_SA
#undef PG8_SB
#undef PG8_STAGE_A
#undef PG8_LOAD_AO
#undef PG8_STAGE_B
#undef PG8_LDA
#undef PG8_LDB
#undef PG8_MMA
#undef PG8_WAIT_V
#undef PG8_WAIT_VN
#undef PG8_WAIT_V8F
#undef PG8_WAIT_V6F
#undef PG8_WAIT_V6F
#undef PG8_WAIT_L
#undef PG8_BAR
#undef PG8_SCHED
}

struct DenseOrder {
    static constexpr bool GATHER = false, HALFABLE = false, MULTI = true; static constexpr unsigned KMULV = 1u;
    __device__ __forceinline__ bool half(const Unit&) const { return false; }
    int nM, nN, nwg, G, c; unsigned rowbytes; const char* Bt; size_t tstepB;
    __device__ __forceinline__ unsigned rowstep() const { return rowbytes; }
    __device__ __forceinline__ void init(int M, int N, int K, int G_, int c_, const void* Bt_, int eb = 2) { nM = M / BM; nN = N / BM; nwg = nM * nN; G = G_; c = c_; rowbytes = (unsigned)(K * eb); Bt = (const char*)Bt_; tstepB = (size_t)BM * K * eb; }
    const LAS int* ulist;
    __device__ __forceinline__ bool next(int i, Unit& u) const { if (i >= 8) return false; const i32x4 v = *(const LAS i32x4*)(ulist + 4 * i); u.pm = v[0]; u.pn = v[1]; u.e = v[2]; u.li = i; return v[3] != 0; }
    __device__ __forceinline__ bool find(int i, Unit& u) const {
        const long L = (long)i * G + c; if (L >= nwg) return false;
        int wgid = (int)L; { const int q = nwg / NXCD, r = nwg % NXCD, xcd = wgid % NXCD, off = wgid / NXCD; wgid = (xcd < r ? xcd * (q + 1) : r * (q + 1) + (xcd - r) * q) + off; }
        const int nig = WGM * nN, gid = wgid / nig, fm = gid * WGM, gsz = (nM - fm) < WGM ? (nM - fm) : WGM;
        u.pm = fm + ((wgid % nig) % gsz); u.pn = (wgid % nig) / gsz; u.e = 0; u.li = i; return true;
    }
    __device__ __forceinline__ unsigned rowoff(const Unit& u, int r) const { return (unsigned)(u.pm * BM + r) * rowbytes; }
    __device__ __forceinline__ const char* bbase(const Unit& u) const { return Bt + (size_t)u.pn * tstepB; }
};
struct GluOrder : DenseOrder { static constexpr unsigned KMULV = (unsigned)T; static constexpr bool MULTI = false; };
struct S5Order {
    static constexpr bool GATHER = false, HALFABLE = false, MULTI = true; static constexpr unsigned KMULV = 1u;
    __device__ __forceinline__ bool half(const Unit&) const { return false; }
    int G, c; const char* Bt;
    __device__ __forceinline__ unsigned rowstep() const { return (unsigned)(KS5 * 2); }
    const LAS int* ulist;
    __device__ __forceinline__ bool next(int i, Unit& u) const { if (i >= 8) return false; const i32x4 v = *(const LAS i32x4*)(ulist + 4 * i); u.pm = v[0]; u.pn = v[1]; u.e = v[2]; u.li = i; return v[3] != 0; }
    __device__ __forceinline__ bool find(int i, Unit& u) const { const int L = i * G + c; if (L >= 256) return false; u.pm = L; u.pn = L >> 2; u.e = 0; u.li = i; return true; }
    __device__ __forceinline__ unsigned rowoff(const Unit& u, int r) const { return (unsigned)(u.pm * BM + r) * (unsigned)(KS5 * 2); }
    __device__ __forceinline__ const char* bbase(const Unit& u) const { return Bt + (size_t)u.pn * (size_t)(BM * KS5 * 2); }
};
template <bool GATHER_> struct MoeOrder {
    static constexpr bool GATHER = GATHER_, HALFABLE = true, MULTI = true; static constexpr unsigned KMULV = 1u;
    int NF, NU, G, c; const LAS int* pst; const LAS int* fst; const LAS int* hst; const LAS unsigned* table; const char* Bt; size_t estepB, tstepB; unsigned rowbytes;
    __device__ __forceinline__ unsigned rowstep() const { return rowbytes; }
    const LAS int* ulist;
    __device__ __forceinline__ bool find(int i, Unit& u) const {
        const int L = i * G + c; if (L >= NU) return false;
        int e = 0;
        if (L < NF) { const int rt = L >> 3; while (e < NE - 1 && fst[e + 1] <= rt) ++e; u.pm = (pst[e] + 2 * (rt - fst[e])) * 128; u.e = e; }
        else { const int hh = (L - NF) >> 3; while (e < NE - 1 && hst[e + 1] <= hh) ++e; u.pm = (pst[e + 1] - 1) * 128; u.e = e | 256; }
        u.pn = L & 7; u.li = i; return true;
    }
    int ibeg = 0, iend = 8;
    __device__ __forceinline__ bool next(int i, Unit& u) const {
        const int j = ibeg + i; if (j >= iend) return false;
        const i32x4 v = *(const LAS i32x4*)(ulist + 4 * j);
        u.pm = v[0]; u.pn = v[1]; u.e = v[2]; u.li = j; return v[3] != 0;
    }
    __device__ __forceinline__ bool half(const Unit& u) const { return (u.e & 256) != 0; }
    __device__ __forceinline__ unsigned rowoff(const Unit& u, int r) const { if constexpr (GATHER_) return table[u.li * 256 + r]; else return (unsigned)(u.pm + r) * rowbytes; }
    __device__ __forceinline__ const char* bbase(const Unit& u) const { return Bt + (size_t)(u.e & 255) * estepB + (size_t)u.pn * tstepB; }
};

template <class MO> __device__ __forceinline__ void moe_units(const MO& S, LAS int* ulist, int tid) {
    if (tid < 8) { Unit u; u.pm = 0; u.pn = 0; u.e = 0; u.li = tid; const bool ok = S.find(tid, u); *(LAS i32x4*)(ulist + 4 * tid) = (i32x4){u.pm, u.pn, u.e, ok ? 1 : 0}; }
}

struct EpiInProj {
    static constexpr int NST = 16;
    static constexpr bool PERM = true;
    bf16 *Q, *Kk, *Gs, *U2; const float *cosT, *sinT;
    __device__ __forceinline__ void operator()(const f32x4 (&acc)[2][2][4][2], const Unit& u, int wr, int wc, int fr, int fq) const {
        const int seg = u.pn >> 2;
        const int colseg = (u.pn & 3) * 256 + wc * 32 + 8 * fq;
        const int hd_ = u.pn & 3;
        const float lgam = hd_ == 0 ? -0.045803689613f : hd_ == 1 ? -0.022720076500f : hd_ == 2 ? -0.011315313227f : -0.005646563141f;
        if (seg <= 1) {
            bf16* const O = (seg == 0) ? Q : Kk;
            float frq[2][4];
#pragma unroll
            for (int bj = 0; bj < 2; ++bj) { const int i0 = ((colseg + bj * HALF) & (HD - 1)) >> 1;
#pragma unroll
                for (int j = 0; j < 4; ++j) frq[bj][j] = __builtin_amdgcn_exp2f(-0.10381025296523f * (float)(i0 + j)) * 0.15915494309189535f; }
#pragma unroll
            for (int ai = 0; ai < 2; ++ai) {
#pragma unroll
                for (int m = 0; m < 4; ++m) { const int row = u.pm * BM + ai * HALF + wr * 64 + m * 16 + fr; const int tpos = row & (SEQ - 1); const float tf = (float)tpos;
                    const float fdec = (seg == 0) ? W8_INV * __builtin_amdgcn_exp2f(lgam * tf) : (W8_INV * 0.0625f) * __builtin_amdgcn_exp2f(-lgam * tf);
#pragma unroll
                    for (int bj = 0; bj < 2; ++bj) { const int col = colseg + bj * HALF; const f32x4 v0 = acc[ai][bj][m][0] * fdec, v1 = acc[ai][bj][m][1] * fdec; f32x4 c, sn;
#pragma unroll
                        for (int j = 0; j < 4; ++j) { const float x = __builtin_amdgcn_fractf(tf * frq[bj][j]); c[j] = __builtin_amdgcn_cosf(x); sn[j] = __builtin_amdgcn_sinf(x); }
                        u32x4 w; w.x = cvt_pk_bf16(v0[0] * c[0] - v0[1] * sn[0], v0[0] * sn[0] + v0[1] * c[0]); w.y = cvt_pk_bf16(v0[2] * c[1] - v0[3] * sn[1], v0[2] * sn[1] + v0[3] * c[1]);
                        w.z = cvt_pk_bf16(v1[0] * c[2] - v1[1] * sn[2], v1[0] * sn[2] + v1[1] * c[2]); w.w = cvt_pk_bf16(v1[2] * c[3] - v1[3] * sn[3], v1[2] * sn[3] + v1[3] * c[3]);
                        *(u32x4*)(O + (size_t)row * RW + col) = w; } }
            }
        } else {
#pragma unroll
            for (int ai = 0; ai < 2; ++ai)
#pragma unroll
                for (int m = 0; m < 4; ++m) {
                    const int row = u.pm * BM + ai * HALF + wr * 64 + m * 16 + fr; const int tpos = row & (SEQ - 1);
#pragma unroll
                    for (int bj = 0; bj < 2; ++bj) {
                        const int col = colseg + bj * HALF; const f32x4 v0 = acc[ai][bj][m][0] * W8_INV, v1 = acc[ai][bj][m][1] * W8_INV;
                        if (seg == 2) {
                            u32x4 w; w.x = cvt_pk_bf16(silu_f(v0[0]), silu_f(v0[1])); w.y = cvt_pk_bf16(silu_f(v0[2]), silu_f(v0[3])); w.z = cvt_pk_bf16(silu_f(v1[0]), silu_f(v1[1])); w.w = cvt_pk_bf16(silu_f(v1[2]), silu_f(v1[3]));
                            *(u32x4*)(Gs + (size_t)row * RW + col) = w;
                        } else {
                            const int gidx = col >> 4, ch0 = col & 15, b = row >> 11, c = tpos >> 4, tt = tpos & 15;
                            u32x4 w; w.x = cvt_pk_bf16(v0[0], v0[1]); w.y = cvt_pk_bf16(v0[2], v0[3]); w.z = cvt_pk_bf16(v1[0], v1[1]); w.w = cvt_pk_bf16(v1[2], v1[3]);
                            *(u32x4*)(U2 + (size_t)(gidx * 1024 + b * 128 + c) * KS5 + tt * 16 + ch0) = w;
                        }
                    }
                }
        }
    }
};
struct EpiBf16 {
    static constexpr int NST = 16;
    static constexpr bool PERM = true;
    bf16* O; int ldc; float sc;
    __device__ __forceinline__ void operator()(const f32x4 (&acc)[2][2][4][2], const Unit& u, int wr, int wc, int fr, int fq) const {
        const int row0 = u.pm * BM + wr * 64 + fr, col0 = u.pn * BM + wc * 32 + 8 * fq;
#pragma unroll
        for (int ai = 0; ai < 2; ++ai)
#pragma unroll
            for (int m = 0; m < 4; ++m) { bf16* rowp = O + (size_t)(row0 + ai * HALF + m * 16) * ldc + col0;
#pragma unroll
                for (int bj = 0; bj < 2; ++bj) { const f32x4 v0 = acc[ai][bj][m][0] * sc, v1 = acc[ai][bj][m][1] * sc;
                    u32x4 w; w.x = cvt_pk_bf16(v0[0], v0[1]); w.y = cvt_pk_bf16(v0[2], v0[3]); w.z = cvt_pk_bf16(v1[0], v1[1]); w.w = cvt_pk_bf16(v1[2], v1[3]);
                    *(u32x4*)(rowp + bj * HALF) = w; } }
    }
};
struct EpiF8 {
    static constexpr int NST = 8;
    static constexpr bool PERM = true;
    unsigned char* O; int ldc; float sc;
    __device__ __forceinline__ void operator()(const f32x4 (&acc)[2][2][4][2], const Unit& u, int wr, int wc, int fr, int fq) const {
        const int row0 = u.pm + wr * 64 + fr, col0 = u.pn * BM + wc * 32 + 8 * fq; const int nai = (u.e & 256) ? 1 : 2;
#pragma unroll
        for (int ai = 0; ai < 2; ++ai) if (ai < nai)
#pragma unroll
            for (int m = 0; m < 4; ++m) { unsigned char* rowp = O + (size_t)(row0 + ai * HALF + m * 16) * ldc + col0;
#pragma unroll
                for (int bj = 0; bj < 2; ++bj) { const f32x4 v0 = acc[ai][bj][m][0] * sc, v1 = acc[ai][bj][m][1] * sc;
                    u32x2 w; w.x = cvt4_fp8(v0[0], v0[1], v0[2], v0[3]); w.y = cvt4_fp8(v1[0], v1[1], v1[2], v1[3]);
                    *(u32x2*)(rowp + bj * HALF) = w; } }
    }
};
struct EpiS5Out {
    static constexpr int NST = 32;
    static constexpr bool PERM = true;
    bf16* Y; unsigned char* Y8;
    __device__ __forceinline__ void operator()(const f32x4 (&acc)[2][2][4][2], const Unit& u, int wr, int wc, int fr, int fq) const {
        const unsigned lane0 = (unsigned)(fr * 256 + (fq >> 1) * 16 + (fq & 1) * 8) + (unsigned)(wr * 16384 + wc * 32);
#pragma unroll
        for (int ai = 0; ai < 2; ++ai) { const unsigned gb = ((unsigned)(u.pm >> 2) * (unsigned)T + (unsigned)(((u.pm * 2 + ai) & 7) * SEQ)) * 16u + lane0;
#pragma unroll
            for (int m = 0; m < 4; ++m)
#pragma unroll
                for (int bj = 0; bj < 2; ++bj) {
                    const f32x4 v0 = acc[ai][bj][m][0], v1 = acc[ai][bj][m][1];
                    u32x4 w; w.x = cvt_pk_bf16(gelu_tanh_f(v0[0]), gelu_tanh_f(v0[1])); w.y = cvt_pk_bf16(gelu_tanh_f(v0[2]), gelu_tanh_f(v0[3]));
                    w.z = cvt_pk_bf16(gelu_tanh_f(v1[0]), gelu_tanh_f(v1[1])); w.w = cvt_pk_bf16(gelu_tanh_f(v1[2]), gelu_tanh_f(v1[3]));
                    const unsigned yo = gb + (unsigned)(m * 4096 + bj * 128);
                    *(u32x4*)(Y + yo) = w;
                    u32x2 w8; w8.x = cvt4_fp8(bflo(w.x), bfhi(w.x), bflo(w.y), bfhi(w.y)); w8.y = cvt4_fp8(bflo(w.z), bfhi(w.z), bflo(w.w), bfhi(w.w));
                    *(u32x2*)(Y8 + yo) = w8;
                }
        }
    }
};
struct EpiGlu {
    static constexpr int NST = 16;
    static constexpr bool PERM = true;
    const bf16* Y; unsigned char* MIX8;
    __device__ __forceinline__ void operator()(const f32x4 (&acc)[2][2][4][2], const Unit& u, int wr, int wc, int fr, int fq) const {
        const int row0 = u.pm * BM + wr * 64 + fr, col0 = u.pn * BM + wc * 32 + 8 * fq;
        const unsigned ylb = ((unsigned)(u.pn * 16 + wc * 2 + (fq >> 1)) * (unsigned)T + (unsigned)(u.pm * BM + wr * 64 + fr)) * 16u + 8u * (unsigned)(fq & 1);
        u32x4 yv[2][4][2];
#pragma unroll
        for (int ai = 0; ai < 2; ++ai)
#pragma unroll
            for (int m = 0; m < 4; ++m)
#pragma unroll
                for (int bj = 0; bj < 2; ++bj) yv[ai][m][bj] = *(const u32x4*)(Y + ylb + (unsigned)(bj * 8 * T * 16 + (ai * HALF + m * 16) * 16));
#pragma unroll
        for (int ai = 0; ai < 2; ++ai)
#pragma unroll
            for (int m = 0; m < 4; ++m) { const int row = row0 + ai * HALF + m * 16;
#pragma unroll
                for (int bj = 0; bj < 2; ++bj) { const int col = col0 + bj * HALF; const f32x4 v0 = acc[ai][bj][m][0] * W8_INV, v1 = acc[ai][bj][m][1] * W8_INV;
                    const u32x4 y = yv[ai][m][bj];
                    u32x2 w; w.x = cvt4_fp8(bflo(y.x) * sigmoid_f(v0[0]), bfhi(y.x) * sigmoid_f(v0[1]), bflo(y.y) * sigmoid_f(v0[2]), bfhi(y.y) * sigmoid_f(v0[3]));
                    w.y = cvt4_fp8(bflo(y.z) * sigmoid_f(v1[0]), bfhi(y.z) * sigmoid_f(v1[1]), bflo(y.w) * sigmoid_f(v1[2]), bfhi(y.w) * sigmoid_f(v1[3]));
                    *(u32x2*)(MIX8 + (size_t)row * DM + 1024 + col) = w; } }
    }
};
template <bool XF32> struct EpiResid {
    static constexpr int NST = 16;
    static constexpr bool PERM = true;
    const void* xin_; bf16* Z;
    __device__ __forceinline__ void operator()(const f32x4 (&acc)[2][2][4][2], const Unit& u, int wr, int wc, int fr, int fq) const {
        const int row0 = u.pm * BM + wr * 64 + fr, col0 = u.pn * BM + wc * 32 + 8 * fq;
#pragma unroll
        for (int ai = 0; ai < 2; ++ai) {
            f32x4 xf0[XF32 ? 4 : 1][2], xf1[XF32 ? 4 : 1][2]; u32x4 xb[XF32 ? 1 : 4][2];
#pragma unroll
            for (int m = 0; m < 4; ++m)
#pragma unroll
                for (int bj = 0; bj < 2; ++bj) { const size_t off = (size_t)(row0 + ai * HALF + m * 16) * DM + col0 + bj * HALF;
                    if constexpr (XF32) { const float* xf = (const float*)xin_ + off; xf0[m][bj] = __builtin_nontemporal_load((const f32x4*)xf); xf1[m][bj] = __builtin_nontemporal_load((const f32x4*)(xf + 4)); }
                    else xb[m][bj] = __builtin_nontemporal_load((const u32x4*)((const bf16*)xin_ + off)); }
#pragma unroll
            for (int m = 0; m < 4; ++m) { const size_t off = (size_t)(row0 + ai * HALF + m * 16) * DM + col0;
#pragma unroll
                for (int bj = 0; bj < 2; ++bj) { const f32x4 v0 = acc[ai][bj][m][0] * W8_INV, v1 = acc[ai][bj][m][1] * W8_INV;
                    u32x4 w;
                    if constexpr (XF32) { const f32x4 x0 = xf0[m][bj], x1 = xf1[m][bj];
                        w.x = cvt_pk_bf16(ALPHA * x0[0] + v0[0], ALPHA * x0[1] + v0[1]); w.y = cvt_pk_bf16(ALPHA * x0[2] + v0[2], ALPHA * x0[3] + v0[3]);
                        w.z = cvt_pk_bf16(ALPHA * x1[0] + v1[0], ALPHA * x1[1] + v1[1]); w.w = cvt_pk_bf16(ALPHA * x1[2] + v1[2], ALPHA * x1[3] + v1[3]);
                    } else { const u32x4 x = xb[m][bj];
                        w.x = cvt_pk_bf16(ALPHA * bflo(x.x) + v0[0], ALPHA * bfhi(x.x) + v0[1]); w.y = cvt_pk_bf16(ALPHA * bflo(x.y) + v0[2], ALPHA * bfhi(x.y) + v0[3]);
                        w.z = cvt_pk_bf16(ALPHA * bflo(x.z) + v1[0], ALPHA * bfhi(x.z) + v1[1]); w.w = cvt_pk_bf16(ALPHA * bflo(x.w) + v1[2], ALPHA * bfhi(x.w) + v1[3]); }
                    *(u32x4*)(Z + off + bj * HALF) = w; } }
        }
    }
};
struct EpiGateUp {
    static constexpr int NST = 4;
    static constexpr bool PERM = true;
    unsigned char* H;
    __device__ __forceinline__ void operator()(const f32x4 (&acc)[2][2][4][2], const Unit& u, int wr, int wc, int fr, int fq) const {
        const int row0 = u.pm + wr * 64 + fr, col0 = u.pn * HALF + wc * 32 + 8 * fq; const int nai = (u.e & 256) ? 1 : 2;
#pragma unroll
        for (int ai = 0; ai < 2; ++ai) if (ai < nai)
#pragma unroll
            for (int m = 0; m < 4; ++m) { const f32x4 g0 = acc[ai][0][m][0] * W8_INV, g1 = acc[ai][0][m][1] * W8_INV, u0 = acc[ai][1][m][0] * W8_INV, u1 = acc[ai][1][m][1] * W8_INV;
                u32x2 w; w.x = cvt4_fp8(silu_f(g0[0]) * u0[0], silu_f(g0[1]) * u0[1], silu_f(g0[2]) * u0[2], silu_f(g0[3]) * u0[3]);
                w.y = cvt4_fp8(silu_f(g1[0]) * u1[0], silu_f(g1[1]) * u1[1], silu_f(g1[2]) * u1[2], silu_f(g1[3]) * u1[3]);
                *(u32x2*)(H + (size_t)(row0 + ai * HALF + m * 16) * DE + col0) = w; }
    }
};
}

#define XB_TMO      128
#define XB_XCNT(j)  (256  + 64 * (j))
#define XB_XSUB(j)  (1280 + 64 * (j))
#define XB_XGEN(j)  (2304 + 64 * (j))
#define XB_TOP      3328
#define XB_TOPGEN   3392
#define XCD_BAR_WORDS 3456
#define XB_SPIN_CAP (1u << 18)

__device__ __forceinline__ unsigned xb_ld(unsigned* p)              { return __hip_atomic_load(p, __ATOMIC_RELAXED, __HIP_MEMORY_SCOPE_AGENT); }
__device__ __forceinline__ unsigned xb_add(unsigned* p, unsigned v) { return __hip_atomic_fetch_add(p, v, __ATOMIC_RELAXED, __HIP_MEMORY_SCOPE_AGENT); }
__device__ __forceinline__ unsigned xb_xcc_id() { return (unsigned)__builtin_amdgcn_s_getreg((3 << 11) | 20) & 0xFu; }
#define XB_SPIN(cond, bar) do { unsigned _sp = 0; while (cond) { __builtin_amdgcn_s_sleep(1); \
    if ((++_sp & 255u) == 0u) { if (xb_ld(&(bar)[XB_TMO])) break; if (_sp > XB_SPIN_CAP) { atomicAdd(&(bar)[XB_TMO], 1u); break; } } } } while (0)

struct XcdBarrier { unsigned* bar; unsigned x; volatile LAS unsigned* st; };

__device__ __forceinline__ XcdBarrier xcd_barrier_post(unsigned* bar, volatile LAS unsigned* st) {
    XcdBarrier b; b.bar = bar; b.x = xb_xcc_id(); b.st = st;
    if (threadIdx.x == 0) (void)xb_add(&bar[XB_XCNT(b.x)], 1u);
    return b;
}
__device__ __forceinline__ void xcd_barrier_complete(unsigned* bar, unsigned x, unsigned& nloc, unsigned& nx) {
    const unsigned G = gridDim.x * gridDim.y * gridDim.z;
    unsigned sum, cnt, mine, sp = 0u;
    for (;;) {
        sum = 0u; cnt = 0u; mine = 0u;
#pragma unroll
        for (unsigned j = 0; j < 16; ++j) { const unsigned c = xb_ld(&bar[XB_XCNT(j)]); sum += c; cnt += (c > 0u) ? 1u : 0u; mine = (j == x) ? c : mine; }
        if (sum == G) break;
        __builtin_amdgcn_s_sleep(1);
        if ((++sp & 255u) == 0u) { if (xb_ld(&bar[XB_TMO])) break; if (sp > XB_SPIN_CAP) { atomicAdd(&bar[XB_TMO], 1u); break; } }
    }
    nloc = mine > 0u ? mine : 1u; nx = cnt > 0u ? cnt : 1u;
}
__device__ __forceinline__ void xcd_barrier(const XcdBarrier& b) {
    asm volatile("s_waitcnt vmcnt(0)" ::: "memory");
    __syncthreads();
    if (threadIdx.x == 0) {
        unsigned* bar = b.bar;
        __builtin_amdgcn_s_waitcnt(0);
        unsigned nloc = b.st[0], nx = b.st[1];
        if (nloc == 0u) { xcd_barrier_complete(bar, b.x, nloc, nx); b.st[0] = nloc; b.st[1] = nx; }
        const unsigned old = xb_add(&bar[XB_XSUB(b.x)], 1u);
        const unsigned gen = old / nloc;
        if (old + 1u == (gen + 1u) * nloc) {
            __builtin_amdgcn_fence(__ATOMIC_RELEASE, "agent");
            asm volatile("s_waitcnt vmcnt(0)" ::: "memory");
            const unsigned og = xb_add(&bar[XB_TOP], 1u);
            const unsigned tg = og / nx;
            if (og + 1u == (tg + 1u) * nx) xb_add(&bar[XB_TOPGEN], 1u);
            else XB_SPIN(xb_ld(&bar[XB_TOPGEN]) == tg, bar);
            __builtin_amdgcn_fence(__ATOMIC_ACQUIRE, "agent");
            xb_add(&bar[XB_XGEN(b.x)], 1u);
            asm volatile("s_waitcnt vmcnt(0)" ::: "memory");
        } else {
            XB_SPIN(xb_ld(&bar[XB_XGEN(b.x)]) == gen, bar);
            __builtin_amdgcn_fence(__ATOMIC_ACQUIRE, "agent");
            asm volatile("s_waitcnt vmcnt(0)" ::: "memory");
        }
    }
    __syncthreads();
}

struct Args { const float* in[21]; float* out; unsigned char* ws; int ph_lo, ph_hi; };

struct Frame {
    LAS unsigned char* lds;
    int tid, lane, wave, vcu, G;
    unsigned char* ws; unsigned* ctl;
};

struct TItem { const float* src; unsigned char* dst; int srcN, dld, f8; };
__device__ __forceinline__ void titem_load(const TItem& t, f32x4 (&v)[16], int lane) {
    const float* p = t.src + (size_t)(16 * (lane >> 4)) * t.srcN + 4 * (lane & 15);
#pragma unroll
    for (int i = 0; i < 16; ++i) v[i] = __builtin_nontemporal_load((const f32x4*)(p + (size_t)i * t.srcN));
}
__device__ __forceinline__ void titem_convert_write(const TItem& t, const f32x4 (&v)[16], int lane) {
    unsigned char* d = t.dst + (size_t)(4 * (lane & 15)) * t.dld + 16 * (lane >> 4);
#pragma unroll
    for (int c = 0; c < 4; ++c) { u32x4 w;
        w.x = cvt4_fp8(v[0][c] * W8_SCALE, v[1][c] * W8_SCALE, v[2][c] * W8_SCALE, v[3][c] * W8_SCALE); w.y = cvt4_fp8(v[4][c] * W8_SCALE, v[5][c] * W8_SCALE, v[6][c] * W8_SCALE, v[7][c] * W8_SCALE);
        w.z = cvt4_fp8(v[8][c] * W8_SCALE, v[9][c] * W8_SCALE, v[10][c] * W8_SCALE, v[11][c] * W8_SCALE); w.w = cvt4_fp8(v[12][c] * W8_SCALE, v[13][c] * W8_SCALE, v[14][c] * W8_SCALE, v[15][c] * W8_SCALE);
        *(u32x4*)(d + (size_t)c * t.dld) = w; }
}
constexpr int TI_IN = 2 * 32 * 80, TI_OUT = 2 * 32 * 32, TI_GLU = 2 * 16 * 16, TI_G = 64 * 32 * 16, TI_U = TI_G, TI_D = 64 * 16 * 32;
constexpr int TI_N = TI_IN + TI_OUT + TI_GLU + TI_G + TI_U + TI_D;
__device__ __forceinline__ TItem titem_decode(const Args& a, unsigned char* ws, int it) {
    TItem t; int r = it;
    if (r < TI_IN) { const int l = r / (32 * 80), q = r % (32 * 80), kb = q / 80, nb = q % 80, n0 = nb * 64, seg = n0 >> 10;
        const int drow = (seg == 0 ? 0 : seg == 1 ? 1024 : seg == 2 ? 4096 : seg == 3 ? 2048 : 3072) + (n0 & 1023);
        t.src = a.in[1] + (size_t)l * DM * NPROJ + (size_t)kb * 64 * NPROJ + n0; t.srcN = NPROJ; t.dst = ws + WS_WIN + (((size_t)l * NPROJ + drow) * DM + kb * 64); t.dld = DM; t.f8 = 1; return t; }
    r -= TI_IN;
    if (r < TI_OUT) { const int l = r / 1024, q = r % 1024, kb = q / 32, nb = q % 32;
        t.src = a.in[2] + (size_t)l * DM * DM + (size_t)kb * 64 * DM + nb * 64; t.srcN = DM; t.dst = ws + WS_WOUT + (((size_t)l * DM + nb * 64) * DM + kb * 64); t.dld = DM; t.f8 = 1; return t; }
    r -= TI_OUT;
    if (r < TI_GLU) { const int l = r / 256, q = r % 256, kb = q / 16, nb = q % 16;
        t.src = a.in[11] + (size_t)l * 1024 * 1024 + (size_t)kb * 64 * 1024 + nb * 64; t.srcN = 1024; t.dst = ws + WS_WGLU + (((size_t)l * 1024 + nb * 64) * 1024 + kb * 64); t.dld = 1024; t.f8 = 1; return t; }
    r -= TI_GLU;
    if (r < TI_G + TI_U) { const int up = r >= TI_G ? 1 : 0; if (up) r -= TI_G; const int le = r / 512, q = r % 512, kb = ((q >> 1) / 16) * 2 + (q & 1), nb = (q >> 1) % 16, n0 = nb * 64;
        const int drow = (n0 >> 7) * 256 + up * 128 + (n0 & 127);
        t.src = (up ? a.in[19] : a.in[18]) + (size_t)le * DM * DE + (size_t)kb * 64 * DE + n0; t.srcN = DE; t.dst = ws + WS_WGU + ((size_t)le * 2048 + drow) * DM + kb * 64; t.dld = DM; t.f8 = 1; return t; }
    r -= TI_G + TI_U;
    { const int le = r / 512, q = r % 512, kb = ((q >> 1) / 32) * 2 + (q & 1), nb = (q >> 1) % 32;
        t.src = a.in[20] + (size_t)le * DE * DM + (size_t)kb * 64 * DM + nb * 64; t.srcN = DM; t.dst = ws + WS_WDN + ((size_t)le * DM + nb * 64) * DE + kb * 64; t.dld = DE; t.f8 = 1; return t; }
}

__device__ __forceinline__ void convert_items(Frame& F, const Args& a, int first, int count, int gw = -1, int NGW = 0) {
    int lane_ = F.lane; asm volatile("" : "+v"(lane_));
    if (gw < 0) { gw = F.vcu * NWAVES + F.wave; NGW = F.G * NWAVES; }
    f32x4 va[16], vb[16];
    for (int q = gw; q < count / 2; q += NGW) {
        const TItem ta = titem_decode(a, F.ws, first + 2 * q), tb = titem_decode(a, F.ws, first + 2 * q + 1);
        titem_load(ta, va, lane_); titem_load(tb, vb, lane_);
        titem_convert_write(ta, va, lane_); titem_convert_write(tb, vb, lane_);
    }
}
struct ConvHook { static constexpr bool ON = true; Frame* F; const Args* a; int first, count, gw, ngw, at;
    __device__ __forceinline__ bool wants(int ui) const { return ui == at; }
    __device__ __forceinline__ void operator()(int) const { convert_items(*F, *a, first, count, gw, ngw); } };
constexpr int TI_MOE0 = TI_IN + TI_OUT + TI_GLU;

__device__ __forceinline__ void p0_prologue(Frame& F, const Args& a) {
    LAS float* scr = (LAS float*)(F.lds + F.wave * 16640);
    const int gw = F.vcu * NWAVES + F.wave, NGW = F.G * NWAVES;
    {
        LAS float* APr = (LAS float*)(F.lds);
        LAS float* APi = APr + 17 * 64;
        LAS float* BBr = APi + 17 * 64;
        LAS float* BBi = BBr + 1024;
        LAS float* CCr = BBi + 1024;
        LAS float* CCi = CCr + 1024;
        LAS float* DD = CCi + 1024;
        LAS float* KM = DD + 16;
        for (int it = F.vcu; it < 2 * SGRP; it += F.G) {
            const int l = it / SGRP, g = it % SGRP; const size_t lg = (size_t)l * SGRP + g;
            const float dt = expf(a.in[10][lg]);
            for (int idx = F.tid; idx < 17 * 64; idx += 512) { const int tau = idx >> 6, p = idx & 63;
                const float zr = a.in[3][lg * SST + p] * dt, zi = a.in[4][lg * SST + p] * dt; const float mg = expf(zr * (float)tau); float sn, cs; sincosf(zi * (float)tau, &sn, &cs);
                APr[idx] = mg * cs; APi[idx] = mg * sn;
                if (tau == 16) { float* A16 = (float*)(F.ws + WS_S5A) + (lg * SST + p) * 2; A16[0] = mg * cs; A16[1] = mg * sn; } }
            for (int idx = F.tid; idx < 1024; idx += 512) { const int p = idx >> 4;
                const float lre = a.in[3][lg * SST + p], lim = a.in[4][lg * SST + p], zr = lre * dt, zi = lim * dt;
                float sn, cs, sh, ch_; sincosf(zi, &sn, &cs); sincosf(0.5f * zi, &sh, &ch_); (void)ch_;
                const float em = expm1f(zr), ez = em + 1.0f; const float nr = em * cs - 2.0f * sh * sh, ni = ez * sn, den = lre * lre + lim * lim;
                const float sr = (nr * lre + ni * lim) / den, si = (ni * lre - nr * lim) / den;
                const float br = a.in[5][lg * 1024 + idx], bi = a.in[6][lg * 1024 + idx];
                BBr[idx] = sr * br - si * bi; BBi[idx] = sr * bi + si * br;
                CCr[idx] = a.in[7][lg * 1024 + idx]; CCi[idx] = a.in[8][lg * 1024 + idx]; }
            if (F.tid < 16) DD[F.tid] = a.in[9][lg * SCH + F.tid];
            __syncthreads();
            { const int tau = F.tid >> 5, ch0 = ((F.tid >> 2) & 7) * 2, cp0 = (F.tid & 3) * 4; float acc[2][4];
#pragma unroll
              for (int i = 0; i < 2; ++i)
#pragma unroll
                  for (int j = 0; j < 4; ++j) acc[i][j] = 0.f;
              for (int p = 0; p < 64; ++p) { const float ar = APr[tau * 64 + p], ai = APi[tau * 64 + p];
                  const f32x4 br = *(const LAS f32x4*)(BBr + p * 16 + cp0), bi = *(const LAS f32x4*)(BBi + p * 16 + cp0);
#pragma unroll
                  for (int i = 0; i < 2; ++i) { const float cr = CCr[(ch0 + i) * 64 + p], ci = CCi[(ch0 + i) * 64 + p]; const float car = cr * ar - ci * ai, cai = cr * ai + ci * ar;
#pragma unroll
                      for (int j = 0; j < 4; ++j) acc[i][j] += car * br[j] - cai * bi[j]; } }
#pragma unroll
              for (int i = 0; i < 2; ++i)
#pragma unroll
                  for (int j = 0; j < 4; ++j) KM[(tau << 8) + ((ch0 + i) << 4) + cp0 + j] = acc[i][j]; }
            __syncthreads();
            bf16* Bout = (bf16*)(F.ws + WS_S5OUT) + lg * (size_t)(256 * KS5);
            for (int v = F.tid; v < 256 * 48; v += 512) { const int n = v / 48, k8 = (v % 48) * 8, tt = n >> 4, ch = n & 15; float o[8];
                if (k8 < 256) { const int s5 = k8 >> 4, cpb = k8 & 15;
#pragma unroll
                    for (int j = 0; j < 8; ++j) { float x = (s5 <= tt) ? KM[((tt - s5) << 8) + (ch << 4) + cpb + j] : 0.f; if (s5 == tt && cpb + j == ch) x += DD[ch]; o[j] = x; } }
                else { const int p0 = (k8 - 256) & 63; const bool im = k8 >= 320;
#pragma unroll
                    for (int j = 0; j < 8; ++j) { const int p = p0 + j; const float cr = CCr[ch * 64 + p], ci = CCi[ch * 64 + p], ar = APr[(tt + 1) * 64 + p], ai = APi[(tt + 1) * 64 + p];
                        o[j] = im ? -(cr * ai + ci * ar) : (cr * ar - ci * ai); } }
                u32x4 w; w.x = cvt_pk_bf16(o[0], o[1]); w.y = cvt_pk_bf16(o[2], o[3]); w.z = cvt_pk_bf16(o[4], o[5]); w.w = cvt_pk_bf16(o[6], o[7]);
                *(u32x4*)(Bout + (size_t)n * KS5 + k8) = w; }
            bf16* Min = (bf16*)(F.ws + WS_S5IN) + lg * (size_t)(128 * 256);
            for (int v = F.tid; v < 128 * 32; v += 512) { const int n = v >> 5, k8 = (v & 31) * 8, p = n & 63, s5 = k8 >> 4, cpb = k8 & 15; float o[8];
                const float ar = APr[(15 - s5) * 64 + p], ai = APi[(15 - s5) * 64 + p];
#pragma unroll
                for (int j = 0; j < 8; ++j) { const float br = BBr[p * 16 + cpb + j], bi = BBi[p * 16 + cpb + j]; o[j] = (n < 64) ? (ar * br - ai * bi) : (ar * bi + ai * br); }
                u32x4 w; w.x = cvt_pk_bf16(o[0], o[1]); w.y = cvt_pk_bf16(o[2], o[3]); w.z = cvt_pk_bf16(o[4], o[5]); w.w = cvt_pk_bf16(o[6], o[7]);
                *(u32x4*)(Min + (size_t)n * 256 + k8) = w; }
            __syncthreads();
        }
    }
    __syncthreads();
    convert_items(F, a, 0, TI_IN / 2);
    for (int part = 0; part < 2; ++part) { const float* x = a.in[0];
      const bool split = (F.G == 256); const size_t half = (size_t)T * DM / 16;
      if (split && part == 0 && F.vcu < 128) continue;
      const size_t i0 = split ? (size_t)part * half : 0, i1 = split ? i0 + half : (part == 0 ? 2 * half : 0);
      const size_t gwx = (split && part == 0) ? (size_t)(gw - 128 * NWAVES) : (size_t)gw, ngwx = (split && part == 0) ? (size_t)(128 * NWAVES) : (size_t)NGW;
      for (size_t i = i0 + gwx * 64 + F.lane; i < i1; i += 4 * ngwx * 64) {
          f32x4 p[4], q[4];
#pragma unroll
          for (int k = 0; k < 4; ++k) { const size_t ik = i + (size_t)k * ngwx * 64; if (ik < i1) { p[k] = __builtin_nontemporal_load((const f32x4*)(x + ik * 8)); q[k] = __builtin_nontemporal_load((const f32x4*)(x + ik * 8 + 4)); } }
#pragma unroll
          for (int k = 0; k < 4; ++k) { const size_t ik = i + (size_t)k * ngwx * 64; if (ik < i1) {
              u32x2 w8; w8.x = cvt4_fp8(p[k][0], p[k][1], p[k][2], p[k][3]); w8.y = cvt4_fp8(q[k][0], q[k][1], q[k][2], q[k][3]); *(u32x2*)(F.ws + WS_XB8 + ik * 8) = w8; } } } }
    { const float* rw = a.in[16]; bf16* hi = (bf16*)(F.ws + WS_RWT); bf16* lo = hi + NE * DM;
      for (int i = gw * 64 + F.lane; i < NE * DM; i += NGW * 64) { const int e = i >> 11, k = i & 2047; const float v = rw[k * NE + e];
          const unsigned h = cvt_pk_bf16(v, 0.f) & 0xffffu; const float r = v - __uint_as_float(h << 16);
          hi[i] = (bf16)h; lo[i] = (bf16)(cvt_pk_bf16(r, 0.f) & 0xffffu); } }
}

typedef float f32x16 __attribute__((ext_vector_type(16)));
constexpr int RK_OFF = 0, RV_OFF = 65536, RP_OFF = 131072, RX_OFF = 147456;
#define RET_BAR() do { asm volatile("s_waitcnt vmcnt(0) lgkmcnt(0)" ::: "memory"); __builtin_amdgcn_s_barrier(); asm volatile("" ::: "memory"); } while (0)
#define RET_BAR_L() do { asm volatile("s_waitcnt lgkmcnt(0)" ::: "memory"); __builtin_amdgcn_s_barrier(); asm volatile("" ::: "memory"); } while (0)
__device__ __forceinline__ void retention_qtile(Frame& F, const bf16* Q, const bf16* Kk, const bf16* VT, const bf16* Gs, unsigned char* MIX8, int b, int h, int I) {
    int lane_ = F.lane; asm volatile("" : "+v"(lane_));
    const int w = F.wave, rg = w & 3, hf = w >> 2, l31 = lane_ & 31, hh = lane_ >> 5;
    LAS unsigned char* Ks = F.lds + RK_OFF; LAS unsigned char* Vs = F.lds + RV_OFF; LAS unsigned char* Ps = F.lds + RP_OFF; LAS float* Xs = (LAS float*)(F.lds + RX_OFF);
    const int ipos = I * 128 + rg * 32 + l31; const size_t tok = (size_t)b * SEQ + ipos;
    bf16x8 qf[16];
#pragma unroll
    for (int ks = 0; ks < 16; ++ks) qf[ks] = *(const bf16x8*)(Q + tok * RW + h * HD + ks * 16 + hh * 8);
    f32x16 oacc[4];
#pragma unroll
    for (int e = 0; e < 4; ++e)
#pragma unroll
        for (int r = 0; r < 16; ++r) oacc[e][r] = 0.f;
    const int nJ = 2 * I + 2;
    const char* kbase = (const char*)(Kk + ((size_t)b * SEQ) * RW + h * HD); const char* vbase = (const char*)(VT + ((size_t)h * HD) * T + (size_t)b * SEQ);
    const int krow = w * 2 + (lane_ >> 5), vrow = w * 8 + (lane_ >> 3);
    const unsigned ko0 = (unsigned)(krow * RW * 2 + ((l31 ^ (krow & 15)) * 16)), vo0 = (unsigned)(vrow * T * 2 + (((lane_ & 7) ^ ((vrow >> 1) & 7)) * 16));
#define RET_DMA_KV(J) do { const char* kb_ = kbase + (size_t)(J) * (64 * RW * 2); const char* vb_ = vbase + (size_t)(J) * 128; const int bo_ = ((J) & 1) * 32768; \
        unsigned ko_ = ko0, vo_ = vo0; asm volatile("" : "+v"(ko_), "+v"(vo_)); \
        _Pragma("unroll") for (int k = 0; k < 4; ++k) __builtin_amdgcn_global_load_lds((const unsigned*)(kb_ + (ko_ + (unsigned)k * (unsigned)(16 * RW * 2))), (LAS unsigned*)(Ks + bo_ + (k * 512 + w * 64) * 16), 16, 0, 0); \
        _Pragma("unroll") for (int k = 0; k < 4; ++k) __builtin_amdgcn_global_load_lds((const unsigned*)(vb_ + (vo_ + (unsigned)k * (unsigned)(64 * T * 2))), (LAS unsigned*)(Vs + bo_ + (k * 512 + w * 64) * 16), 16, 0, 0); } while (0)
    const int kr = 32 * hf + l31, kx = kr & 15; const int pr = 32 * rg + l31, px = (pr >> 1) & 7; const int vx = (l31 >> 1) & 7;
    LAS unsigned char* pp = Ps + pr * 128;
    unsigned ka[8], pa[4], va[4];
#pragma unroll
    for (int m = 0; m < 8; ++m) ka[m] = (unsigned)(size_t)(Ks + kr * 512 + (((2 * m + hh) ^ kx) * 16));
#pragma unroll
    for (int m = 0; m < 4; ++m) { pa[m] = (unsigned)(size_t)(Ps + pr * 128 + (((2 * m + hh) ^ px) * 16)); va[m] = (unsigned)(size_t)(Vs + (128 * hf + l31) * 128 + (((2 * m + hh) ^ vx) * 16)); }
#define DSR128(dst, addr, off) asm volatile("ds_read_b128 %0, %1 offset:" #off : "=v"(dst) : "v"(addr) : "memory")
#define WAITL(n) do { asm volatile("s_waitcnt lgkmcnt(" #n ")" ::: "memory"); __builtin_amdgcn_sched_barrier(0); } while (0)
#define SBAR() __builtin_amdgcn_sched_barrier(0)
#define RET_DMA_K(J_) do { const char* kb_ = kbase + (size_t)(J_) * (64 * RW * 2); const int bo_ = ((J_) & 1) * 32768; unsigned ko_ = ko0; asm volatile("" : "+v"(ko_)); \
        _Pragma("unroll") for (int k = 0; k < 4; ++k) __builtin_amdgcn_global_load_lds((const unsigned*)(kb_ + (ko_ + (unsigned)k * (unsigned)(16 * RW * 2))), (LAS unsigned*)(Ks + bo_ + (k * 512 + w * 64) * 16), 16, 0, 0); } while (0)
#define RET_DMA_V(J_) do { const char* vb_ = vbase + (size_t)(J_) * 128; const int bo_ = ((J_) & 1) * 32768; unsigned vo_ = vo0; asm volatile("" : "+v"(vo_)); \
        _Pragma("unroll") for (int k = 0; k < 4; ++k) __builtin_amdgcn_global_load_lds((const unsigned*)(vb_ + (vo_ + (unsigned)k * (unsigned)(64 * T * 2))), (LAS unsigned*)(Vs + bo_ + (k * 512 + w * 64) * 16), 16, 0, 0); } while (0)
#define RET_BARV(n) do { asm volatile("s_waitcnt vmcnt(" #n ")" ::: "memory"); __builtin_amdgcn_s_barrier(); asm volatile("" ::: "memory"); } while (0)
    bf16x8 f0, f1, f2, f3;
    RET_DMA_K(0); RET_DMA_V(0); RET_DMA_K(1);
    RET_BARV(8);
    SBAR(); DSR128(f0, ka[0], 0); DSR128(f1, ka[1], 0); DSR128(f2, ka[2], 0); DSR128(f3, ka[3], 0); SBAR();
    for (int J = 0; J < nJ; ++J) {
        const bool hasn = (J + 1 < nJ);
        if (hasn) RET_BARV(4); else RET_BARV(0);
        if (hasn) RET_DMA_V(J + 1);
        const unsigned bofs = (unsigned)((J & 1) * 32768);
        unsigned kaj[8], vaj[4];
#pragma unroll
        for (int m = 0; m < 8; ++m) kaj[m] = ka[m] + bofs;
#pragma unroll
        for (int m = 0; m < 4; ++m) vaj[m] = va[m] + bofs;
        f32x16 sacc;
#pragma unroll
        for (int r = 0; r < 16; ++r) sacc[r] = 0.f;
        {
#define RET_S1(fr, ks, cnt, nxt) WAITL(cnt); sacc = __builtin_amdgcn_mfma_f32_32x32x16_bf16(fr, qf[ks], sacc, 0, 0, 0); SBAR(); nxt; SBAR();
            RET_S1(f0, 0, 3, DSR128(f0, kaj[4], 0)) RET_S1(f1, 1, 3, DSR128(f1, kaj[5], 0)) RET_S1(f2, 2, 3, DSR128(f2, kaj[6], 0)) RET_S1(f3, 3, 3, DSR128(f3, kaj[7], 0))
            RET_S1(f0, 4, 3, DSR128(f0, kaj[0], 256)) RET_S1(f1, 5, 3, DSR128(f1, kaj[1], 256)) RET_S1(f2, 6, 3, DSR128(f2, kaj[2], 256)) RET_S1(f3, 7, 3, DSR128(f3, kaj[3], 256))
            RET_S1(f0, 8, 3, DSR128(f0, kaj[4], 256)) RET_S1(f1, 9, 3, DSR128(f1, kaj[5], 256)) RET_S1(f2, 10, 3, DSR128(f2, kaj[6], 256)) RET_S1(f3, 11, 3, DSR128(f3, kaj[7], 256))
            RET_S1(f0, 12, 3, (void)0) RET_S1(f1, 13, 2, (void)0) RET_S1(f2, 14, 1, (void)0) RET_S1(f3, 15, 0, (void)0)
#undef RET_S1
        }
        if (J * 64 + 63 > I * 128 + rg * 32) { const int d0 = ipos - J * 64 - 32 * hf - 4 * hh;
#pragma unroll
            for (int r = 0; r < 16; ++r) sacc[r] = (d0 >= (r & 3) + 8 * (r >> 2)) ? sacc[r] : 0.f; }
#pragma unroll
        for (int q = 0; q < 4; ++q) { u32x2 pw; pw.x = cvt_pk_bf16(sacc[4 * q], sacc[4 * q + 1]); pw.y = cvt_pk_bf16(sacc[4 * q + 2], sacc[4 * q + 3]);
            *(LAS u32x2*)(pp + (((4 * hf + q) ^ px) * 16) + 8 * hh) = pw; }
        bf16x8 pA, pB, v0, v1, v2, v3;
        SBAR(); DSR128(v0, vaj[0], 0); DSR128(v1, vaj[0], 4096); DSR128(v2, vaj[0], 8192); DSR128(v3, vaj[0], 12288); SBAR();
        asm volatile("s_waitcnt lgkmcnt(4)" ::: "memory");
        RET_BARV(4);
        if (J + 2 < nJ) RET_DMA_K(J + 2);
        {
            SBAR(); DSR128(pA, pa[0], 0); DSR128(pB, pa[1], 0);
#define RET_S2(vr, pr_, et, cnt, nxt) WAITL(cnt); oacc[et] = __builtin_amdgcn_mfma_f32_32x32x16_bf16(vr, pr_, oacc[et], 0, 0, 0); SBAR(); nxt; SBAR();
            RET_S2(v0, pA, 0, 1, DSR128(v0, vaj[1], 0)) RET_S2(v1, pA, 1, 2, DSR128(v1, vaj[1], 4096)) RET_S2(v2, pA, 2, 3, DSR128(v2, vaj[1], 8192)) RET_S2(v3, pA, 3, 4, DSR128(v3, vaj[1], 12288))
            SBAR(); DSR128(pA, pa[2], 0);
            RET_S2(v0, pB, 0, 4, DSR128(v0, vaj[2], 0)) RET_S2(v1, pB, 1, 4, DSR128(v1, vaj[2], 4096)) RET_S2(v2, pB, 2, 4, DSR128(v2, vaj[2], 8192)) RET_S2(v3, pB, 3, 4, DSR128(v3, vaj[2], 12288))
            SBAR(); DSR128(pB, pa[3], 0);
            RET_S2(v0, pA, 0, 4, DSR128(v0, vaj[3], 0)) RET_S2(v1, pA, 1, 4, DSR128(v1, vaj[3], 4096)) RET_S2(v2, pA, 2, 4, DSR128(v2, vaj[3], 8192)) RET_S2(v3, pA, 3, 4, DSR128(v3, vaj[3], 12288))
            RET_S2(v0, pB, 0, 3, (void)0) RET_S2(v1, pB, 1, 2, (void)0) RET_S2(v2, pB, 2, 1, (void)0) RET_S2(v3, pB, 3, 0, (void)0)
#undef RET_S2
        }
        if (hasn) { const unsigned bn = (unsigned)(((J + 1) & 1) * 32768);
            SBAR(); DSR128(f0, ka[0] + bn, 0); DSR128(f1, ka[1] + bn, 0); DSR128(f2, ka[2] + bn, 0); DSR128(f3, ka[3] + bn, 0); SBAR(); }
    }
#undef RET_DMA_K
#undef RET_DMA_V
#undef RET_BARV
#undef RET_DMA_KV
#undef DSR128
#undef WAITL
#undef SBAR
    float s1 = 0.f, s2 = 0.f;
#pragma unroll
    for (int et = 0; et < 4; ++et)
#pragma unroll
        for (int r = 0; r < 16; ++r) { s1 += oacc[et][r]; s2 += oacc[et][r] * oacc[et][r]; }
    s1 += __shfl_xor(s1, 32); s2 += __shfl_xor(s2, 32);
    if (hh == 0) { Xs[(hf * 128 + pr) * 2] = s1; Xs[(hf * 128 + pr) * 2 + 1] = s2; }
    RET_BAR();
    s1 += Xs[((hf ^ 1) * 128 + pr) * 2]; s2 += Xs[((hf ^ 1) * 128 + pr) * 2 + 1];
    const float mean = s1 * (1.0f / 256.0f); const float var = fmaxf(s2 * (1.0f / 256.0f) - mean * mean, 0.f);
    const float rstd = 1.0f / sqrtf(var + LN_EPS);
    u32x2 gvv[4][4];
#pragma unroll
    for (int et = 0; et < 4; ++et)
#pragma unroll
        for (int q = 0; q < 4; ++q) gvv[et][q] = *(const u32x2*)(Gs + tok * RW + h * HD + 128 * hf + 32 * et + 8 * q + 4 * hh);
#pragma unroll
    for (int et = 0; et < 4; ++et) { unsigned d[4];
#pragma unroll
        for (int q = 0; q < 4; ++q) { const u32x2 gv = gvv[et][q];
            d[q] = cvt4_fp8((oacc[et][4 * q] - mean) * rstd * bflo(gv.x), (oacc[et][4 * q + 1] - mean) * rstd * bfhi(gv.x),
                            (oacc[et][4 * q + 2] - mean) * rstd * bflo(gv.y), (oacc[et][4 * q + 3] - mean) * rstd * bfhi(gv.y)); }
        const unsigned r0 = (unsigned)__shfl_xor((int)(hh ? d[0] : d[2]), 32), r1 = (unsigned)__shfl_xor((int)(hh ? d[1] : d[3]), 32);
        u32x4 w; w.x = hh ? r0 : d[0]; w.y = hh ? d[2] : r0; w.z = hh ? r1 : d[1]; w.w = hh ? d[3] : r1;
        *(u32x4*)(MIX8 + tok * DM + h * HD + 128 * hf + 32 * et + 16 * hh) = w; }
    RET_BAR();
}

constexpr int S5A_OFF = 0, S5I_OFF = 65536, S5E_OFF = S5I_OFF + 128 * 129 * 4;
__device__ __forceinline__ void s5in_pair(Frame& F, bf16* U2, const bf16* Min, const float* A16, int g, int b0) {
    const int l15 = F.lane & 15, g4 = F.lane >> 4, w = F.wave;
    LAS unsigned char* As = F.lds + S5A_OFF; LAS float* inc = (LAS float*)(F.lds + S5I_OFF); LAS float* Es = (LAS float*)(F.lds + S5E_OFF);
#define S5_STAGE(bb) do { const char* ub = (const char*)(U2 + (size_t)(g * 1024 + (bb) * 128) * KS5); const int row0 = w * 2 + (F.lane >> 5); \
      const unsigned so = (unsigned)(row0 * KS5 * 2 + (((F.lane & 31) ^ (row0 & 15)) * 16)); \
      _Pragma("unroll") for (int k = 0; k < 8; ++k) pg8::glds16s(ub + (size_t)k * (16 * KS5 * 2), so, (unsigned)(size_t)As + (unsigned)((k * 512 + w * 64) * 16)); } while (0)
    S5_STAGE(b0);
    bf16x8 bfr[8];
#pragma unroll
    for (int ks = 0; ks < 8; ++ks) bfr[ks] = *(const bf16x8*)(Min + (size_t)(w * 16 + l15) * 256 + ks * 32 + g4 * 8);
    const float a16r = A16[F.lane * 2], a16i = A16[F.lane * 2 + 1];
#pragma nounroll
    for (int ub_ = 0; ub_ < 2; ++ub_) { const int b = b0 + ub_;
    asm volatile("s_waitcnt vmcnt(0)" ::: "memory"); __syncthreads();
#pragma unroll 2
    for (int ct = 0; ct < 8; ++ct) { f32x4 acc = (f32x4){0.f, 0.f, 0.f, 0.f}; const int row = ct * 16 + l15;
#pragma unroll
        for (int ks = 0; ks < 8; ++ks) { const bf16x8 af = *(const LAS bf16x8*)(As + row * 512 + (((4 * ks + g4) ^ (row & 15)) * 16));
            acc = __builtin_amdgcn_mfma_f32_16x16x32_bf16(af, bfr[ks], acc, 0, 0, 0); }
#pragma unroll
        for (int r = 0; r < 4; ++r) inc[(ct * 16 + 4 * g4 + r) * 129 + w * 16 + l15] = acc[r]; }
    __syncthreads();
    if (ub_ == 0) S5_STAGE(b0 + 1);
    { const int p = F.lane, seg = w; const float ar = a16r, ai = a16i;
      float hr = 0.f, hi = 0.f;
#pragma unroll 4
      for (int j = 0; j < 16; ++j) { const int c = seg * 16 + j; const float ir = inc[c * 129 + p], ii = inc[c * 129 + 64 + p];
          const float nr = ar * hr - ai * hi + ir, ni = ar * hi + ai * hr + ii; hr = nr; hi = ni; }
      Es[(seg * 64 + p) * 2] = hr; Es[(seg * 64 + p) * 2 + 1] = hi;
      float pr = ar, pi = ai;
#pragma unroll
      for (int q = 0; q < 4; ++q) { const float t = pr * pr - pi * pi; pi = 2.f * pr * pi; pr = t; }
      LDS_WAIT(); __builtin_amdgcn_s_barrier(); asm volatile("" ::: "memory");
      float sr = 0.f, si = 0.f;
      for (int j = 0; j < seg; ++j) { const float er = Es[(j * 64 + p) * 2], ei = Es[(j * 64 + p) * 2 + 1]; const float nr = pr * sr - pi * si + er, ni = pr * si + pi * sr + ei; sr = nr; si = ni; }
      hr = sr; hi = si;
      bf16* row = U2 + (size_t)(g * 1024 + b * 128 + seg * 16) * KS5 + 256 + p;
#pragma unroll 4
      for (int j = 0; j < 16; ++j) { const int c = seg * 16 + j;
          row[(size_t)j * KS5] = (bf16)(cvt_pk_bf16(hr, 0.f) & 0xffffu); row[(size_t)j * KS5 + 64] = (bf16)(cvt_pk_bf16(hi, 0.f) & 0xffffu);
          const float ir = inc[c * 129 + p], ii = inc[c * 129 + 64 + p];
          const float nr = ar * hr - ai * hi + ir, ni = ar * hi + ai * hr + ii; hr = nr; hi = ni; }
    }
    LDS_WAIT(); __builtin_amdgcn_s_barrier(); asm volatile("" ::: "memory");
    }
    asm volatile("s_waitcnt vmcnt(0)" ::: "memory"); __syncthreads();
#undef S5_STAGE
}

__device__ __forceinline__ void ln1_router_unit(Frame& F, const Args& a, int layer, int unit) {
    const int l15 = F.lane & 15, g4 = F.lane >> 4, w = F.wave;
    const bf16* Zb = (const bf16*)(F.ws + WS_Z); unsigned char* X1F8 = F.ws + WS_XF; float* stats = (float*)(F.ws + WS_Z + 64 * MiB);
    const float* gam = a.in[12] + layer * DM; const float* bet = a.in[13] + layer * DM;
    LAS int* lcnt = (LAS int*)(F.lds + TST_OFF + 640); LAS int* lbase = lcnt + 32;
    if (F.tid < 32) lcnt[F.tid] = 0;
    const int r0 = unit * 64;
    LAS unsigned char* x1s = F.lds;
    LAS float* gl = (LAS float*)(F.lds + 131584);
    const f32x4 gst = *(const f32x4*)(gam + 4 * F.tid), bst = *(const f32x4*)(bet + 4 * F.tid);
    LAS float* sts = (LAS float*)(F.lds + 147968);
    f32x4 acc[4][2];
#pragma unroll
    for (int rt = 0; rt < 4; ++rt) { acc[rt][0] = (f32x4){0.f, 0.f, 0.f, 0.f}; acc[rt][1] = (f32x4){0.f, 0.f, 0.f, 0.f}; }
    {
        u32x4 xin[8][4];
#pragma unroll
        for (int rr = 0; rr < 8; ++rr)
#pragma unroll
            for (int j = 0; j < 4; ++j) xin[rr][j] = __builtin_nontemporal_load((const u32x4*)(Zb + (size_t)(r0 + 32 * (rr >> 2) + 4 * w + (rr & 3)) * DM + 8 * F.lane + 512 * j));
        *(LAS f32x4*)(gl + 4 * F.tid) = gst; *(LAS f32x4*)(gl + DM + 4 * F.tid) = bst;
        LDS_WAIT(); __builtin_amdgcn_s_barrier(); asm volatile("" ::: "memory");
        size_t zo_ = 0; asm volatile("" : "+s"(zo_));
        const bf16* rwh = (const bf16*)(F.ws + WS_RWT) + zo_ + (size_t)l15 * DM + w * 256 + g4 * 8; const bf16* rwl = rwh + NE * DM;
#pragma unroll
        for (int p = 0; p < 2; ++p) {
#pragma unroll
            for (int q4 = 0; q4 < 4; ++q4) { const int rr = 4 * p + q4; const int lr = 4 * w + q4; float v[4][8]; float s = 0.f;
                unsigned go_ = (unsigned)(8 * F.lane); asm volatile("" : "+v"(go_));
#pragma unroll
                for (int j = 0; j < 4; ++j) { const u32x4 x = xin[rr][j];
                    v[j][0] = bflo(x.x); v[j][1] = bfhi(x.x); v[j][2] = bflo(x.y); v[j][3] = bfhi(x.y); v[j][4] = bflo(x.z); v[j][5] = bfhi(x.z); v[j][6] = bflo(x.w); v[j][7] = bfhi(x.w);
#pragma unroll
                    for (int q = 0; q < 8; ++q) s += v[j][q]; }
                const float mean = wave_sum(s) * (1.0f / DM); float s2 = 0.f;
#pragma unroll
                for (int j = 0; j < 4; ++j)
#pragma unroll
                    for (int q = 0; q < 8; ++q) { v[j][q] -= mean; s2 += v[j][q] * v[j][q]; }
                const float rstd = 1.0f / sqrtf(wave_sum(s2) * (1.0f / DM) + LN_EPS);
                if (F.lane == 0) { sts[(32 * p + lr) * 2] = mean; sts[(32 * p + lr) * 2 + 1] = rstd; }
#pragma unroll
                for (int j = 0; j < 4; ++j) { const f32x4 g0 = *(const LAS f32x4*)(gl + go_ + 512 * j), g1 = *(const LAS f32x4*)(gl + go_ + 512 * j + 4), b0 = *(const LAS f32x4*)(gl + DM + go_ + 512 * j), b1 = *(const LAS f32x4*)(gl + DM + go_ + 512 * j + 4);
                    u32x4 pk; pk.x = cvt_pk_bf16(v[j][0] * rstd * g0[0] + b0[0], v[j][1] * rstd * g0[1] + b0[1]); pk.y = cvt_pk_bf16(v[j][2] * rstd * g0[2] + b0[2], v[j][3] * rstd * g0[3] + b0[3]);
                    pk.z = cvt_pk_bf16(v[j][4] * rstd * g1[0] + b1[0], v[j][5] * rstd * g1[1] + b1[1]); pk.w = cvt_pk_bf16(v[j][6] * rstd * g1[2] + b1[2], v[j][7] * rstd * g1[3] + b1[3]);
                    *(LAS u32x4*)(x1s + lr * 4112 + (8 * F.lane + 512 * j) * 2) = pk;
                    u32x2 p8; p8.x = cvt4_fp8(bflo(pk.x), bfhi(pk.x), bflo(pk.y), bfhi(pk.y)); p8.y = cvt4_fp8(bflo(pk.z), bfhi(pk.z), bflo(pk.w), bfhi(pk.w));
                    *(u32x2*)(X1F8 + (size_t)(r0 + 32 * p + lr) * DM + 8 * F.lane + 512 * j) = p8; }
            }
            LDS_WAIT(); __builtin_amdgcn_s_barrier(); asm volatile("" ::: "memory");
#pragma nounroll
            for (int s0 = 0; s0 < 8; s0 += 4) {
                bf16x8 ah[4][2], bh[4][2], bl[4][2];
#pragma unroll
                for (int i = 0; i < 4; ++i) {
#pragma unroll
                    for (int t = 0; t < 2; ++t) ah[i][t] = *(const LAS bf16x8*)(x1s + (t * 16 + l15) * 4112 + (w * 256 + (s0 + i) * 32 + g4 * 8) * 2);
#pragma unroll
                    for (int n = 0; n < 2; ++n) { bh[i][n] = *(const bf16x8*)(rwh + (size_t)n * 16 * DM + (s0 + i) * 32); bl[i][n] = *(const bf16x8*)(rwl + (size_t)n * 16 * DM + (s0 + i) * 32); } }
#pragma unroll
                for (int i = 0; i < 4; ++i)
#pragma unroll
                    for (int t = 0; t < 2; ++t)
#pragma unroll
                        for (int n = 0; n < 2; ++n) { acc[2 * p + t][n] = __builtin_amdgcn_mfma_f32_16x16x32_bf16(ah[i][t], bh[i][n], acc[2 * p + t][n], 0, 0, 0);
                            acc[2 * p + t][n] = __builtin_amdgcn_mfma_f32_16x16x32_bf16(ah[i][t], bl[i][n], acc[2 * p + t][n], 0, 0, 0); } }
            LDS_WAIT(); __builtin_amdgcn_s_barrier(); asm volatile("" ::: "memory");
        }
    }
    {
      LAS float* part = (LAS float*)F.lds;
#pragma unroll
      for (int rt = 0; rt < 4; ++rt)
#pragma unroll
          for (int n = 0; n < 2; ++n)
#pragma unroll
              for (int r = 0; r < 4; ++r) part[(w * 64 + rt * 16 + 4 * g4 + r) * 33 + n * 16 + l15] = acc[rt][n][r];
    }
    __syncthreads();
    { LAS float* part = (LAS float*)F.lds; LAS float* lsum = part + 8 * 64 * 33;
      const int row = F.tid >> 3, eb = (F.tid & 7) * 4;
#pragma unroll
      for (int j = 0; j < 4; ++j) { float sacc_ = 0.f;
#pragma unroll
          for (int k = 0; k < 8; ++k) sacc_ += part[(k * 64 + row) * 33 + eb + j];
          lsum[row * 33 + eb + j] = sacc_; } }
    __syncthreads();
    int e0 = 0, e1 = 0, rk0 = 0, rk1 = 0; float w0 = 0.f, w1 = 0.f;
    if (F.tid < 64) { const LAS float* part = (const LAS float*)F.lds; const float* rb = a.in[17];
        float lgt[32]; float mx = -3.0e38f;
#pragma unroll
        for (int e = 0; e < 32; ++e) { lgt[e] = part[(8 * 64 + F.tid) * 33 + e] + rb[e]; mx = fmaxf(mx, lgt[e]); }
        float bs = -1.f; float ba1 = 0.f, ba2 = 0.f; int bi1 = 0, bi2 = 0;
#pragma unroll
        for (int gi = 0; gi < 4; ++gi) { float a1 = -3.0e38f, a2 = -3.0e38f; int i1 = 0, i2 = 0;
#pragma unroll
            for (int j = 0; j < 8; ++j) { const float v = lgt[gi * 8 + j]; if (v > a1) { a2 = a1; i2 = i1; a1 = v; i1 = gi * 8 + j; } else if (v > a2) { a2 = v; i2 = gi * 8 + j; } }
            const float p1 = __expf(a1 - mx), p2 = __expf(a2 - mx), sc = p1 + p2;
            if (sc > bs) { bs = sc; ba1 = p1; ba2 = p2; bi1 = i1; bi2 = i2; } }
        e0 = bi1; e1 = bi2; w0 = ba1 / (ba1 + ba2); w1 = ba2 / (ba1 + ba2);
        rk0 = __hip_atomic_fetch_add(lcnt + e0, 1, __ATOMIC_RELAXED, __HIP_MEMORY_SCOPE_WORKGROUP);
        rk1 = __hip_atomic_fetch_add(lcnt + e1, 1, __ATOMIC_RELAXED, __HIP_MEMORY_SCOPE_WORKGROUP);
    }
    __syncthreads();
    if (F.tid < 32) lbase[F.tid] = (int)__hip_atomic_fetch_add(F.ctl + CW_CNT + (layer * NE + F.tid) * 64, (unsigned)lcnt[F.tid], __ATOMIC_RELAXED, __HIP_MEMORY_SCOPE_AGENT);
    __syncthreads();
    if (F.tid < 64) { const int tok = r0 + F.tid; const int s0 = lbase[e0] + rk0, s1 = lbase[e1] + rk1;
        int* list = (int*)(F.ws + WS_LIST); list[e0 * T + s0] = tok; list[e1 * T + s1] = tok;
        i32x4* ti = (i32x4*)(F.ws + WS_TOK) + (size_t)tok * 2;
        ti[0] = (i32x4){e0, s0, e1, s1}; ti[1] = (i32x4){(int)__float_as_uint(w0), (int)__float_as_uint(w1), 0, 0}; }
    if (F.tid < 64) { f32x2 st; st[0] = sts[F.tid * 2]; st[1] = sts[F.tid * 2 + 1]; *(f32x2*)(stats + (size_t)(r0 + F.tid) * 2) = st; }
    __syncthreads();
}

__device__ __forceinline__ void moe_setup(Frame& F, int layer) {
    LAS int* cnt = (LAS int*)(F.lds + TST_OFF); LAS int* pst = cnt + 32; LAS int* fst = pst + 33; LAS int* hst = fst + 33;
    __syncthreads();
    if (F.tid < 32) cnt[F.tid] = (int)__hip_atomic_load(F.ctl + CW_CNT + (layer * NE + F.tid) * 64, __ATOMIC_RELAXED, __HIP_MEMORY_SCOPE_AGENT);
    __syncthreads();
    if (F.tid < 64) {
        const int e = F.tid; int c = e < NE ? cnt[e & 31] : 0; c = c < 0 ? 0 : (c > T ? T : c); const int t = (c + 127) >> 7, f = t >> 1, hb = t & 1;
        int st = t, sf = f, sh = hb;
#pragma unroll
        for (int o = 1; o < 32; o <<= 1) { const int a = __shfl_up(st, o), b = __shfl_up(sf, o), d = __shfl_up(sh, o); if (e >= o) { st += a; sf += b; sh += d; } }
        if (e < NE) { pst[e] = st - t; fst[e] = sf - f; hst[e] = sh - hb; }
        if (e == NE - 1) { pst[NE] = st; fst[NE] = sf; hst[NE] = sh; } }
    __syncthreads();
}

constexpr int LN2R = 2;
__device__ __forceinline__ void ln2_rows(Frame& F, const LAS float* gl, const int (&toks)[LN2R], float* outf, bf16* outb) {
    const LAS int* pst = (const LAS int*)(F.lds + TST_OFF) + 32;
    i32x4 inf[LN2R][2];
#pragma unroll
    for (int r = 0; r < LN2R; ++r) { const i32x4* ti = (const i32x4*)(F.ws + WS_TOK) + (size_t)toks[r] * 2; inf[r][0] = ti[0]; inf[r][1] = ti[1]; }
    u32x4 xx[LN2R][4]; u32x2 pa[LN2R][4], pb[LN2R][4]; f32x2 stv[LN2R];
#pragma unroll
    for (int r = 0; r < LN2R; ++r) { const int tok = toks[r]; const int e0 = inf[r][0][0] & 31, e1 = inf[r][0][2] & 31;
        const size_t ra = (size_t)pst[e0] * 128 + inf[r][0][1], rb = (size_t)pst[e1] * 128 + inf[r][0][3];
        const bf16* x1 = (const bf16*)(F.ws + WS_Z) + (size_t)tok * DM + 8 * F.lane;
        stv[r] = *(const f32x2*)((const float*)(F.ws + WS_Z + 64 * MiB) + (size_t)tok * 2);
        const unsigned char* ya = F.ws + WS_YB + ra * DM + 8 * F.lane; const unsigned char* yb = F.ws + WS_YB + rb * DM + 8 * F.lane;
#pragma unroll
        for (int j = 0; j < 4; ++j) { xx[r][j] = __builtin_nontemporal_load((const u32x4*)(x1 + 512 * j)); pa[r][j] = __builtin_nontemporal_load((const u32x2*)(ya + 512 * j)); pb[r][j] = __builtin_nontemporal_load((const u32x2*)(yb + 512 * j)); } }
    float wts[LN2R][2];
#pragma unroll
    for (int r = 0; r < LN2R; ++r) { wts[r][0] = __uint_as_float((unsigned)inf[r][1][0]) * 0.0625f; wts[r][1] = __uint_as_float((unsigned)inf[r][1][1]) * 0.0625f; }
#pragma unroll
    for (int r = 0; r < LN2R; ++r) { const int tok = toks[r];
        const float w0 = wts[r][0], w1 = wts[r][1];
        float v[4][8]; float s = 0.f;
        const float m1 = stv[r][0], r1 = stv[r][1];
        unsigned g1o_ = (unsigned)(8 * F.lane); asm volatile("" : "+v"(g1o_));
#pragma unroll
        for (int j = 0; j < 4; ++j) { const u32x4 x = xx[r][j]; const u32x2 p = pa[r][j], q = pb[r][j];
            const f32x4 ga = *(const LAS f32x4*)(gl + 2 * DM + g1o_ + 512 * j), gb = *(const LAS f32x4*)(gl + 2 * DM + g1o_ + 512 * j + 4), ba = *(const LAS f32x4*)(gl + 3 * DM + g1o_ + 512 * j), bb = *(const LAS f32x4*)(gl + 3 * DM + g1o_ + 512 * j + 4);
            float x1v[8];
            x1v[0] = (bflo(x.x) - m1) * r1 * ga[0] + ba[0]; x1v[1] = (bfhi(x.x) - m1) * r1 * ga[1] + ba[1]; x1v[2] = (bflo(x.y) - m1) * r1 * ga[2] + ba[2]; x1v[3] = (bfhi(x.y) - m1) * r1 * ga[3] + ba[3];
            x1v[4] = (bflo(x.z) - m1) * r1 * gb[0] + bb[0]; x1v[5] = (bfhi(x.z) - m1) * r1 * gb[1] + bb[1]; x1v[6] = (bflo(x.w) - m1) * r1 * gb[2] + bb[2]; x1v[7] = (bfhi(x.w) - m1) * r1 * gb[3] + bb[3];
            const f32x2 p0 = __builtin_amdgcn_cvt_pk_f32_fp8((int)p.x, false), p1 = __builtin_amdgcn_cvt_pk_f32_fp8((int)p.x, true), p2 = __builtin_amdgcn_cvt_pk_f32_fp8((int)p.y, false), p3 = __builtin_amdgcn_cvt_pk_f32_fp8((int)p.y, true);
            const f32x2 q0 = __builtin_amdgcn_cvt_pk_f32_fp8((int)q.x, false), q1 = __builtin_amdgcn_cvt_pk_f32_fp8((int)q.x, true), q2 = __builtin_amdgcn_cvt_pk_f32_fp8((int)q.y, false), q3 = __builtin_amdgcn_cvt_pk_f32_fp8((int)q.y, true);
            v[j][0] = ALPHA * x1v[0] + w0 * p0[0] + w1 * q0[0]; v[j][1] = ALPHA * x1v[1] + w0 * p0[1] + w1 * q0[1];
            v[j][2] = ALPHA * x1v[2] + w0 * p1[0] + w1 * q1[0]; v[j][3] = ALPHA * x1v[3] + w0 * p1[1] + w1 * q1[1];
            v[j][4] = ALPHA * x1v[4] + w0 * p2[0] + w1 * q2[0]; v[j][5] = ALPHA * x1v[5] + w0 * p2[1] + w1 * q2[1];
            v[j][6] = ALPHA * x1v[6] + w0 * p3[0] + w1 * q3[0]; v[j][7] = ALPHA * x1v[7] + w0 * p3[1] + w1 * q3[1];
#pragma unroll
            for (int t = 0; t < 8; ++t) s += v[j][t]; }
        const float mean = wave_sum(s) * (1.0f / DM); float s2 = 0.f;
#pragma unroll
        for (int j = 0; j < 4; ++j)
#pragma unroll
            for (int t = 0; t < 8; ++t) { v[j][t] -= mean; s2 += v[j][t] * v[j][t]; }
        const float rstd = 1.0f / sqrtf(wave_sum(s2) * (1.0f / DM) + LN_EPS);
        unsigned go_ = (unsigned)(8 * F.lane); asm volatile("" : "+v"(go_));
#pragma unroll
        for (int j = 0; j < 4; ++j) { const f32x4 g0 = *(const LAS f32x4*)(gl + go_ + 512 * j), g1 = *(const LAS f32x4*)(gl + go_ + 512 * j + 4), b0 = *(const LAS f32x4*)(gl + DM + go_ + 512 * j), b1 = *(const LAS f32x4*)(gl + DM + go_ + 512 * j + 4);
            f32x4 o0, o1;
#pragma unroll
            for (int t = 0; t < 4; ++t) { o0[t] = v[j][t] * rstd * g0[t] + b0[t]; o1[t] = v[j][4 + t] * rstd * g1[t] + b1[t]; }
            if (outf) { float* op = outf + (size_t)tok * DM + 8 * F.lane + 512 * j; __builtin_nontemporal_store(o0, (f32x4*)op); __builtin_nontemporal_store(o1, (f32x4*)(op + 4)); }
            if (outb) { u32x4 pk; pk.x = cvt_pk_bf16(o0[0], o0[1]); pk.y = cvt_pk_bf16(o0[2], o0[3]); pk.z = cvt_pk_bf16(o1[0], o1[1]); pk.w = cvt_pk_bf16(o1[2], o1[3]);
                __builtin_nontemporal_store(pk, (u32x4*)(outb + (size_t)tok * DM + 8 * F.lane + 512 * j));
                u32x2 p8; p8.x = cvt4_fp8(o0[0], o0[1], o0[2], o0[3]); p8.y = cvt4_fp8(o1[0], o1[1], o1[2], o1[3]); *(u32x2*)(F.ws + WS_XB8 + (size_t)tok * DM + 8 * F.lane + 512 * j) = p8; } }
    }
}

__global__ void __launch_bounds__(NWAVES * 64, 2) mk_fwd(Args args) {
    extern __shared__ __attribute__((aligned(16))) unsigned char lds_raw[];
    Frame F;
    F.lds = (LAS unsigned char*)lds_raw;
    F.tid = threadIdx.x; F.lane = F.tid & 63; F.wave = __builtin_amdgcn_readfirstlane(F.tid >> 6);
    F.G = gridDim.x; { const int bx = blockIdx.x; F.vcu = (F.G % 8 == 0) ? (bx % 8) * (F.G / 8) + bx / 8 : bx; }
    F.ws = args.ws; F.ctl = (unsigned*)(args.ws + WS_CTL);
    volatile LAS unsigned* MISC = (volatile LAS unsigned*)(F.lds + MISC_OFF);
    if (F.tid < 4) MISC[F.tid] = 0u;
    __syncthreads();
    XcdBarrier bar; bar.bar = F.ctl + CW_BAR; bar.x = 0; bar.st = MISC;
    if (MK_N_LAUNCHES == 1) bar = xcd_barrier_post(F.ctl + CW_BAR, MISC);
    const int lo = args.ph_lo, hi = args.ph_hi;
#ifndef ONLY_PHASE
#define ONLY_PHASE -1
#endif
#define PON(k) (ONLY_PHASE < 0 || ONLY_PHASE == (k))
#ifndef PROBE_PHASE
#define PROBE_PHASE -1
#endif
#define RPT(k) ((PROBE_PHASE == (k)) ? 2 : 1)
#define IN(k) (lo <= (k) && (k) < hi)
#define PHASE_FRAME Frame P = F; { size_t z_ = 0; asm volatile("" : "+s"(z_)); P.ws = F.ws + z_; P.wave = F.wave + (int)z_; } P.lane = (int)__builtin_amdgcn_mbcnt_hi(~0u, __builtin_amdgcn_mbcnt_lo(~0u, 0u)); asm volatile("" : "+v"(P.lane)); P.tid = P.wave * 64 + P.lane; P.ctl = (unsigned*)(P.ws + WS_CTL)
#define SEAM(k) do { if (IN(k) && IN((k) + 1)) xcd_barrier(bar); } while (0)

    if (PON(0) && IN(0)) { PHASE_FRAME; p0_prologue(P, args); __syncthreads(); }
    if (PROBE_PHASE == 0 && PON(0) && IN(0)) { PHASE_FRAME; p0_prologue(P, args); __syncthreads(); }
    SEAM(0);

    for (int layer = 0; layer < 2; ++layer) {
        const int pb = 1 + 9 * layer;
#define MIXCONV() do { const int c_ = P.vcu & 1, ng_ = (P.G >> 1) * NWAVES, g0_ = (P.vcu >> 1) * NWAVES + P.wave; \
            convert_items(P, args, TI_IN / 2 + c_ * (TI_IN / 4), TI_IN / 4, g0_, ng_); \
            convert_items(P, args, TI_IN + c_ * (TI_OUT / 2), TI_OUT / 2, (g0_ + ng_ - (TI_IN / 8) % ng_) % ng_, ng_); \
            convert_items(P, args, TI_IN + TI_OUT + c_ * (TI_GLU / 2), TI_GLU / 2, (g0_ + 2 * ng_ - (TI_IN / 8 + TI_OUT / 4) % ng_) % ng_, ng_); } while (0)
        if (PON(1) && IN(pb + 0)) for (int rp_ = 0; rp_ < RPT(1); ++rp_) {
            PHASE_FRAME;
            bf16* XB = (bf16*)(P.ws + WS_XB); float* XF = (float*)(P.ws + WS_XF);
            bf16* Qb = (bf16*)(P.ws + WS_Q); bf16* Kb = (bf16*)(P.ws + WS_K); bf16* Gb = (bf16*)(P.ws + WS_G); bf16* VT = (bf16*)(P.ws + WS_VT);
            bf16* U2 = (bf16*)(P.ws + WS_U2); bf16* Yb = (bf16*)(P.ws + WS_Y); bf16* MIX = (bf16*)(P.ws + WS_MIX); float* Z = (float*)(P.ws + WS_Z);
            bf16* X1B = (bf16*)(P.ws + WS_X1B); bf16* Hb = (bf16*)(P.ws + WS_H); bf16* YB = (bf16*)(P.ws + WS_YB);
            const bf16* Win = (const bf16*)(P.ws + WS_WIN) + (size_t)layer * NPROJ * DM;
            (void)XB; (void)XF; (void)Qb; (void)Kb; (void)Gb; (void)VT; (void)U2; (void)Yb; (void)MIX; (void)Z; (void)X1B; (void)Hb; (void)YB; (void)Win;
            { pg8::DenseOrder S; S.init(T, 4096, DM, P.G, (int)blockIdx.x, P.ws + WS_WIN + (size_t)layer * NPROJ * DM, 1);
              pg8::EpiInProj E{Qb, Kb, Gb, U2, (const float*)(P.ws + WS_COS), (const float*)(P.ws + WS_SIN)};
              if (layer == 0 && (P.vcu & 1) != 0) { MIXCONV(); __syncthreads(); }
              S.ulist = (const LAS int*)(P.lds + TST_OFF + 896); __syncthreads(); pg8::moe_units(S, (LAS int*)(P.lds + TST_OFF + 896), P.tid); __syncthreads();
              pg8::gemm_phase<true>(P.lds, P.tid, (const char*)(P.ws + WS_XB8), DM, S, E); }
            { pg8::DenseOrder S; S.init(1024, T, DM, P.G, (int)blockIdx.x, P.ws + WS_XB8, 1);
              pg8::EpiBf16 E{VT, T, W8_INV};
              S.ulist = (const LAS int*)(P.lds + TST_OFF + 896); __syncthreads(); pg8::moe_units(S, (LAS int*)(P.lds + TST_OFF + 896), P.tid); __syncthreads();
              pg8::gemm_phase<true>(P.lds, P.tid, (const char*)(P.ws + WS_WIN + ((size_t)layer * NPROJ + 4096) * DM), DM, S, E); }
            if (layer == 0 && (P.vcu & 1) == 0) { __syncthreads(); MIXCONV(); }
        }
        SEAM(pb + 0);

        if (PON(2) && IN(pb + 1)) for (int rp_ = 0; rp_ < RPT(2); ++rp_) {
            PHASE_FRAME;
            bf16* XB = (bf16*)(P.ws + WS_XB); float* XF = (float*)(P.ws + WS_XF);
            bf16* Qb = (bf16*)(P.ws + WS_Q); bf16* Kb = (bf16*)(P.ws + WS_K); bf16* Gb = (bf16*)(P.ws + WS_G); bf16* VT = (bf16*)(P.ws + WS_VT);
            bf16* U2 = (bf16*)(P.ws + WS_U2); bf16* Yb = (bf16*)(P.ws + WS_Y); bf16* MIX = (bf16*)(P.ws + WS_MIX); float* Z = (float*)(P.ws + WS_Z);
            bf16* X1B = (bf16*)(P.ws + WS_X1B); bf16* Hb = (bf16*)(P.ws + WS_H); bf16* YB = (bf16*)(P.ws + WS_YB);
            const bf16* Win = (const bf16*)(P.ws + WS_WIN) + (size_t)layer * NPROJ * DM;
            (void)XB; (void)XF; (void)Qb; (void)Kb; (void)Gb; (void)VT; (void)U2; (void)Yb; (void)MIX; (void)Z; (void)X1B; (void)Hb; (void)YB; (void)Win;
            const int cpos = P.vcu & 3, ufirst4 = TI_MOE0 + TI_G + layer * (TI_U / 2) + cpos * (TI_U / 8), cgw4 = (P.vcu >> 2) * NWAVES + P.wave, cngw4 = (P.G >> 2) * NWAVES;
            for (int rq_ = 0; rq_ < (PROBE_PHASE == 21 ? 2 : 1); ++rq_)
            for (int u = P.vcu; u < 256; u += P.G) { const int bh = u >> 3, p = u & 7, b = bh >> 2, h = bh & 3;
                if (cpos == 0) { convert_items(P, args, ufirst4, TI_U / 8, cgw4, cngw4); __syncthreads(); }
                retention_qtile(P, Qb, Kb, VT, Gb, P.ws + WS_MIX8, b, h, 15 - p); __syncthreads();
                if (cpos == 1) { convert_items(P, args, ufirst4, TI_U / 8, cgw4, cngw4); __syncthreads(); }
                retention_qtile(P, Qb, Kb, VT, Gb, P.ws + WS_MIX8, b, h, p); __syncthreads();
                if (cpos == 2) { convert_items(P, args, ufirst4, TI_U / 8, cgw4, cngw4); __syncthreads(); } }
            for (int rq_ = 0; rq_ < (PROBE_PHASE == 22 ? 2 : 1); ++rq_)
            for (int u2 = P.vcu * 2; u2 < 512; u2 += 2 * P.G) { const int g = u2 >> 3, b0 = u2 & 7;
                s5in_pair(P, U2, (const bf16*)(P.ws + WS_S5IN) + ((size_t)layer * SGRP + g) * (128 * 256), (const float*)(P.ws + WS_S5A) + ((size_t)layer * SGRP + g) * SST * 2, g, b0); }
            if (cpos == 3) { __syncthreads(); convert_items(P, args, ufirst4, TI_U / 8, cgw4, cngw4); __syncthreads(); }
        }
        if (F.G == 256) { if (IN(pb + 1) && IN(pb + 2)) { VM_WAIT(); __syncthreads(); } } else SEAM(pb + 1);

        if (PON(3) && IN(pb + 2)) for (int rp_ = 0; rp_ < RPT(3); ++rp_) {
            PHASE_FRAME;
            bf16* XB = (bf16*)(P.ws + WS_XB); float* XF = (float*)(P.ws + WS_XF);
            bf16* Qb = (bf16*)(P.ws + WS_Q); bf16* Kb = (bf16*)(P.ws + WS_K); bf16* Gb = (bf16*)(P.ws + WS_G); bf16* VT = (bf16*)(P.ws + WS_VT);
            bf16* U2 = (bf16*)(P.ws + WS_U2); bf16* Yb = (bf16*)(P.ws + WS_Y); bf16* MIX = (bf16*)(P.ws + WS_MIX); float* Z = (float*)(P.ws + WS_Z);
            bf16* X1B = (bf16*)(P.ws + WS_X1B); bf16* Hb = (bf16*)(P.ws + WS_H); bf16* YB = (bf16*)(P.ws + WS_YB);
            const bf16* Win = (const bf16*)(P.ws + WS_WIN) + (size_t)layer * NPROJ * DM;
            (void)XB; (void)XF; (void)Qb; (void)Kb; (void)Gb; (void)VT; (void)U2; (void)Yb; (void)MIX; (void)Z; (void)X1B; (void)Hb; (void)YB; (void)Win;
            pg8::S5Order S; S.G = P.G; S.c = P.vcu; S.Bt = (const char*)((const bf16*)(P.ws + WS_S5OUT) + (size_t)layer * SGRP * 256 * KS5);
            pg8::EpiS5Out E{Yb, P.ws + WS_Y8};
            int k5 = KS5; asm volatile("" : "+s"(k5));
            S.ulist = (const LAS int*)(P.lds + TST_OFF + 896); __syncthreads(); pg8::moe_units(S, (LAS int*)(P.lds + TST_OFF + 896), P.tid); __syncthreads();
            pg8::gemm_phase<false>(P.lds, P.tid, (const char*)U2, k5, S, E);
        }
        SEAM(pb + 2);

        if (PON(4) && IN(pb + 3)) for (int rp_ = 0; rp_ < RPT(4); ++rp_) {
            PHASE_FRAME;
            bf16* XB = (bf16*)(P.ws + WS_XB); float* XF = (float*)(P.ws + WS_XF);
            bf16* Qb = (bf16*)(P.ws + WS_Q); bf16* Kb = (bf16*)(P.ws + WS_K); bf16* Gb = (bf16*)(P.ws + WS_G); bf16* VT = (bf16*)(P.ws + WS_VT);
            bf16* U2 = (bf16*)(P.ws + WS_U2); bf16* Yb = (bf16*)(P.ws + WS_Y); bf16* MIX = (bf16*)(P.ws + WS_MIX); float* Z = (float*)(P.ws + WS_Z);
            bf16* X1B = (bf16*)(P.ws + WS_X1B); bf16* Hb = (bf16*)(P.ws + WS_H); bf16* YB = (bf16*)(P.ws + WS_YB);
            const bf16* Win = (const bf16*)(P.ws + WS_WIN) + (size_t)layer * NPROJ * DM;
            (void)XB; (void)XF; (void)Qb; (void)Kb; (void)Gb; (void)VT; (void)U2; (void)Yb; (void)MIX; (void)Z; (void)X1B; (void)Hb; (void)YB; (void)Win;
            pg8::GluOrder S; S.init(T, 1024, 1024, P.G, (int)blockIdx.x, P.ws + WS_WGLU + (size_t)layer * 1024 * 1024, 1); S.rowbytes = 16;
            pg8::EpiGlu E{Yb, P.ws + WS_MIX8};
            S.ulist = (const LAS int*)(P.lds + TST_OFF + 896); __syncthreads(); pg8::moe_units(S, (LAS int*)(P.lds + TST_OFF + 896), P.tid); __syncthreads();
            pg8::gemm_phase<true>(P.lds, P.tid, (const char*)(P.ws + WS_Y8), 1024, S, E);
        }
        SEAM(pb + 3);

        if (PON(5) && IN(pb + 4)) for (int rp_ = 0; rp_ < RPT(5); ++rp_) {
            PHASE_FRAME;
            bf16* XB = (bf16*)(P.ws + WS_XB); float* XF = (float*)(P.ws + WS_XF);
            bf16* Qb = (bf16*)(P.ws + WS_Q); bf16* Kb = (bf16*)(P.ws + WS_K); bf16* Gb = (bf16*)(P.ws + WS_G); bf16* VT = (bf16*)(P.ws + WS_VT);
            bf16* U2 = (bf16*)(P.ws + WS_U2); bf16* Yb = (bf16*)(P.ws + WS_Y); bf16* MIX = (bf16*)(P.ws + WS_MIX); float* Z = (float*)(P.ws + WS_Z);
            bf16* X1B = (bf16*)(P.ws + WS_X1B); bf16* Hb = (bf16*)(P.ws + WS_H); bf16* YB = (bf16*)(P.ws + WS_YB);
            const bf16* Win = (const bf16*)(P.ws + WS_WIN) + (size_t)layer * NPROJ * DM;
            (void)XB; (void)XF; (void)Qb; (void)Kb; (void)Gb; (void)VT; (void)U2; (void)Yb; (void)MIX; (void)Z; (void)X1B; (void)Hb; (void)YB; (void)Win;
            pg8::DenseOrder S; S.init(T, DM, DM, P.G, (int)blockIdx.x, P.ws + WS_WOUT + (size_t)layer * DM * DM, 1);

            constexpr int GC0 = 5462, GC1 = 5462, GC2 = TI_G / 2 - GC0 - GC1;
            const int gcls = P.vcu % 3, gfirst = TI_MOE0 + layer * (TI_G / 2) + (gcls == 0 ? 0 : (gcls == 1 ? GC0 : GC0 + GC1)), gcount = gcls == 0 ? GC0 : (gcls == 1 ? GC1 : GC2);
            const int cgw = (P.vcu / 3) * NWAVES + P.wave, cngw = ((P.G - gcls + 2) / 3) * NWAVES;
            if (gcls == 0) convert_items(P, args, gfirst, gcount, cgw, cngw);
            S.ulist = (const LAS int*)(P.lds + TST_OFF + 896); __syncthreads(); pg8::moe_units(S, (LAS int*)(P.lds + TST_OFF + 896), P.tid); __syncthreads();
            const ConvHook H{&P, &args, gfirst, gcount, cgw, cngw, gcls == 1 ? 0 : -1};
            if (layer == 0) { pg8::EpiResid<true> E{(const void*)args.in[0], (bf16*)Z}; pg8::gemm_phase<true>(P.lds, P.tid, (const char*)(P.ws + WS_MIX8), DM, S, E, H); }
            else { pg8::EpiResid<false> E{(const void*)XB, (bf16*)Z}; pg8::gemm_phase<true>(P.lds, P.tid, (const char*)(P.ws + WS_MIX8), DM, S, E, H); }
            if (gcls == 2) convert_items(P, args, gfirst, gcount, cgw, cngw);
        }
        SEAM(pb + 4);

        if (PON(6) && IN(pb + 5)) for (int rp_ = 0; rp_ < RPT(6); ++rp_) {
            PHASE_FRAME;
            bf16* XB = (bf16*)(P.ws + WS_XB); float* XF = (float*)(P.ws + WS_XF);
            bf16* Qb = (bf16*)(P.ws + WS_Q); bf16* Kb = (bf16*)(P.ws + WS_K); bf16* Gb = (bf16*)(P.ws + WS_G); bf16* VT = (bf16*)(P.ws + WS_VT);
            bf16* U2 = (bf16*)(P.ws + WS_U2); bf16* Yb = (bf16*)(P.ws + WS_Y); bf16* MIX = (bf16*)(P.ws + WS_MIX); float* Z = (float*)(P.ws + WS_Z);
            bf16* X1B = (bf16*)(P.ws + WS_X1B); bf16* Hb = (bf16*)(P.ws + WS_H); bf16* YB = (bf16*)(P.ws + WS_YB);
            const bf16* Win = (const bf16*)(P.ws + WS_WIN) + (size_t)layer * NPROJ * DM;
            (void)XB; (void)XF; (void)Qb; (void)Kb; (void)Gb; (void)VT; (void)U2; (void)Yb; (void)MIX; (void)Z; (void)X1B; (void)Hb; (void)YB; (void)Win;
            for (int u = P.vcu; u < T / 64; u += P.G) ln1_router_unit(P, args, layer, u);

        }
        SEAM(pb + 5);

        if (PON(7) && IN(pb + 6)) for (int rp_ = 0; rp_ < RPT(7); ++rp_) {
            PHASE_FRAME;
            bf16* XB = (bf16*)(P.ws + WS_XB); float* XF = (float*)(P.ws + WS_XF);
            bf16* Qb = (bf16*)(P.ws + WS_Q); bf16* Kb = (bf16*)(P.ws + WS_K); bf16* Gb = (bf16*)(P.ws + WS_G); bf16* VT = (bf16*)(P.ws + WS_VT);
            bf16* U2 = (bf16*)(P.ws + WS_U2); bf16* Yb = (bf16*)(P.ws + WS_Y); bf16* MIX = (bf16*)(P.ws + WS_MIX); float* Z = (float*)(P.ws + WS_Z);
            bf16* X1B = (bf16*)(P.ws + WS_X1B); bf16* Hb = (bf16*)(P.ws + WS_H); bf16* YB = (bf16*)(P.ws + WS_YB);
            const bf16* Win = (const bf16*)(P.ws + WS_WIN) + (size_t)layer * NPROJ * DM;
            (void)XB; (void)XF; (void)Qb; (void)Kb; (void)Gb; (void)VT; (void)U2; (void)Yb; (void)MIX; (void)Z; (void)X1B; (void)Hb; (void)YB; (void)Win;
            moe_setup(P, layer);
            const LAS int* cnt = (const LAS int*)(P.lds + TST_OFF); const LAS int* pst = cnt + 32; const LAS int* fst = pst + 33; const LAS int* hst = fst + 33;
            LAS unsigned* table = (LAS unsigned*)(P.lds + TAB_OFF);
            pg8::MoeOrder<true> S; S.NF = fst[NE] * 8; S.NU = S.NF + hst[NE] * 8; S.G = P.G; S.c = P.vcu; S.pst = pst; S.fst = fst; S.hst = hst; S.table = table; S.rowbytes = 0;
            S.Bt = (const char*)(P.ws + WS_WGU) + (size_t)layer * NE * 2048 * DM; S.estepB = (size_t)2048 * DM; S.tstepB = (size_t)256 * DM;
            S.ulist = (const LAS int*)(P.lds + TST_OFF + 896); pg8::moe_units(S, (LAS int*)(P.lds + TST_OFF + 896), P.tid); __syncthreads();
            { const int* list = (const int*)(P.ws + WS_LIST); int tk[8]; bool okk[8];
#pragma unroll
              for (int i = 0; i < 8; ++i) { pg8::Unit u; okk[i] = S.next(i, u) && (P.tid < 256); int tok = 0;
                  if (okk[i]) { const int e = u.e & 255; const int slot = (u.pm - pst[e] * 128) + P.tid; if (slot < cnt[e]) tok = list[e * T + slot]; }
                  tk[i] = tok; }
#pragma unroll
              for (int i = 0; i < 8; ++i) if (okk[i]) { int tok = tk[i]; tok = tok < 0 ? 0 : (tok >= T ? T - 1 : tok); table[i * 256 + P.tid] = (unsigned)tok * (unsigned)DM; } }
            __syncthreads();
            const int dcls = P.vcu & 3, dk = P.vcu >> 2, nclass = P.G >> 2;
            int dfirst = TI_MOE0 + 2 * TI_G + layer * (TI_D / 2) + dcls * (TI_D / 8), dcount = TI_D / 8, dgw = dk * NWAVES + P.wave, dngw = nclass * NWAVES;
            { const int ntall = S.NU - 4 * P.G; int nt = ntall > dcls ? (ntall - dcls + 3) >> 2 : 0; nt = nt > nclass ? nclass : nt;
              const int wtot = 3 * nt + 5 * (nclass - nt), c0 = 3 * (dk < nt ? dk : nt) + 5 * (dk > nt ? dk - nt : 0), c1 = c0 + (dk < nt ? 3 : 5);
              const int npc = TI_D / 16;
              const int p0 = (int)(((long)npc * c0) / wtot), p1 = (int)(((long)npc * c1) / wtot);
              dfirst += 2 * p0; dcount = 2 * (p1 - p0); dgw = P.wave; dngw = NWAVES; }
            pg8::EpiGateUp E{(unsigned char*)Hb};
            if (dcls == 0) convert_items(P, args, dfirst, dcount, dgw, dngw);
            { const ConvHook H{&P, &args, dfirst, dcount, dgw, dngw, dcls == 1 ? 0 : (dcls == 2 ? 2 : -1)};
              pg8::gemm_phase<true>(P.lds, P.tid, (const char*)(P.ws + WS_XF), DM, S, E, H); }
            if (dcls == 3) convert_items(P, args, dfirst, dcount, dgw, dngw);
        }
        SEAM(pb + 6);

        if (PON(8) && IN(pb + 7)) for (int rp_ = 0; rp_ < RPT(8); ++rp_) {
            PHASE_FRAME;
            bf16* XB = (bf16*)(P.ws + WS_XB); float* XF = (float*)(P.ws + WS_XF);
            bf16* Qb = (bf16*)(P.ws + WS_Q); bf16* Kb = (bf16*)(P.ws + WS_K); bf16* Gb = (bf16*)(P.ws + WS_G); bf16* VT = (bf16*)(P.ws + WS_VT);
            bf16* U2 = (bf16*)(P.ws + WS_U2); bf16* Yb = (bf16*)(P.ws + WS_Y); bf16* MIX = (bf16*)(P.ws + WS_MIX); float* Z = (float*)(P.ws + WS_Z);
            bf16* X1B = (bf16*)(P.ws + WS_X1B); bf16* Hb = (bf16*)(P.ws + WS_H); bf16* YB = (bf16*)(P.ws + WS_YB);
            const bf16* Win = (const bf16*)(P.ws + WS_WIN) + (size_t)layer * NPROJ * DM;
            (void)XB; (void)XF; (void)Qb; (void)Kb; (void)Gb; (void)VT; (void)U2; (void)Yb; (void)MIX; (void)Z; (void)X1B; (void)Hb; (void)YB; (void)Win;
            moe_setup(P, layer);
            const LAS int* pst = (const LAS int*)(P.lds + TST_OFF) + 32; const LAS int* fst = pst + 33; const LAS int* hst = fst + 33;
            pg8::MoeOrder<false> S; S.NF = fst[NE] * 8; S.NU = S.NF + hst[NE] * 8; S.G = P.G; S.c = P.vcu; S.pst = pst; S.fst = fst; S.hst = hst; S.table = (const LAS unsigned*)(P.lds + TAB_OFF); S.rowbytes = DE;
            S.ulist = (const LAS int*)(P.lds + TST_OFF + 896);
            S.Bt = (const char*)(P.ws + WS_WDN) + (size_t)layer * NE * DM * DE; S.estepB = (size_t)DM * DE; S.tstepB = (size_t)256 * DE;
            pg8::moe_units(S, (LAS int*)(P.lds + TST_OFF + 896), P.tid); __syncthreads();
            pg8::EpiF8 E{(unsigned char*)YB, DM, W8_INV * 16.0f};
            pg8::gemm_phase<true>(P.lds, P.tid, (const char*)Hb, DE, S, E);
        }
        SEAM(pb + 7);

        if (PON(9) && IN(pb + 8)) for (int rp_ = 0; rp_ < RPT(9); ++rp_) {
            PHASE_FRAME;
            bf16* XB = (bf16*)(P.ws + WS_XB); float* XF = (float*)(P.ws + WS_XF);
            bf16* Qb = (bf16*)(P.ws + WS_Q); bf16* Kb = (bf16*)(P.ws + WS_K); bf16* Gb = (bf16*)(P.ws + WS_G); bf16* VT = (bf16*)(P.ws + WS_VT);
            bf16* U2 = (bf16*)(P.ws + WS_U2); bf16* Yb = (bf16*)(P.ws + WS_Y); bf16* MIX = (bf16*)(P.ws + WS_MIX); float* Z = (float*)(P.ws + WS_Z);
            bf16* X1B = (bf16*)(P.ws + WS_X1B); bf16* Hb = (bf16*)(P.ws + WS_H); bf16* YB = (bf16*)(P.ws + WS_YB);
            const bf16* Win = (const bf16*)(P.ws + WS_WIN) + (size_t)layer * NPROJ * DM;
            (void)XB; (void)XF; (void)Qb; (void)Kb; (void)Gb; (void)VT; (void)U2; (void)Yb; (void)MIX; (void)Z; (void)X1B; (void)Hb; (void)YB; (void)Win;
            moe_setup(P, layer);
            float* outf = layer == 1 ? args.out : (float*)nullptr; bf16* outb = layer == 1 ? (bf16*)nullptr : XB;
            { LAS float* gl = (LAS float*)P.lds;
              { const f32x4 g = *(const f32x4*)(args.in[14] + layer * DM + 4 * P.tid), b = *(const f32x4*)(args.in[15] + layer * DM + 4 * P.tid); *(LAS f32x4*)(gl + 4 * P.tid) = g; *(LAS f32x4*)(gl + DM + 4 * P.tid) = b;
                const f32x4 g1 = *(const f32x4*)(args.in[12] + layer * DM + 4 * P.tid), b1 = *(const f32x4*)(args.in[13] + layer * DM + 4 * P.tid); *(LAS f32x4*)(gl + 2 * DM + 4 * P.tid) = g1; *(LAS f32x4*)(gl + 3 * DM + 4 * P.tid) = b1; }
              __syncthreads();
              const int step = P.G * NWAVES; const int tok0 = P.vcu * NWAVES + P.wave;
#pragma nounroll
              for (int tok = tok0; tok < T; tok += LN2R * step) { int toks[LN2R];
#pragma unroll
                  for (int r = 0; r < LN2R; ++r) toks[r] = (tok + r * step < T) ? tok + r * step : tok;
                  ln2_rows(P, gl, toks, outf, outb); } }
        }
        if (layer == 0) SEAM(pb + 8);
    }
#undef IN
#undef SEAM
}

extern "C" void kernel_launch(void* const* d_in, const int* in_sizes, int n_in, void* d_out, int out_size, void* d_ws, size_t ws_size, hipStream_t stream) {
    static int grid = 0;
    if (grid == 0) {
        if (n_in != 21 || out_size != T * DM || ws_size < WS_END) { fprintf(stderr, "kernel_launch: unexpected problem (n_in %d, out %d, ws %zu; need ws >= %zu)\n", n_in, out_size, ws_size, (size_t)WS_END); grid = -1; return; }
        int dev = 0, cus = 0, per_cu = 0;
        if (hipGetDevice(&dev) != hipSuccess || hipDeviceGetAttribute(&cus, hipDeviceAttributeMultiprocessorCount, dev) != hipSuccess) { grid = -1; return; }
        if (hipFuncSetAttribute((const void*)mk_fwd, hipFuncAttributeMaxDynamicSharedMemorySize, LDS_BYTES) != hipSuccess) { fprintf(stderr, "kernel_launch: hipFuncSetAttribute failed\n"); grid = -1; return; }
        if (hipOccupancyMaxActiveBlocksPerMultiprocessor(&per_cu, (const void*)mk_fwd, NWAVES * 64, LDS_BYTES) != hipSuccess || per_cu < 1) fprintf(stderr, "kernel_launch: occupancy query reports %d\n", per_cu);
        (void)hipGetLastError();
        grid = cus;
    }
    if (grid < 0) return;
    (void)hipMemsetAsync((char*)d_ws + WS_CTL, 0, CTL_ZERO_BYTES, stream);
    Args a{};
    for (int i = 0; i < 21; ++i) a.in[i] = (const float*)d_in[i];
    a.out = (float*)d_out; a.ws = (unsigned char*)d_ws;
#if MK_N_LAUNCHES == 1
    a.ph_lo = 0; a.ph_hi = NPH;
    hipLaunchKernelGGL(mk_fwd, dim3(grid), dim3(NWAVES * 64), LDS_BYTES, stream, a);
#else
    for (int p = 0; p < NPH; ++p) { a.ph_lo = p; a.ph_hi = p + 1; hipLaunchKernelGGL(mk_fwd, dim3(grid), dim3(NWAVES * 64), LDS_BYTES, stream, a); }
#endif
}
```
